# Optimizing an MI355X kernel written in HIP

```python
import jax, jax.numpy as jnp
from jax import lax
import numpy as np

D_MODEL = 1024
BATCH = 16
SEQ = 256
DEPTH = 4
DEC_BATCH = 2
DEC_SEQ = 1024
PAST_LEN = 256

GRID_W = 64
N_MIXERS = 3
N_FOURIER_LAYERS = (DEPTH + 2) // 3
N_DELTA_LAYERS = (DEPTH + 1) // 3
N_MLSTM_LAYERS = DEPTH // 3
N_DIR = 2
EPS = 1e-6

FNET_GROUPS = 4
FNET_GROUP_DIM = D_MODEL // FNET_GROUPS

DN_HEADS = 8
DN_DK = 128
DN_DV = 128
DN_CONV = 5
DN_CHUNK = 64
DN_QKV = DN_HEADS * (2 * DN_DK + DN_DV)
DN_PROJ = DN_QKV + DN_HEADS * DN_DV + 2 * N_DIR * DN_HEADS

ML_HEADS = 8
ML_DQK = 64
ML_DV = 128
ML_CHUNK = 64
ML_HQ = ML_HEADS * ML_DQK
ML_HV = ML_HEADS * ML_DV
ML_PROJ = 2 * ML_HQ + 2 * ML_HV + 2 * N_DIR * ML_HEADS

D_FF = 2816

kernel_name = 'hybrid_fnet_gdn_mlstm_diffusion_step'


def rmsnorm(x, g):
    xf = x.astype(jnp.float32)
    y = xf * lax.rsqrt(jnp.mean(xf * xf, axis=-1, keepdims=True) + EPS)
    return (y * g.astype(jnp.float32)).astype(x.dtype)


def l2norm(x):
    return x * lax.rsqrt(jnp.sum(x * x, axis=-1, keepdims=True) + EPS)


def adaln(cond, w, b):
    m = (jax.nn.silu(cond) @ w + b)[:, None, :]
    return jnp.split(m, 6, axis=-1)


def dwconv_seq(x, w):
    K, T = w.shape[0], x.shape[1]
    p = K // 2
    xp = jnp.pad(x, ((0, 0), (p, p), (0, 0)))
    return sum(xp[:, j:j + T, :] * w[j] for j in range(K))


def dwconv_grid(x, w):
    R, W = x.shape[1], x.shape[2]
    xp = jnp.pad(x, ((0, 0), (1, 1), (1, 1), (0, 0)))
    return sum(xp[:, i:i + R, j:j + W, :] * w[i, j] for i in range(3) for j in range(3))


def to_chunks(a, chunk):
    B, T, H = a.shape[:3]
    a = a.reshape((B, T // chunk, chunk, H) + a.shape[3:])
    return jnp.moveaxis(a, (1, 3), (0, 2))


def from_chunks(o):
    o = jnp.moveaxis(o, (0, 2), (1, 3))
    return o.reshape((o.shape[0], o.shape[1] * o.shape[2]) + o.shape[3:])


def conv_ffn(h, w_up, conv_w, conv_b, w_down, rows):
    B, T, _ = h.shape
    a, g = jnp.split(h @ w_up, 2, axis=-1)
    g = dwconv_grid(g.reshape(B, rows, T // rows, D_FF), conv_w).reshape(B, T, D_FF) + conv_b
    return (jax.nn.silu(g) * a) @ w_down


def fourier_mix(h, w, b):
    B, T, _ = h.shape
    hg = h.astype(jnp.float32).reshape(B, T, FNET_GROUPS, FNET_GROUP_DIM)
    f = jnp.real(jnp.fft.fft2(hg, axes=(1, 3), norm='ortho'))
    return f.reshape(B, T, D_MODEL).astype(h.dtype) @ w + b


def gdn_chunked(q, k, v, g, beta, s0):
    C = DN_CHUNK
    qc, kc, vc = to_chunks(q, C), to_chunks(k, C), to_chunks(v, C)
    gc = jnp.cumsum(to_chunks(g, C), axis=-1)
    bc = to_chunks(beta, C)
    tril = jnp.tril(jnp.ones((C, C), bool))
    strict = jnp.tril(jnp.ones((C, C), bool), -1)
    decay = jnp.exp(jnp.where(tril, gc[..., :, None] - gc[..., None, :], -jnp.inf))
    kb = kc * bc[..., None]
    a_mat = jnp.where(strict, jnp.einsum('nbhcd,nbhsd->nbhcs', kb, kc) * decay, 0.0) + jnp.eye(C, dtype=jnp.float32)
    u = lax.linalg.triangular_solve(a_mat, vc * bc[..., None], left_side=True, lower=True, unit_diagonal=True)
    w = lax.linalg.triangular_solve(a_mat, kb * jnp.exp(gc)[..., None], left_side=True, lower=True, unit_diagonal=True)
    qk = jnp.einsum('nbhcd,nbhsd->nbhcs', qc, kc) * decay
    q_dec = qc * jnp.exp(gc)[..., None]
    g_last = gc[..., -1]
    k_dec = kc * jnp.exp(g_last[..., None] - gc)[..., None]

    def step(s, xs):
        u_n, w_n, qk_n, qd_n, kd_n, gl_n = xs
        v_new = u_n - jnp.einsum('bhcd,bhde->bhce', w_n, s)
        o_n = jnp.einsum('bhcd,bhde->bhce', qd_n, s) + jnp.einsum('bhcs,bhse->bhce', qk_n, v_new)
        s = s * jnp.exp(gl_n)[..., None, None] + jnp.einsum('bhcd,bhce->bhde', kd_n, v_new)
        return s, o_n

    s_fin, o = lax.scan(step, s0, (u, w, qk, q_dec, k_dec, g_last))
    return from_chunks(o), s_fin


def gated_delta_mix(h, w_in, conv_w, a_log, dt_bias, norm_g, w_out, s0):
    B, T, _ = h.shape
    f32 = jnp.float32
    qkv, z, gates = jnp.split(h @ w_in, [DN_QKV, DN_QKV + DN_HEADS * DN_DV], axis=-1)
    qkv = jax.nn.silu(dwconv_seq(qkv, conv_w)).astype(f32)
    q, k, v = jnp.split(qkv, [DN_HEADS * DN_DK, 2 * DN_HEADS * DN_DK], axis=-1)
    q = l2norm(q.reshape(B, T, DN_HEADS, DN_DK)) * (DN_DK ** -0.5)
    k = l2norm(k.reshape(B, T, DN_HEADS, DN_DK))
    v = v.reshape(B, T, DN_HEADS, DN_DV)
    gates = gates.astype(f32).reshape(B, T, N_DIR, 2, DN_HEADS)
    g = -jnp.exp(a_log.astype(f32)) * jax.nn.softplus(gates[..., 0, :] + dt_bias)
    beta = jax.nn.sigmoid(gates[..., 1, :])
    s0 = s0.astype(f32)
    o_f, s_f = gdn_chunked(q, k, v, g[:, :, 0], beta[:, :, 0], s0[:, 0])
    o_b, s_b = gdn_chunked(q[:, ::-1], k[:, ::-1], v[:, ::-1], g[:, ::-1, 1], beta[:, ::-1, 1], s0[:, 1])
    o = o_f + o_b[:, ::-1]
    o = rmsnorm(o, norm_g) * jax.nn.silu(z.astype(f32).reshape(B, T, DN_HEADS, DN_DV))
    y = o.reshape(B, T, DN_HEADS * DN_DV).astype(h.dtype) @ w_out
    return y, jnp.stack([s_f, s_b], axis=1)


def mlstm_chunked(q, k, v, li, lf, c0, n0, m0):
    C = ML_CHUNK
    qc, kc, vc = to_chunks(q, C), to_chunks(k, C), to_chunks(v, C)
    bcum = jnp.cumsum(to_chunks(lf, C), axis=-1)
    lic = to_chunks(li, C)
    tril = jnp.tril(jnp.ones((C, C), bool))
    d_log = jnp.where(tril, bcum[..., :, None] - bcum[..., None, :] + lic[..., None, :], -jnp.inf)
    d_max = jnp.max(d_log, axis=-1)
    qk = jnp.einsum('nbhcd,nbhsd->nbhcs', qc, kc)
    b_last = bcum[..., -1]
    w_log = b_last[..., None] - bcum + lic
    w_max = jnp.max(w_log, axis=-1)

    def step(carry, xs):
        c, n, m = carry
        qk_n, dl_n, dm_n, b_n, q_n, k_n, v_n, bl_n, wl_n, wm_n = xs
        m_t = jnp.maximum(b_n + m[..., None], dm_n)
        inter = jnp.exp(b_n + m[..., None] - m_t)
        s = qk_n * jnp.exp(dl_n - m_t[..., None])
        num = inter[..., None] * jnp.einsum('bhcd,bhde->bhce', q_n, c) + jnp.einsum('bhcs,bhse->bhce', s, v_n)
        den = inter * jnp.einsum('bhcd,bhd->bhc', q_n, n) + jnp.sum(s, axis=-1)
        h = num / jnp.maximum(jnp.abs(den), jnp.exp(-m_t))[..., None]
        m_new = jnp.maximum(bl_n + m, wm_n)
        dec = jnp.exp(bl_n + m - m_new)
        kw = k_n * jnp.exp(wl_n - m_new[..., None])[..., None]
        c = dec[..., None, None] * c + jnp.einsum('bhcd,bhce->bhde', kw, v_n)
        n = dec[..., None] * n + jnp.sum(kw, axis=-2)
        return (c, n, m_new), h

    (c_f, n_f, m_f), h = lax.scan(step, (c0, n0, m0), (qk, d_log, d_max, bcum, qc, kc, vc, b_last, w_log, w_max))
    return from_chunks(h), c_f, n_f, m_f


def mlstm_mix(h, w_in, b_i, b_f, norm_g, w_out, c0, n0, m0):
    B, T, _ = h.shape
    f32 = jnp.float32
    q, k, v, o, gates = jnp.split((h @ w_in).astype(f32), [ML_HQ, 2 * ML_HQ, 2 * ML_HQ + ML_HV, 2 * ML_HQ + 2 * ML_HV], axis=-1)
    q = q.reshape(B, T, ML_HEADS, ML_DQK) * (ML_DQK ** -0.5)
    k = k.reshape(B, T, ML_HEADS, ML_DQK)
    v = v.reshape(B, T, ML_HEADS, ML_DV)
    gates = gates.reshape(B, T, N_DIR, 2, ML_HEADS)
    li = gates[..., 0, :] + b_i
    lf = jax.nn.log_sigmoid(gates[..., 1, :] + b_f)
    c0, n0, m0 = c0.astype(f32), n0.astype(f32), m0.astype(f32)
    h_f, cf, nf, mf = mlstm_chunked(q, k, v, li[:, :, 0], lf[:, :, 0], c0[:, 0], n0[:, 0], m0[:, 0])
    h_b, cb, nb, mb = mlstm_chunked(q[:, ::-1], k[:, ::-1], v[:, ::-1], li[:, ::-1, 1], lf[:, ::-1, 1], c0[:, 1], n0[:, 1], m0[:, 1])
    hs = h_f + h_b[:, ::-1]
    hs = rmsnorm(hs, norm_g) * jax.nn.sigmoid(o.reshape(B, T, ML_HEADS, ML_DV))
    y = hs.reshape(B, T, ML_HV).astype(h.dtype) @ w_out
    return y, jnp.stack([cf, cb], axis=1), jnp.stack([nf, nb], axis=1), jnp.stack([mf, mb], axis=1)


def trunk(x, cond, rows, st_d, st_c, st_n, st_m, params):
    (w_ada, b_ada, norm_mix, norm_ffn, norm_final, ffn_w_up, ffn_conv_w, ffn_conv_b, ffn_w_down,
     fnet_w, fnet_b, dn_w_in, dn_conv_w, dn_a_log, dn_dt_bias, dn_norm, dn_w_out,
     ml_w_in, ml_b_i, ml_b_f, ml_norm, ml_w_out) = params
    out_d, out_c, out_n, out_m = [], [], [], []
    for layer in range(DEPTH):
        sh1, sc1, g1, sh2, sc2, g2 = adaln(cond, w_ada[layer], b_ada[layer])
        h = rmsnorm(x, norm_mix[layer]) * (1 + sc1) + sh1
        kind, j = layer % N_MIXERS, layer // N_MIXERS
        if kind == 0:
            y = fourier_mix(h, fnet_w[j], fnet_b[j])
        elif kind == 1:
            y, sd = gated_delta_mix(h, dn_w_in[j], dn_conv_w[j], dn_a_log[j], dn_dt_bias[j], dn_norm[j], dn_w_out[j], st_d[:, j])
            out_d.append(sd)
        else:
            y, mc, mn, mm = mlstm_mix(h, ml_w_in[j], ml_b_i[j], ml_b_f[j], ml_norm[j], ml_w_out[j], st_c[:, j], st_n[:, j], st_m[:, j])
            out_c.append(mc)
            out_n.append(mn)
            out_m.append(mm)
        x = x + g1 * y
        h = rmsnorm(x, norm_ffn[layer]) * (1 + sc2) + sh2
        x = x + g2 * conv_ffn(h, ffn_w_up[layer], ffn_conv_w[layer], ffn_conv_b[layer], ffn_w_down[layer], rows)
    return (rmsnorm(x, norm_final), jnp.stack(out_d, axis=1), jnp.stack(out_c, axis=1),
            jnp.stack(out_n, axis=1), jnp.stack(out_m, axis=1))


def setup_inputs(seed: int = 0) -> dict:
    key = jax.random.key(seed)
    ks = jax.random.split(key, 32)
    f32 = jnp.float32

    def nrm(k, shape, s):
        return jax.random.normal(k, shape, f32) * s

    D = D_MODEL
    dt = jnp.exp(jax.random.uniform(ks[22], (N_DELTA_LAYERS, N_DIR, DN_HEADS), f32, np.log(1e-3), np.log(1e-1)))
    return {
        'x_prompt': nrm(ks[0], (BATCH, SEQ, D), 1.0),
        'x_sample': nrm(ks[1], (DEC_BATCH, DEC_SEQ, D), 1.0),
        'state_delta': nrm(ks[2], (DEC_BATCH, N_DELTA_LAYERS, N_DIR, DN_HEADS, DN_DK, DN_DV), 0.1),
        'state_mlstm_c': nrm(ks[3], (DEC_BATCH, N_MLSTM_LAYERS, N_DIR, ML_HEADS, ML_DQK, ML_DV), 0.5),
        'state_mlstm_n': nrm(ks[4], (DEC_BATCH, N_MLSTM_LAYERS, N_DIR, ML_HEADS, ML_DQK), 0.5),
        'state_mlstm_m': nrm(ks[5], (DEC_BATCH, N_MLSTM_LAYERS, N_DIR, ML_HEADS), 1.0),
        'c': nrm(ks[6], (DEC_BATCH, D), 1.0),
        'c_ctx': nrm(ks[7], (D,), 1.0),
        'w_ada': nrm(ks[8], (DEPTH, D, 6 * D), D ** -0.5),
        'b_ada': nrm(ks[9], (DEPTH, 6 * D), 0.02),
        'norm_mix': 1.0 + nrm(ks[10], (DEPTH, D), 0.02),
        'norm_ffn': 1.0 + nrm(ks[11], (DEPTH, D), 0.02),
        'norm_final': 1.0 + nrm(ks[12], (D,), 0.02),
        'ffn_w_up': nrm(ks[13], (DEPTH, D, 2 * D_FF), D ** -0.5),
        'ffn_conv_w': nrm(ks[14], (DEPTH, 3, 3, D_FF), 1.0 / 3.0),
        'ffn_conv_b': nrm(ks[15], (DEPTH, D_FF), 0.02),
        'ffn_w_down': nrm(ks[16], (DEPTH, D_FF, D), D_FF ** -0.5),
        'fnet_w': nrm(ks[17], (N_FOURIER_LAYERS, D, D), D ** -0.5),
        'fnet_b': nrm(ks[18], (N_FOURIER_LAYERS, D), 0.02),
        'dn_w_in': nrm(ks[19], (N_DELTA_LAYERS, D, DN_PROJ), D ** -0.5),
        'dn_conv_w': nrm(ks[20], (N_DELTA_LAYERS, DN_CONV, DN_QKV), DN_CONV ** -0.5),
        'dn_a_log': jnp.log(jax.random.uniform(ks[21], (N_DELTA_LAYERS, N_DIR, DN_HEADS), f32, 1.0, 16.0)),
        'dn_dt_bias': jnp.log(jnp.expm1(dt)),
        'dn_norm': 1.0 + nrm(ks[23], (N_DELTA_LAYERS, DN_DV), 0.02),
        'dn_w_out': nrm(ks[24], (N_DELTA_LAYERS, DN_HEADS * DN_DV, D), (DN_HEADS * DN_DV) ** -0.5),
        'ml_w_in': nrm(ks[25], (N_MLSTM_LAYERS, D, ML_PROJ), D ** -0.5),
        'ml_b_i': nrm(ks[26], (N_MLSTM_LAYERS, N_DIR, ML_HEADS), 0.1),
        'ml_b_f': jax.random.uniform(ks[27], (N_MLSTM_LAYERS, N_DIR, ML_HEADS), f32, 3.0, 6.0),
        'ml_norm': 1.0 + nrm(ks[28], (N_MLSTM_LAYERS, ML_DV), 0.02),
        'ml_w_out': nrm(ks[29], (N_MLSTM_LAYERS, ML_HV, D), ML_HV ** -0.5),
    }


def reference(x_prompt, x_sample, state_delta, state_mlstm_c, state_mlstm_n, state_mlstm_m, c,
              c_ctx, w_ada, b_ada, norm_mix, norm_ffn, norm_final,
              ffn_w_up, ffn_conv_w, ffn_conv_b, ffn_w_down,
              fnet_w, fnet_b,
              dn_w_in, dn_conv_w, dn_a_log, dn_dt_bias, dn_norm, dn_w_out,
              ml_w_in, ml_b_i, ml_b_f, ml_norm, ml_w_out):
    params = (w_ada, b_ada, norm_mix, norm_ffn, norm_final, ffn_w_up, ffn_conv_w, ffn_conv_b, ffn_w_down,
              fnet_w, fnet_b, dn_w_in, dn_conv_w, dn_a_log, dn_dt_bias, dn_norm, dn_w_out,
              ml_w_in, ml_b_i, ml_b_f, ml_norm, ml_w_out)
    b = x_prompt.shape[0]
    f32 = jnp.float32
    zd = jnp.zeros((b, N_DELTA_LAYERS, N_DIR, DN_HEADS, DN_DK, DN_DV), f32)
    zc = jnp.zeros((b, N_MLSTM_LAYERS, N_DIR, ML_HEADS, ML_DQK, ML_DV), f32)
    zn = jnp.zeros((b, N_MLSTM_LAYERS, N_DIR, ML_HEADS, ML_DQK), f32)
    zm = jnp.zeros((b, N_MLSTM_LAYERS, N_DIR, ML_HEADS), f32)
    y_prompt, new_d, new_c, new_n, new_m = trunk(x_prompt, c_ctx[None, :], 1, zd, zc, zn, zm, params)
    rows = x_sample.shape[1] // GRID_W
    y_sample, _, _, _, _ = trunk(x_sample, c, rows, state_delta, state_mlstm_c, state_mlstm_n, state_mlstm_m, params)
    return (y_prompt, y_sample, new_d, new_c, new_n, new_m)
```

```cpp
#include <hip/hip_runtime.h>
#include <cstdint>
#include <cstdio>

#ifndef PROBE_MASK
#define PROBE_MASK 0
#endif
#ifndef N_LAUNCH_MODE
#define N_LAUNCH_MODE 1
#endif

#define LAS __attribute__((address_space(3)))
#define GAS __attribute__((address_space(1)))
typedef unsigned short bf16_t;
typedef float f32x4 __attribute__((ext_vector_type(4)));
typedef float f32x2 __attribute__((ext_vector_type(2)));
typedef unsigned u4v __attribute__((ext_vector_type(4)));
typedef unsigned u2v __attribute__((ext_vector_type(2)));
typedef __bf16 bf16x2_t __attribute__((ext_vector_type(2)));
__device__ __forceinline__ unsigned cvtpk(float lo, float hi) { const f32x2 v = {lo, hi}; return __builtin_bit_cast(unsigned, __builtin_convertvector(v, bf16x2_t)); }

constexpr int D = 1024, MCTX = 4096, MTOT = 6144;
constexpr int DFF = 2816, NUP = 5632;
constexpr int DN_PROJ = 4128, ML_PROJ = 3104;
constexpr int NWAVES = 8, NTHR = 512;
constexpr float EPS = 1e-6f;
enum { I_XP = 0, I_XS, I_SD, I_SC, I_SN, I_SM, I_C, I_CCTX, I_WADA, I_BADA, I_NMIX, I_NFFN, I_NFIN, I_WUP, I_CW, I_CB, I_WDN,
       I_FW, I_FB, I_DWIN, I_DCW, I_DALOG, I_DDT, I_DNORM, I_DWOUT, I_MWIN, I_MBI, I_MBF, I_MNORM, I_MWOUT, N_IN };
constexpr size_t O_Y = 0, O_ND = 6291456, O_NC = 10485760, O_NN = 12582912, O_NM = 12599296;

constexpr size_t WS_CTL = 0;
constexpr size_t CTL_BYTES = 65536;
constexpr size_t ZERO_BYTES = CTL_BYTES;
constexpr size_t WS_MOD = WS_CTL + CTL_BYTES;
constexpr size_t MOD_BYTES = 4 * 3 * 6144 * 4;
constexpr size_t WS_X = WS_MOD + MOD_BYTES;
constexpr size_t WS_H = WS_X + (size_t)MTOT * D * 4;
constexpr size_t WS_TAB = WS_H + (size_t)MTOT * D * 2;
constexpr size_t TAB_CS256 = 0, TAB_CST256 = 512 * 256 * 2, TAB_CST1024 = TAB_CST256 + 256 * 512 * 2, TAB_BYTES = TAB_CST1024 + 1024 * 2048 * 2;
constexpr size_t WS_WT = WS_TAB + TAB_BYTES;
constexpr size_t WT_UP = 0;
constexpr size_t WT_DN = WT_UP + (size_t)4 * NUP * D * 2;
constexpr size_t WT_F = WT_DN + (size_t)4 * D * DFF * 2;
constexpr size_t WT_CS = WT_F + (size_t)2 * D * D * 2;
constexpr size_t WT_DIN = WT_CS + (size_t)2 * 2048 * D * 2;
constexpr size_t WT_DOUT = WT_DIN + (size_t)4352 * D * 2;
constexpr size_t WT_MIN = WT_DOUT + (size_t)D * D * 2;
constexpr size_t WT_MOUT = WT_MIN + (size_t)3328 * D * 2;
constexpr size_t WT_BYTES = WT_MOUT + (size_t)D * D * 2;
constexpr size_t WS_SLAB = WS_WT + WT_BYTES;
constexpr size_t SLAB_FULL = (size_t)MTOT * D * 4, SLAB_SMP = (size_t)2048 * D * 4;
constexpr size_t WS_BIG = WS_SLAB + 2 * SLAB_FULL + 2 * SLAB_SMP;
constexpr size_t BIG_UG = 0;
constexpr size_t BIG_ACT = BIG_UG + (size_t)MTOT * NUP * 2;
constexpr size_t BIG_ZTC = 0;
constexpr size_t BIG_ZTS = BIG_ZTC + (size_t)16 * 1024 * 512 * 2;
constexpr size_t BIG_PROJ = 0;
constexpr size_t BIG_GATES = BIG_PROJ + (size_t)MTOT * 4096 * 2;
constexpr size_t BIG_OG = BIG_GATES + (size_t)MTOT * 32 * 4;
constexpr size_t BIG_WN = BIG_OG + (size_t)MTOT * D * 2;
constexpr size_t BIG_QKM = BIG_WN + (size_t)1536 * 8192 * 2;
constexpr size_t BIG_U = BIG_QKM + (size_t)1536 * 4096 * 2;
constexpr size_t BIG_VEC = BIG_U + (size_t)1536 * 8192 * 4;
constexpr size_t BIG_QS = BIG_VEC + (size_t)1536 * 192 * 4;
constexpr size_t BIG_KTG = BIG_QS + (size_t)768 * 8192 * 2;
constexpr size_t BIG_END_DN = BIG_KTG + (size_t)768 * 8192 * 2;
constexpr size_t BIG_END = BIG_END_DN > (size_t)MTOT * NUP * 2 + (size_t)MTOT * DFF * 2 ? BIG_END_DN : (size_t)MTOT * NUP * 2 + (size_t)MTOT * DFF * 2;
constexpr size_t BIG_Q = 0, BIG_K = 0, BIG_V = 0, BIG_GA = 0, BIG_BE = 0;
constexpr size_t WS_END = WS_BIG + BIG_END;

constexpr int LDS_BYTES = 131072 + 1024 + 4096;
constexpr int MISC_OFF = 131072;

__device__ __forceinline__ unsigned f2bf(float f) { unsigned u = __builtin_bit_cast(unsigned, f); return (u + 0x7fffu + ((u >> 16) & 1u)) >> 16; }
__device__ __forceinline__ float bf2f(unsigned h) { return __builtin_bit_cast(float, h << 16); }
__device__ __forceinline__ unsigned pk2(float lo, float hi) { return cvtpk(lo, hi); }
__device__ __forceinline__ float dpp_add(float v, const int ctrl_sel) {
    int s;
    switch (ctrl_sel) {
        case 0: s = __builtin_amdgcn_update_dpp(0, __builtin_bit_cast(int, v), 0xB1, 0xF, 0xF, true); break;
        case 1: s = __builtin_amdgcn_update_dpp(0, __builtin_bit_cast(int, v), 0x4E, 0xF, 0xF, true); break;
        case 2: s = __builtin_amdgcn_update_dpp(0, __builtin_bit_cast(int, v), 0x141, 0xF, 0xF, true); break;
        default: s = __builtin_amdgcn_update_dpp(0, __builtin_bit_cast(int, v), 0x140, 0xF, 0xF, true); break;
    }
    return v + __builtin_bit_cast(float, s);
}
__device__ __forceinline__ float wave_sum(float v) {
    v = dpp_add(v, 0); v = dpp_add(v, 1); v = dpp_add(v, 2); v = dpp_add(v, 3);
    const int iv = __builtin_bit_cast(int, v);
    const float r0 = __builtin_bit_cast(float, __builtin_amdgcn_readlane(iv, 0)), r1 = __builtin_bit_cast(float, __builtin_amdgcn_readlane(iv, 16));
    const float r2 = __builtin_bit_cast(float, __builtin_amdgcn_readlane(iv, 32)), r3 = __builtin_bit_cast(float, __builtin_amdgcn_readlane(iv, 48));
    return (r0 + r1) + (r2 + r3);
}
__device__ __forceinline__ float silu_f(float x) { return x * __builtin_amdgcn_rcpf(1.f + __expf(-x)); }
__device__ __forceinline__ float sigmoid_f(float x) { return __builtin_amdgcn_rcpf(1.f + __expf(-x)); }
__device__ __forceinline__ float softplus_f(float x) { return x > 20.f ? x : log1pf(expf(x)); }
__device__ __forceinline__ float logsigmoid_f(float x) { return fminf(x, 0.f) - log1pf(expf(-fabsf(x))); }
__device__ __forceinline__ int row_cond(int r) { return r < MCTX ? 0 : 1 + ((r - MCTX) >> 10); }
__device__ __forceinline__ void row_seq(int r, int& seq, int& t, int& T) {
    if (r < MCTX) { seq = r >> 8; t = r & 255; T = 256; } else { seq = 16 + ((r - MCTX) >> 10); t = (r - MCTX) & 1023; T = 1024; }
}
__device__ __forceinline__ int seq_row0(int seq) { return seq < 16 ? seq * 256 : MCTX + (seq - 16) * 1024; }
__device__ __forceinline__ int seq_len(int seq) { return seq < 16 ? 256 : 1024; }

#define XB_TMO      128
#define XB_XCNT(j)  (256  + 64 * (j))
#define XB_XSUB(j)  (1280 + 64 * (j))
#define XB_XGEN(j)  (2304 + 64 * (j))
#define XB_TOP      3328
#define XB_TOPGEN   3392
#define XCD_BAR_WORDS 3456
#define XB_SPIN_CAP (1u << 20)
__device__ __forceinline__ unsigned xb_ld(unsigned* p)              { return __hip_atomic_load(p, __ATOMIC_RELAXED, __HIP_MEMORY_SCOPE_AGENT); }
__device__ __forceinline__ unsigned xb_add(unsigned* p, unsigned v) { return __hip_atomic_fetch_add(p, v, __ATOMIC_RELAXED, __HIP_MEMORY_SCOPE_AGENT); }
__device__ __forceinline__ unsigned xb_xcc_id() { return (unsigned)__builtin_amdgcn_s_getreg((3 << 11) | 20) & 0xFu; }
#define XB_SPIN(cond, bar) do { unsigned _sp = 0; while (cond) { __builtin_amdgcn_s_sleep(1); \
    if ((++_sp & 255u) == 0u) { if (xb_ld(&(bar)[XB_TMO])) break; if (_sp > XB_SPIN_CAP) { atomicAdd(&(bar)[XB_TMO], 1u); break; } } } } while (0)
struct XcdBarrier { unsigned* bar; unsigned x; volatile LAS unsigned* st; };
__device__ __forceinline__ XcdBarrier xcd_barrier_post(unsigned* bar, volatile LAS unsigned* st) {
    XcdBarrier b; b.bar = bar; b.x = xb_xcc_id(); b.st = st;
    if (threadIdx.x == 0) (void)xb_add(&bar[XB_XCNT(b.x)], 1u);
    return b;
}
__device__ __forceinline__ void xcd_barrier_complete(unsigned* bar, unsigned x, unsigned& nloc, unsigned& nx) {
    const unsigned G = gridDim.x * gridDim.y * gridDim.z;
    unsigned sum, cnt, mine, sp = 0u;
    for (;;) {
        sum = 0u; cnt = 0u; mine = 0u;
#pragma unroll
        for (unsigned j = 0; j < 16; ++j) { const unsigned c = xb_ld(&bar[XB_XCNT(j)]); sum += c; cnt += (c > 0u) ? 1u : 0u; mine = (j == x) ? c : mine; }
        if (sum == G) break;
        __builtin_amdgcn_s_sleep(1);
        if ((++sp & 255u) == 0u) { if (xb_ld(&bar[XB_TMO])) break; if (sp > XB_SPIN_CAP) { atomicAdd(&bar[XB_TMO], 1u); break; } }
    }
    nloc = mine > 0u ? mine : 1u; nx = cnt > 0u ? cnt : 1u;
}
__device__ __forceinline__ void xcd_barrier(const XcdBarrier& b) {
    asm volatile("s_waitcnt vmcnt(0)" ::: "memory");
    __syncthreads();
    if (threadIdx.x == 0) {
        unsigned* bar = b.bar;
        __builtin_amdgcn_s_waitcnt(0);
        unsigned nloc = b.st[0], nx = b.st[1];
        if (nloc == 0u) { xcd_barrier_complete(bar, b.x, nloc, nx); b.st[0] = nloc; b.st[1] = nx; }
        const unsigned old = xb_add(&bar[XB_XSUB(b.x)], 1u);
        const unsigned gen = old / nloc;
        if (old + 1u == (gen + 1u) * nloc) {
            __builtin_amdgcn_fence(__ATOMIC_RELEASE, "agent");
            asm volatile("s_waitcnt vmcnt(0)" ::: "memory");
            const unsigned og = xb_add(&bar[XB_TOP], 1u);
            const unsigned tg = og / nx;
            if (og + 1u == (tg + 1u) * nx) xb_add(&bar[XB_TOPGEN], 1u);
            else XB_SPIN(xb_ld(&bar[XB_TOPGEN]) == tg, bar);
            __builtin_amdgcn_fence(__ATOMIC_ACQUIRE, "agent");
            xb_add(&bar[XB_XGEN(b.x)], 1u);
            asm volatile("s_waitcnt vmcnt(0)" ::: "memory");
        } else {
            XB_SPIN(xb_ld(&bar[XB_XGEN(b.x)]) == gen, bar);
            __builtin_amdgcn_fence(__ATOMIC_ACQUIRE, "agent");
            asm volatile("s_waitcnt vmcnt(0)" ::: "memory");
        }
    }
    __syncthreads();
}

namespace pg8 {
typedef short bf16x8 __attribute__((ext_vector_type(8)));
typedef unsigned u32x4 __attribute__((ext_vector_type(4)));
constexpr int BM = 256, BK = 64, HALF = 128, HTB = HALF * BK * 2, STAGE_BYTES = 8 * HTB, NXCD = 8, WGM = 8;
__device__ __forceinline__ int lds_byte(int r, int c) { const int st = (r >> 4) * 2 + (c >> 5), rr = r & 15, cc = c & 31, ob = rr * 64 + cc * 2; return st * 1024 + (ob ^ (((ob >> 9) & 1) << 5)); }
__device__ __forceinline__ void stage_rc(int b, int& R, int& C) { const int st = b / 1024, sb = b % 1024, swz = sb ^ (((sb >> 9) & 1) << 5); R = (st >> 1) * 16 + swz / 64; C = (st & 1) * 32 + (swz % 64) / 2; }
__device__ __forceinline__ int perm32(int rho) { const int n = rho >> 4, i = rho & 15; return 8 * (i >> 2) + 4 * n + (i & 3); }
__device__ __forceinline__ unsigned cvt_pk_bf16(float lo, float hi) { unsigned r; asm volatile("v_cvt_pk_bf16_f32 %0, %1, %2" : "=v"(r) : "v"(lo), "v"(hi)); return r; }

struct Unit { const char* A; const char* B; char* out; int nt, ldc, flag, row0; };
__device__ __forceinline__ bool tile_order(int L, int nM, int nN, int& pm, int& pn) {
    const int nwg = nM * nN; if (L >= nwg || L < 0) return false;
    int wgid = L; { const int q = nwg / NXCD, r = nwg % NXCD, xcd = wgid % NXCD, off = wgid / NXCD; wgid = (xcd < r ? xcd * (q + 1) : r * (q + 1) + (xcd - r) * q) + off; }
    const int nig = WGM * nN, gid = wgid / nig, fm = gid * WGM, gsz = (nM - fm) < WGM ? (nM - fm) : WGM;
    pm = fm + ((wgid % nig) % gsz); pn = (wgid % nig) / gsz; return true;
}
struct SchedPlain {
    int G, c, nM, nN, ns, lda, ldb, ldc, nt, osz, gate_pn, lim; const char* A; const char* B; char* O; size_t osplit;
    __device__ __forceinline__ bool next(int i, Unit& u) const {
        int pm, pq; if (i * G + c >= lim || !tile_order(i * G + c, nM, nN * ns, pm, pq)) return false;
        const int pn = pq % nN, ks = pq / nN;
        u.A = A + ((size_t)pm * 256 * lda + (size_t)ks * nt * 64) * 2; u.B = B + ((size_t)pn * 256 * ldb + (size_t)ks * nt * 64) * 2;
        u.out = O + (size_t)ks * osplit + ((size_t)pm * 256 * ldc + (size_t)pn * 256) * osz; u.nt = nt; u.ldc = ldc; u.flag = (pn == gate_pn) ? 1 : 0; u.row0 = pm * 256; return true;
    }
};
struct EpiF32 {
    static constexpr bool PERM = false;
    __device__ __forceinline__ void operator()(const f32x4 (&acc)[2][2][4][2], const Unit& u, int wr, int wc, int fr, int fq) const {
        char* outp = u.out; asm volatile("" : "+v"(outp)); GAS float* C = (GAS float*)outp; int tl = threadIdx.x; asm volatile("" : "+v"(tl)); fr = tl & 15; fq = (tl >> 4) & 3; const int row0 = wr * 64 + fr; const int col0 = wc * 32 + 4 * fq;
#pragma unroll
        for (int ai = 0; ai < 2; ++ai)
#pragma unroll
            for (int m = 0; m < 4; ++m) { GAS float* rowp = C + (size_t)(row0 + ai * HALF + m * 16) * u.ldc + col0;
#pragma unroll
                for (int bj = 0; bj < 2; ++bj)
#pragma unroll
                    for (int n = 0; n < 2; ++n) *(GAS f32x4*)(rowp + bj * HALF + n * 16) = acc[ai][bj][m][n]; }
    }
};
template <int OFF> __device__ __forceinline__ void st16_wt(GAS u32x4* p, const u32x4& v) { asm volatile("global_store_dwordx4 %0, %1, off offset:%2 sc1\n\ts_nop 1" :: "v"(p), "v"(v), "n"(OFF) : "memory"); }
struct EpiBf16 {
    static constexpr bool PERM = true;
    float* gates;
    __device__ __forceinline__ void operator()(const f32x4 (&acc)[2][2][4][2], const Unit& u, int wr, int wc, int fr, int fq) const {
        int tl = threadIdx.x; asm volatile("" : "+v"(tl)); fr = tl & 15; fq = (tl >> 4) & 3; const int row0 = wr * 64 + fr; const int col0 = wc * 32 + 8 * fq;
        if (u.flag) {
            if (wc == 0) {
#pragma unroll
                for (int ai = 0; ai < 2; ++ai)
#pragma unroll
                    for (int m = 0; m < 4; ++m) { GAS float* gp = (GAS float*)gates + (size_t)(u.row0 + row0 + ai * HALF + m * 16) * 32 + 8 * fq;
                        *(GAS f32x4*)gp = acc[ai][0][m][0]; *(GAS f32x4*)(gp + 4) = acc[ai][0][m][1]; }
            }
            return;
        }
        char* outp = u.out; asm volatile("" : "+v"(outp)); GAS bf16_t* O = (GAS bf16_t*)outp;
#pragma unroll
        for (int ai = 0; ai < 2; ++ai)
#pragma unroll
            for (int m = 0; m < 4; ++m) { GAS bf16_t* rowp = O + (size_t)(row0 + ai * HALF + m * 16) * u.ldc + col0;
#pragma unroll
                for (int bj = 0; bj < 2; ++bj) { const f32x4 v0 = acc[ai][bj][m][0], v1 = acc[ai][bj][m][1];
                    u32x4 w; w.x = cvt_pk_bf16(v0[0], v0[1]); w.y = cvt_pk_bf16(v0[2], v0[3]); w.z = cvt_pk_bf16(v1[0], v1[1]); w.w = cvt_pk_bf16(v1[2], v1[3]);
                    if (bj == 0) st16_wt<0>((GAS u32x4*)rowp, w); else st16_wt<HALF * 2>((GAS u32x4*)rowp, w); } }
    }
};

template <bool PERM>
__device__ __forceinline__ void prestage_B(LAS unsigned char* lds, const char* B, int ldb) {
    const int tid = threadIdx.x, wid = __builtin_amdgcn_readfirstlane(tid >> 6), lane = tid & 63;
    if (wid == 0 || B == nullptr) return;
    const size_t hstepB = (size_t)HALF * ldb * 2;
#pragma unroll 1
    for (int pass = 0; pass < (wid == 1 ? 2 : 1); ++pass) { const int vw = pass ? 0 : wid; const unsigned ldsw = (unsigned)vw * 1024u;
#pragma unroll
        for (int i = 0; i < 2; ++i) { int R, C; stage_rc((vw * 64 + lane) * 16 + i * 8192, R, C); const int Rb = PERM ? ((R & ~31) + perm32(R & 31)) : R;
            const char* src = B + (unsigned)(Rb * ldb + C) * 2u;
            __builtin_amdgcn_global_load_lds((const unsigned*)src, (LAS unsigned*)(lds + (4 + 0) * HTB + ldsw + i * 8192), 16, 0, 0);
            __builtin_amdgcn_global_load_lds((const unsigned*)(src + hstepB), (LAS unsigned*)(lds + (4 + 1) * HTB + ldsw + i * 8192), 16, 0, 0);
            __builtin_amdgcn_global_load_lds((const unsigned*)(src + BK * 2), (LAS unsigned*)(lds + (4 + 2) * HTB + ldsw + i * 8192), 16, 0, 0);
            __builtin_amdgcn_global_load_lds((const unsigned*)(src + hstepB + BK * 2), (LAS unsigned*)(lds + (4 + 3) * HTB + ldsw + i * 8192), 16, 0, 0); } }
}
template <class Epi, class Sched, bool PRE = false>
__device__ __forceinline__ void gemm_phase(LAS unsigned char* lds, int lda, int ldb, const Sched& S, const Epi& E) {
    const int tid = threadIdx.x, wid = __builtin_amdgcn_readfirstlane(tid >> 6), lane = tid & 63, wr = wid >> 2, wc = wid & 3, fr = lane & 15, fq = lane >> 4;
    unsigned voffA[2], voffB[2];
#pragma unroll
    for (int i = 0; i < 2; ++i) { int R, C; stage_rc(tid * 16 + i * 8192, R, C); const int Rb = Epi::PERM ? ((R & ~31) + perm32(R & 31)) : R;
        voffA[i] = (unsigned)(R * lda + C) * 2u; voffB[i] = (unsigned)(Rb * ldb + C) * 2u; }
    const size_t kstep = (size_t)(BK * 2);
    const size_t hstepA = (size_t)HALF * lda * 2, hstepB = (size_t)HALF * ldb * 2;
    const unsigned ldsw = (unsigned)wid * 1024u;
    const int aoff = lds_byte(wr * 64 + fr, fq * 8), boff = lds_byte(wc * 32 + fr, fq * 8);
#define PG8_SA(b, h) (((b) * 2 + (h)) * HTB)
#define PG8_SB(b, h) ((4 + (b) * 2 + (h)) * HTB)
#define PG8_STAGE(bufoff, gbase, voff) do { _Pragma("unroll") for (int _i = 0; _i < 2; ++_i) \
        __builtin_amdgcn_global_load_lds((const unsigned*)((const char*)(gbase) + (voff)[_i]), (LAS unsigned*)(lds + (bufoff) + ldsw + _i * 8192), 16, 0, 0); } while (0)
#define PG8_LDA(dst, b, h) do { _Pragma("unroll") for (int m = 0; m < 4; ++m) _Pragma("unroll") for (int k = 0; k < 2; ++k) dst[m][k] = *(const LAS bf16x8*)(lds + PG8_SA(b, h) + aoff + m * 2048 + k * 1024); } while (0)
#define PG8_LDB(dst, b, h) do { _Pragma("unroll") for (int n = 0; n < 2; ++n) _Pragma("unroll") for (int k = 0; k < 2; ++k) dst[n][k] = *(const LAS bf16x8*)(lds + PG8_SB(b, h) + boff + n * 2048 + k * 1024); } while (0)
#define PG8_MMA(ai, bj, At, Bt) do { __builtin_amdgcn_s_setprio(1); _Pragma("unroll") for (int m = 0; m < 4; ++m) _Pragma("unroll") for (int n = 0; n < 2; ++n) _Pragma("unroll") for (int k = 0; k < 2; ++k) \
        acc[ai][bj][m][n] = __builtin_amdgcn_mfma_f32_16x16x32_bf16(Bt[n][k], At[m][k], acc[ai][bj][m][n], 0, 0, 0); __builtin_amdgcn_s_setprio(0); } while (0)
#define PG8_WAIT_V(n) asm volatile("s_waitcnt vmcnt(" #n ")" ::: "memory")
#define PG8_WAIT_L(n) asm volatile("s_waitcnt lgkmcnt(" #n ")" ::: "memory")
#define PG8_BAR __builtin_amdgcn_s_barrier()
#define PG8_SCHED __builtin_amdgcn_sched_barrier(0)
    Unit cur, nxt; int ui = 0;
    if (!S.next(0, cur)) return;
    f32x4 acc[2][2][4][2];
#pragma unroll
    for (int a = 0; a < 2; ++a)
#pragma unroll
        for (int b = 0; b < 2; ++b)
#pragma unroll
            for (int m = 0; m < 4; ++m)
#pragma unroll
                for (int n = 0; n < 2; ++n) acc[a][b][m][n] = (f32x4){0.f, 0.f, 0.f, 0.f};
    bf16x8 At[4][2], B0[2][2], B1[2][2];
    const char* cA = cur.A; const char* cB = cur.B; int nt = cur.nt;
    if constexpr (PRE) {
        PG8_STAGE(PG8_SA(0, 0), cA, voffA); PG8_STAGE(PG8_SA(0, 1), cA + hstepA, voffA);
        if (wr == 1) PG8_BAR;
        PG8_WAIT_V(2); PG8_BAR;
        PG8_STAGE(PG8_SA(1, 0), cA + kstep, voffA);
        PG8_WAIT_V(2); PG8_BAR;
    } else {
    PG8_STAGE(PG8_SB(0, 0), cB, voffB); PG8_STAGE(PG8_SB(0, 1), cB + hstepB, voffB); PG8_STAGE(PG8_SA(0, 0), cA, voffA); PG8_STAGE(PG8_SA(0, 1), cA + hstepA, voffA);
    if (wr == 1) PG8_BAR;
    PG8_WAIT_V(2); PG8_BAR;
    PG8_STAGE(PG8_SB(1, 0), cB + kstep, voffB); PG8_STAGE(PG8_SA(1, 0), cA + kstep, voffA); PG8_STAGE(PG8_SB(1, 1), cB + hstepB + kstep, voffB);
    PG8_WAIT_V(6); PG8_BAR;
    }
    for (;;) {
        const bool has_next = S.next(ui + 1, nxt);
        const char* nA = has_next ? nxt.A : cA; const char* nB = has_next ? nxt.B : cB;
        for (int t = 0; t < nt; t += 2) {
            const bool last = (t == nt - 2);
            const char* a1 = cA + (size_t)(t + 1) * kstep;
            const char* a2 = last ? nA : cA + (size_t)(t + 2) * kstep; const char* b2 = last ? nB : cB + (size_t)(t + 2) * kstep;
            const char* a3 = a2 + kstep; const char* b3 = b2 + kstep;
            PG8_LDB(B0, 0, 0); PG8_LDB(B1, 0, 1); PG8_SCHED; PG8_LDA(At, 0, 0); PG8_STAGE(PG8_SA(1, 1), a1 + hstepA, voffA);
            PG8_WAIT_V(8); PG8_WAIT_L(0); PG8_BAR; PG8_MMA(0, 0, At, B0); PG8_MMA(0, 1, At, B1); PG8_BAR; PG8_SCHED;
            PG8_LDA(At, 0, 1); PG8_STAGE(PG8_SB(0, 0), b2, voffB); PG8_STAGE(PG8_SB(0, 1), b2 + hstepB, voffB); PG8_STAGE(PG8_SA(0, 0), a2, voffA);
            PG8_WAIT_V(8); PG8_WAIT_L(0); PG8_BAR; PG8_MMA(1, 0, At, B0); PG8_MMA(1, 1, At, B1); PG8_BAR; PG8_SCHED;
            PG8_LDB(B0, 1, 0); PG8_LDB(B1, 1, 1); PG8_SCHED; PG8_LDA(At, 1, 0); PG8_STAGE(PG8_SA(0, 1), a2 + hstepA, voffA);
            PG8_WAIT_V(8); PG8_WAIT_L(0); PG8_BAR; PG8_MMA(0, 0, At, B0); PG8_MMA(0, 1, At, B1); PG8_BAR; PG8_SCHED;
            PG8_LDA(At, 1, 1); PG8_STAGE(PG8_SB(1, 0), b3, voffB); PG8_STAGE(PG8_SB(1, 1), b3 + hstepB, voffB); PG8_STAGE(PG8_SA(1, 0), a3, voffA);
            PG8_WAIT_V(8); PG8_WAIT_L(0); PG8_BAR; PG8_MMA(1, 0, At, B0); PG8_MMA(1, 1, At, B1); PG8_BAR; PG8_SCHED;
        }
        if (wr == 0) PG8_BAR;
        E(acc, cur, wr, wc, fr, fq);
        if (!has_next) break;
#pragma unroll
        for (int a = 0; a < 2; ++a)
#pragma unroll
            for (int b = 0; b < 2; ++b)
#pragma unroll
                for (int m = 0; m < 4; ++m)
#pragma unroll
                    for (int n = 0; n < 2; ++n) acc[a][b][m][n] = (f32x4){0.f, 0.f, 0.f, 0.f};
        cur = nxt; cA = nA; cB = nB; nt = cur.nt; ++ui;
        if (wr == 1) PG8_BAR;
    }
    PG8_WAIT_V(0);
    PG8_BAR;
#undef PG8_SA
#undef PG8_SB
#undef PG8_STAGE
#undef PG8_LDA
#undef PG8_LDB
#undef PG8_MMA
#undef PG8_WAIT_V
#undef PG8_WAIT_L
#undef PG8_BAR
#undef PG8_SCHED
}
}

__device__ __forceinline__ void xcd_barrier_pre(const XcdBarrier& b, LAS unsigned char* lds, const char* B, int ldb) {
    asm volatile("s_waitcnt vmcnt(0)" ::: "memory");
    __syncthreads();
    pg8::prestage_B<true>(lds, B, ldb);
    if (threadIdx.x == 0) {
        unsigned* bar = b.bar;
        __builtin_amdgcn_s_waitcnt(0);
        unsigned nloc = b.st[0], nx = b.st[1];
        if (nloc == 0u) { xcd_barrier_complete(bar, b.x, nloc, nx); b.st[0] = nloc; b.st[1] = nx; }
        const unsigned old = xb_add(&bar[XB_XSUB(b.x)], 1u);
        const unsigned gen = old / nloc;
        if (old + 1u == (gen + 1u) * nloc) {
            __builtin_amdgcn_fence(__ATOMIC_RELEASE, "agent");
            asm volatile("s_waitcnt vmcnt(0)" ::: "memory");
            const unsigned og = xb_add(&bar[XB_TOP], 1u);
            const unsigned tg = og / nx;
            if (og + 1u == (tg + 1u) * nx) xb_add(&bar[XB_TOPGEN], 1u);
            else XB_SPIN(xb_ld(&bar[XB_TOPGEN]) == tg, bar);
            __builtin_amdgcn_fence(__ATOMIC_ACQUIRE, "agent");
            xb_add(&bar[XB_XGEN(b.x)], 1u);
            asm volatile("s_waitcnt vmcnt(0)" ::: "memory");
        } else {
            XB_SPIN(xb_ld(&bar[XB_XGEN(b.x)]) == gen, bar);
            __builtin_amdgcn_fence(__ATOMIC_ACQUIRE, "agent");
            asm volatile("s_waitcnt vmcnt(0)" ::: "memory");
        }
    }
    __syncthreads();
}
struct Args { const float* in[N_IN]; float* out; unsigned char* ws; int ph_lo, ph_hi; };
constexpr int PTR_OFF = MISC_OFF + 256;
struct Frame {
    float* out; unsigned char* ws; LAS unsigned char* lds;
    int tid, lane, wave, G, wg;
    __device__ __forceinline__ const float* inp(int i) const {
        const unsigned long long v = ((const LAS unsigned long long*)(lds + PTR_OFF))[i];
        const unsigned lo = __builtin_amdgcn_readfirstlane((unsigned)v), hi = __builtin_amdgcn_readfirstlane((unsigned)(v >> 32));
        return (const float*)(const __attribute__((address_space(1))) float*)(((unsigned long long)hi << 32) | lo); }
    __device__ __forceinline__ float* mod_() const { return (float*)(ws + WS_MOD); }
    __device__ __forceinline__ bf16_t* X_() const { return (bf16_t*)(ws + WS_X); }
    __device__ __forceinline__ bf16_t* H_() const { return (bf16_t*)(ws + WS_H); }
    __device__ __forceinline__ unsigned char* slab_() const { return ws + WS_SLAB; }
    __device__ __forceinline__ unsigned char* big_() const { return ws + WS_BIG; }
    __device__ __forceinline__ unsigned char* tab_() const { return ws + WS_TAB; }
    __device__ __forceinline__ unsigned char* wt_() const { return ws + WS_WT; }
};

typedef short bf16x8_t __attribute__((ext_vector_type(8)));
typedef short bf16x4_t __attribute__((ext_vector_type(4)));
__device__ __forceinline__ bf16x8_t frag_nat(const LAS bf16_t* base, int pitch, int row, int k0, int g) { return *(const LAS bf16x8_t*)(base + row * pitch + k0 + 8 * g); }
__device__ __forceinline__ bf16x8_t frag_perm(const LAS bf16_t* base, int pitch, int row, int kb, int g) {
    const bf16x4_t lo = *(const LAS bf16x4_t*)(base + row * pitch + kb + 4 * g), hi = *(const LAS bf16x4_t*)(base + row * pitch + kb + 16 + 4 * g);
    return __builtin_shufflevector(lo, hi, 0, 1, 2, 3, 4, 5, 6, 7);
}
__device__ __forceinline__ int rowp(int t, int r) { return 32 * (t >> 1) + 8 * (r >> 2) + 4 * (t & 1) + (r & 3); }
__device__ __forceinline__ bf16x8_t frag_sw(const LAS bf16_t* base, int pitch, int row, int kc, int g) { return *(const LAS bf16x8_t*)(base + row * pitch + (((kc + g) ^ (((row >> 4) & 1) << 2)) << 3)); }
__device__ __forceinline__ bf16x8_t pack_acc(const f32x4& a, const f32x4& b) {
    typedef unsigned u32x4_t __attribute__((ext_vector_type(4)));
    u32x4_t w; w.x = cvtpk(a[0], a[1]); w.y = cvtpk(a[2], a[3]); w.z = cvtpk(b[0], b[1]); w.w = cvtpk(b[2], b[3]);
    return __builtin_bit_cast(bf16x8_t, w);
}
#define MFMA16(a, b, c) __builtin_amdgcn_mfma_f32_16x16x32_bf16((a), (b), (c), 0, 0, 0)
__device__ __forceinline__ f32x4 up4(const u2v& u) { return (f32x4){__builtin_bit_cast(float, u.x << 16), __builtin_bit_cast(float, u.x & 0xffff0000u), __builtin_bit_cast(float, u.y << 16), __builtin_bit_cast(float, u.y & 0xffff0000u)}; }
__device__ __forceinline__ u2v pk4(const f32x4& v) { u2v o; o.x = cvtpk(v[0], v[1]); o.y = cvtpk(v[2], v[3]); return o; }

__device__ __forceinline__ const bf16_t* slab_ptr(Frame& F, int s) {
    return s < 2 ? (const bf16_t*)(F.slab_() + (size_t)s * SLAB_FULL) : (const bf16_t*)(F.slab_() + 2 * SLAB_FULL + (size_t)(s - 2) * SLAB_SMP) - (size_t)MCTX * D;
}
__device__ __forceinline__ void st4_wt(void* p, unsigned v) { asm volatile("global_store_dword %0, %1, off sc1" :: "v"((GAS void*)p), "v"(v) : "memory"); }
__device__ __forceinline__ void st16f_wt(void* p, const f32x4& v) { asm volatile("global_store_dwordx4 %0, %1, off sc1\n\ts_nop 1" :: "v"((GAS void*)p), "v"(v) : "memory"); }
__device__ __forceinline__ void st8_wt(void* p, const u2v& v) { asm volatile("global_store_dwordx2 %0, %1, off sc1" :: "v"((GAS void*)p), "v"(v) : "memory"); }
__device__ __forceinline__ void st16_wt(void* p, const u4v& v) { asm volatile("global_store_dwordx4 %0, %1, off sc1\n\ts_nop 1" :: "v"((GAS void*)p), "v"(v) : "memory"); }
__device__ __forceinline__ void p0_transpose_item(const float* W, int K, int N, bf16_t* WT, LAS float* scr, int item, int lane, bool up_il = false) {
    const int nblk = N / 32, kb = item / nblk, nb = item % nblk, k0 = 64 * kb, n0 = 32 * nb;
#pragma unroll
    for (int i = 0; i < 32; ++i) { const int kk = 2 * i + (lane >> 5); scr[kk * 33 + (lane & 31)] = W[(size_t)(k0 + kk) * N + n0 + (lane & 31)]; }
    asm volatile("s_waitcnt lgkmcnt(0)" ::: "memory");
    const int c = lane & 7;
#pragma unroll
    for (int j = 0; j < 4; ++j) { const int n = (lane >> 3) + 8 * j; const LAS float* s = scr + (8 * c) * 33 + n;
        u4v o; o.x = pk2(s[0 * 33], s[1 * 33]); o.y = pk2(s[2 * 33], s[3 * 33]); o.z = pk2(s[4 * 33], s[5 * 33]); o.w = pk2(s[6 * 33], s[7 * 33]);
        int orow = n0 + n; if (up_il) { const int gte = orow >= DFF ? 1 : 0, ch = orow - gte * DFF; orow = (ch >> 7) * 256 + gte * 128 + (ch & 127); }
        st16_wt(WT + (size_t)orow * K + k0 + 8 * c, o); }
    asm volatile("s_waitcnt lgkmcnt(0)" ::: "memory");
}
__device__ __forceinline__ void ph_prologue(Frame& F) {
    const int lane = F.lane;
    const float* c_smp = F.inp(I_C); const float* c_ctx = F.inp(I_CCTX);
    for (int task = F.wg; task < 4 * 48; task += F.G) {
        const int l = task / 48, cc = task % 48, col = cc * 128 + lane * 2;
        const float* W = F.inp(I_WADA) + (size_t)l * D * 6144 + col;
        float acc[3][2] = {};
#pragma unroll 16
        for (int k = F.wave * 128; k < F.wave * 128 + 128; ++k) {
            const f32x2 w = *(const f32x2*)(W + (size_t)k * 6144);
            const float s0 = silu_f(c_ctx[k]), s1 = silu_f(c_smp[k]), s2 = silu_f(c_smp[D + k]);
            acc[0][0] += s0 * w[0]; acc[0][1] += s0 * w[1]; acc[1][0] += s1 * w[0]; acc[1][1] += s1 * w[1]; acc[2][0] += s2 * w[0]; acc[2][1] += s2 * w[1];
        }
        LAS float* red = (LAS float*)(F.lds + 8 * 8448);
        __syncthreads();
#pragma unroll
        for (int c = 0; c < 3; ++c) { red[(F.wave * 3 + c) * 128 + lane * 2] = acc[c][0]; red[(F.wave * 3 + c) * 128 + lane * 2 + 1] = acc[c][1]; }
        __syncthreads();
        if (F.tid < 384) { const int c = F.tid >> 7, j = F.tid & 127; float v = F.inp(I_BADA)[l * 6144 + cc * 128 + j];
#pragma unroll
            for (int w = 0; w < 8; ++w) v += red[(w * 3 + c) * 128 + j];
            F.mod_()[((size_t)l * 3 + c) * 6144 + cc * 128 + j] = v; }
    }
    {
        LAS float* scr = (LAS float*)(F.lds + F.wave * 8448);
        const int gw = F.wg * NWAVES + F.wave, NGW = F.G * NWAVES;
        constexpr int I_UP = 16 * 176, I_DNW = 44 * 32, I_FWT = 16 * 32, I_DIN = 16 * 129, I_MIN = 16 * 97;
        constexpr int NITEMS = 4 * I_UP + 4 * I_DNW + 2 * I_FWT + I_DIN + I_FWT + I_MIN + I_FWT;
        for (int it = gw; it < NITEMS; it += NGW) {
            int r = it;
            if (r < 4 * I_UP) { const int l = r / I_UP; p0_transpose_item(F.inp(I_WUP) + (size_t)l * D * NUP, D, NUP, (bf16_t*)(F.wt_() + WT_UP) + (size_t)l * NUP * D, scr, r % I_UP, lane, true); continue; } r -= 4 * I_UP;
            if (r < 4 * I_DNW) { const int l = r / I_DNW; p0_transpose_item(F.inp(I_WDN) + (size_t)l * DFF * D, DFF, D, (bf16_t*)(F.wt_() + WT_DN) + (size_t)l * D * DFF, scr, r % I_DNW, lane); continue; } r -= 4 * I_DNW;
            if (r < 2 * I_FWT) { const int j = r / I_FWT; p0_transpose_item(F.inp(I_FW) + (size_t)j * D * D, D, D, (bf16_t*)(F.wt_() + WT_F) + (size_t)j * D * D, scr, r % I_FWT, lane); continue; } r -= 2 * I_FWT;
            if (r < I_DIN) { p0_transpose_item(F.inp(I_DWIN), D, DN_PROJ, (bf16_t*)(F.wt_() + WT_DIN), scr, r, lane); continue; } r -= I_DIN;
            if (r < I_FWT) { p0_transpose_item(F.inp(I_DWOUT), D, D, (bf16_t*)(F.wt_() + WT_DOUT), scr, r, lane); continue; } r -= I_FWT;
            if (r < I_MIN) { p0_transpose_item(F.inp(I_MWIN), D, ML_PROJ, (bf16_t*)(F.wt_() + WT_MIN), scr, r, lane); continue; } r -= I_MIN;
            p0_transpose_item(F.inp(I_MWOUT), D, D, (bf16_t*)(F.wt_() + WT_MOUT), scr, r, lane);
        }
    }
    const int gt = F.wg * NTHR + F.tid, NGT = F.G * NTHR;
    bf16_t* cs256 = (bf16_t*)(F.tab_() + TAB_CS256); bf16_t* cst256 = (bf16_t*)(F.tab_() + TAB_CST256); bf16_t* cst1024 = (bf16_t*)(F.tab_() + TAB_CST1024);
    for (int i = gt; i < 256 * 256; i += NGT) { const int a = i >> 8, b = i & 255; const int m = (a * b) & 255; float s, c; sincospif(2.0f * (float)m / 256.0f, &s, &c);
        cs256[a * 256 + b] = (bf16_t)f2bf(c); cs256[(256 + a) * 256 + b] = (bf16_t)f2bf(s); cst256[a * 512 + b] = (bf16_t)f2bf(c); cst256[a * 512 + 256 + b] = (bf16_t)f2bf(-s); }
    for (int i = gt; i < 1024 * 1024; i += NGT) { const int a = i >> 10, b = i & 1023; const int m = (a * b) & 1023; float s, c; sincospif(2.0f * (float)m / 1024.0f, &s, &c);
        cst1024[a * 2048 + b] = (bf16_t)f2bf(c); cst1024[a * 2048 + 1024 + b] = (bf16_t)f2bf(-s); }
}
struct SchedWcs { int G, c, nun; const char* WT; const char* CS; char* O;
    __device__ __forceinline__ bool next(int i, pg8::Unit& u) const { const int L = i * G + c; if (L >= nun) return false;
        const int j = L >> 5, cs = (L >> 4) & 1, pm = (L >> 2) & 3, g = L & 3;
        u.A = WT + (size_t)j * D * D * 2 + ((size_t)pm * 256 * D + g * 256) * 2; u.B = CS + (size_t)cs * 256 * 256 * 2;
        u.out = O + (size_t)j * 2048 * D * 2 + ((size_t)(cs * 1024 + pm * 256) * D + g * 256) * 2; u.nt = 4; u.ldc = D; u.flag = 0; u.row0 = 0; return true; } };
__device__ __forceinline__ void ph_wcs(Frame& F) {
    int nun = 64; asm volatile("" : "+s"(nun));
    SchedWcs S{F.G, F.wg, nun, (const char*)(F.wt_() + WT_F), (const char*)(F.tab_() + TAB_CS256), (char*)(F.wt_() + WT_CS)};
    pg8::EpiBf16 E{nullptr};
    pg8::gemm_phase(F.lds, D, 256, S, E);
}

__device__ __forceinline__ void ph_norm(Frame& F, int pl, int pgj, const float* pbias, int nsc, int nss, float sc_ctx, float sc_smp, int nl, int nsh, const float* nw, bool first = false, int wg0 = 0) {
    const int gw = F.wg >= wg0 ? (F.wg - wg0) * NWAVES + F.wave : MTOT, NGW = (F.G - wg0) * NWAVES, lane = F.lane;
    const float* xin_p = F.inp(I_XP); const float* xin_s = F.inp(I_XS);
    const bf16_t* s0 = slab_ptr(F, 0); const bf16_t* s1 = slab_ptr(F, 1); const bf16_t* s2 = slab_ptr(F, 2); const bf16_t* s3 = slab_ptr(F, 3);
    auto ld4 = [](const bf16_t* p) { const u2v u = *(const u2v*)p; return (f32x4){__builtin_bit_cast(float, u.x << 16), __builtin_bit_cast(float, u.x & 0xffff0000u), __builtin_bit_cast(float, u.y << 16), __builtin_bit_cast(float, u.y & 0xffff0000u)}; };
    constexpr int RU = 3;
    for (int rb = gw; rb < MTOT; rb += RU * NGW) {
        f32x4 v[RU][4], sl[RU][4];
#pragma unroll
        for (int q = 0; q < RU; ++q) { const int row = rb + q * NGW; const bool ok = row < MTOT; const int ns = row < MCTX ? nsc : nss;
#pragma unroll
            for (int j = 0; j < 4; ++j) { const size_t o = (size_t)(ok ? row : 0) * D + 4 * lane + 256 * j;
                v[q][j] = first ? ((ok ? row : 0) < MCTX ? *(const f32x4*)(xin_p + o) : *(const f32x4*)(xin_s + o - (size_t)MCTX * D)) : ld4(F.X_() + o);
                if (pl >= 0) { f32x4 s = ld4(s0 + o);
                    if (ns > 1) s = s + ld4(s1 + o);
                    if (ns > 2) s = s + ld4(s2 + o) + ld4(s3 + o);
                    sl[q][j] = s; } } }
#pragma unroll
        for (int q = 0; q < RU; ++q) { const int row = rb + q * NGW; if (row >= MTOT) continue;
            const int cond = row_cond(row); const float scl = row < MCTX ? sc_ctx : sc_smp;
            float ss = 0.f;
#pragma unroll
            for (int j = 0; j < 4; ++j) { const int col = 4 * lane + 256 * j; const size_t o = (size_t)row * D + col;
                f32x4 x = v[q][j];
                if (pl >= 0) {
                    const f32x4 g = *(const f32x4*)(F.mod_() + ((size_t)pl * 3 + cond) * 6144 + pgj * D + col);
                    f32x4 s = sl[q][j] * scl;
                    if (pbias) s = s + *(const f32x4*)(pbias + col);
                    x = x + g * s;
                    st8_wt(F.X_() + o, pk4(x));
                }
                if (first) st8_wt(F.X_() + o, pk4(x));
                v[q][j] = x; ss += (x[0] * x[0] + x[1] * x[1]) + (x[2] * x[2] + x[3] * x[3]); }
            const float rstd = rsqrtf(wave_sum(ss) * (1.f / D) + EPS);
#pragma unroll
            for (int j = 0; j < 4; ++j) { const int col = 4 * lane + 256 * j;
                const f32x4 w = *(const f32x4*)(nw + col);
                f32x4 y = v[q][j] * rstd * w;
                if (nl >= 0) {
                    const float* m = F.mod_() + ((size_t)nl * 3 + cond) * 6144 + nsh * D + col;
                    const f32x4 sh = *(const f32x4*)m, sc = *(const f32x4*)(m + D);
                    y = y * (sc + 1.f) + sh;
                    u2v o; o.x = cvtpk(y[0], y[1]); o.y = cvtpk(y[2], y[3]);
                    st8_wt(F.H_() + (size_t)row * D + col, o);
                } else st16f_wt(F.out + O_Y + (size_t)row * D + col, y);
            }
        }
    }
}

__device__ __forceinline__ pg8::SchedPlain mk_plain(Frame& F, const void* A, int lda, const void* Bt, int ldb, int nN, int ns, int nt, void* O, int ldc, int osz, size_t osplit, int gate_pn) {
    pg8::SchedPlain S; S.G = F.G; S.c = F.wg; S.nM = 24; S.nN = nN; S.ns = ns; S.lda = lda; S.ldb = ldb; S.ldc = ldc; S.nt = nt; S.osz = osz; S.gate_pn = gate_pn;
    S.A = (const char*)A; S.B = (const char*)Bt; S.O = (char*)O; S.osplit = osplit; S.lim = 1 << 30; return S;
}
__device__ __forceinline__ void gemm64(Frame& F, const bf16_t* A, int lda, const bf16_t* Bt, int ldb, bf16_t* C, int ldc) {
    LAS bf16_t* LA = (LAS bf16_t*)F.lds; LAS bf16_t* LB = LA + 64 * 264;
    const int tid = F.tid, lane = F.lane, w = F.wave, r = lane & 15, g = lane >> 4, wr = w >> 1, wc = w & 1;
    u4v ra[4][4], rb[4][4];
#pragma unroll
    for (int kc = 0; kc < 4; ++kc)
#pragma unroll
        for (int i = 0; i < 4; ++i) { const int idx = tid + 512 * i, row = idx >> 5, pc = idx & 31;
            ra[kc][i] = *(const u4v*)(A + (size_t)row * lda + kc * 256 + pc * 8); rb[kc][i] = *(const u4v*)(Bt + (size_t)row * ldb + kc * 256 + pc * 8); }
    f32x4 acc0 = (f32x4){0.f, 0.f, 0.f, 0.f}, acc1 = (f32x4){0.f, 0.f, 0.f, 0.f};
#pragma unroll
    for (int kc = 0; kc < 4; ++kc) {
        __syncthreads();
#pragma unroll
        for (int i = 0; i < 4; ++i) { const int idx = tid + 512 * i, row = idx >> 5, pc = idx & 31; *(LAS u4v*)(LA + row * 264 + pc * 8) = ra[kc][i]; *(LAS u4v*)(LB + row * 264 + pc * 8) = rb[kc][i]; }
        __syncthreads();
#pragma unroll
        for (int kk = 0; kk < 8; ++kk) { const bf16x8_t a = frag_nat(LA, 264, 16 * wr + r, 32 * kk, g);
            acc0 = MFMA16(frag_nat(LB, 264, 32 * wc + r, 32 * kk, g), a, acc0); acc1 = MFMA16(frag_nat(LB, 264, 32 * wc + 16 + r, 32 * kk, g), a, acc1); }
    }
    bf16_t* cp = C + (size_t)(16 * wr + r) * ldc + 32 * wc + 4 * g;
    *(u2v*)cp = pk4(acc0); *(u2v*)(cp + 16) = pk4(acc1);
    __syncthreads();
}
constexpr int XR_OFF = MISC_OFF + 1024;
struct SchedUp { int G, c, lim; const char* A; const char* B; char* UGp; char* ACTp;
    __device__ __forceinline__ bool next(int i, pg8::Unit& u) const { const int L = i * G + c; if (L >= lim) return false; int pm, pn;
        if (L < 352) pg8::tile_order(L, 16, 22, pm, pn); else { pg8::tile_order(L - 352, 8, 22, pm, pn); pm += 16; }
        u.A = A + (size_t)pm * 256 * D * 2; u.B = B + (size_t)pn * 256 * D * 2; u.nt = 16; u.row0 = pm * 256;
        if (pm < 16) { u.flag = 2 + pn * 4; u.out = ACTp + ((size_t)pm * 256 * DFF + pn * 128) * 2; u.ldc = DFF; }
        else { u.flag = 0; u.out = UGp + ((size_t)pm * 256 * NUP + pn * 128) * 2; u.ldc = NUP; }
        return true; } };
__device__ __forceinline__ float dpp_ror1(float v) { return __builtin_bit_cast(float, __builtin_amdgcn_update_dpp(0, __builtin_bit_cast(int, v), 0x121, 0xF, 0xF, false)); }
__device__ __forceinline__ float dpp_ror15(float v) { return __builtin_bit_cast(float, __builtin_amdgcn_update_dpp(0, __builtin_bit_cast(int, v), 0x12F, 0xF, 0xF, false)); }
struct EpiUp {
    static constexpr bool PERM = true;
    const float* cw; const float* cb; LAS unsigned char* lds;
    __device__ __forceinline__ void operator()(f32x4 (&acc)[2][2][4][2], const pg8::Unit& u, int wr, int wc, int fr, int fq) const {
        char* outp = u.out; asm volatile("" : "+v"(outp)); int tl = threadIdx.x; asm volatile("" : "+v"(tl)); fr = tl & 15; fq = (tl >> 4) & 3;
        const int row0 = wr * 64 + fr, col0 = wc * 32 + 8 * fq;
        GAS bf16_t* O = (GAS bf16_t*)outp;
        if ((u.flag & 3) == 0) {
#pragma unroll
            for (int ai = 0; ai < 2; ++ai)
#pragma unroll
                for (int m = 0; m < 4; ++m) { GAS bf16_t* rowp = O + (size_t)(row0 + ai * 128 + m * 16) * u.ldc + col0;
#pragma unroll
                    for (int bj = 0; bj < 2; ++bj) { const f32x4 v0 = acc[ai][bj][m][0], v1 = acc[ai][bj][m][1];
                        pg8::u32x4 w; w.x = cvtpk(v0[0], v0[1]); w.y = cvtpk(v0[2], v0[3]); w.z = cvtpk(v1[0], v1[1]); w.w = cvtpk(v1[2], v1[3]);
                        pg8::st16_wt<0>((GAS pg8::u32x4*)(rowp + bj * DFF), w); } }
            return;
        }
        const int pn = u.flag >> 2, ch0 = pn * 128 + col0;
        LAS float* XR = (LAS float*)(lds + XR_OFF);
#pragma unroll
        for (int ai = 0; ai < 2; ++ai) {
            if (fr == 0) { LAS float* p = XR + (((wr * 4 + wc) * 2 + ai) * 2 + 0) * 32 + 8 * fq; *(LAS f32x4*)p = acc[ai][1][0][0]; *(LAS f32x4*)(p + 4) = acc[ai][1][0][1]; }
            if (fr == 15) { LAS float* p = XR + (((wr * 4 + wc) * 2 + ai) * 2 + 1) * 32 + 8 * fq; *(LAS f32x4*)p = acc[ai][1][3][0]; *(LAS f32x4*)(p + 4) = acc[ai][1][3][1]; } }
        asm volatile("s_waitcnt lgkmcnt(0)" ::: "memory"); __builtin_amdgcn_s_barrier(); asm volatile("" ::: "memory");
#pragma unroll
        for (int ai = 0; ai < 2; ++ai) {
            const int wrp = 1 - wr, aip = wr ? ai : ai - 1, ain = wr ? ai + 1 : ai;
            f32x4 bp[2], bn[2];
#pragma unroll
            for (int n = 0; n < 2; ++n) {
                bp[n] = aip >= 0 ? *(const LAS f32x4*)(XR + (((wrp * 4 + wc) * 2 + aip) * 2 + 1) * 32 + 8 * fq + 4 * n) : (f32x4){0.f, 0.f, 0.f, 0.f};
                bn[n] = ain <= 1 ? *(const LAS f32x4*)(XR + (((wrp * 4 + wc) * 2 + ain) * 2 + 0) * 32 + 8 * fq + 4 * n) : (f32x4){0.f, 0.f, 0.f, 0.f}; }
#pragma unroll
            for (int n = 0; n < 2; ++n) {
                const f32x4 w0 = *(const f32x4*)(cw + 3 * DFF + ch0 + 4 * n), w1 = *(const f32x4*)(cw + 4 * DFF + ch0 + 4 * n), w2 = *(const f32x4*)(cw + 5 * DFF + ch0 + 4 * n), bb = *(const f32x4*)(cb + ch0 + 4 * n);
#pragma unroll
                for (int j = 0; j < 4; ++j) {
                    float R[4], L[4];
#pragma unroll
                    for (int m = 0; m < 4; ++m) { R[m] = dpp_ror1(acc[ai][1][m][n][j]); L[m] = dpp_ror15(acc[ai][1][m][n][j]); }
#pragma unroll
                    for (int m = 0; m < 4; ++m) {
                        const float prev = fr == 0 ? (m == 0 ? bp[n][j] : R[m - 1]) : R[m];
                        const float next = fr == 15 ? (m == 3 ? bn[n][j] : L[m + 1]) : L[m];
                        const float cv = w0[j] * prev + w1[j] * acc[ai][1][m][n][j] + w2[j] * next + bb[j];
                        acc[ai][0][m][n][j] = silu_f(cv) * acc[ai][0][m][n][j]; }
                } }
#pragma unroll
            for (int m = 0; m < 4; ++m) { const f32x4 v0 = acc[ai][0][m][0], v1 = acc[ai][0][m][1];
                pg8::u32x4 w; w.x = cvtpk(v0[0], v0[1]); w.y = cvtpk(v0[2], v0[3]); w.z = cvtpk(v1[0], v1[1]); w.w = cvtpk(v1[2], v1[3]);
                pg8::st16_wt<0>((GAS pg8::u32x4*)(O + (size_t)(row0 + ai * 128 + m * 16) * u.ldc + col0), w); }
        }
    }
};
__device__ __forceinline__ void ph_ffn_up(Frame& F, int l) {
    SchedUp S{F.G, F.wg, 2 * F.G, (const char*)F.H_(), (const char*)(F.wt_() + WT_UP + (size_t)l * NUP * D * 2), (char*)(F.big_() + BIG_UG), (char*)(F.big_() + BIG_ACT)};
    EpiUp E{F.inp(I_CW) + (size_t)l * 9 * DFF, F.inp(I_CB) + (size_t)l * DFF, F.lds};
    for (int sk = 0; sk < (int)((blockIdx.x >> 3) & 7); ++sk) __builtin_amdgcn_s_sleep(36);
    pg8::gemm_phase<EpiUp, SchedUp, true>(F.lds, D, D, S, E);
    const int ntail = 24 * 22 - 2 * F.G;
    for (int st = F.wg; st < ntail * 16; st += F.G) { int pm, pn; pg8::tile_order(2 * F.G + (st >> 4) - 352, 8, 22, pm, pn); pm += 16;
        const int r0 = pm * 256 + ((st >> 2) & 3) * 64, sn = st & 3, c0 = (sn >> 1) * DFF + pn * 128 + (sn & 1) * 64;
        gemm64(F, F.H_() + (size_t)r0 * D, D, (const bf16_t*)(F.wt_() + WT_UP + (size_t)l * NUP * D * 2) + (size_t)(pn * 256 + sn * 64) * D, D, (bf16_t*)(F.big_() + BIG_UG) + (size_t)r0 * NUP + c0, NUP); }
}
__device__ __forceinline__ const char* firstB_up(Frame& F, int l) { SchedUp S{F.G, F.wg, 2 * F.G, (const char*)F.H_(), (const char*)(F.wt_() + WT_UP + (size_t)l * NUP * D * 2), (char*)(F.big_() + BIG_UG), (char*)(F.big_() + BIG_ACT)}; pg8::Unit u; return S.next(0, u) ? u.B : nullptr; }
__device__ __forceinline__ void unpack8(const u4v& u, float (&f)[8]) {
#pragma unroll
    for (int i = 0; i < 4; ++i) { f[2 * i] = __builtin_bit_cast(float, u[i] << 16); f[2 * i + 1] = __builtin_bit_cast(float, u[i] & 0xffff0000u); }
}
struct ConvItem { u2v raw[3][6]; u2v ua[4]; f32x4 w[9]; f32x4 bias; };
__device__ __forceinline__ void conv_load(ConvItem& I, const bf16_t* UG, const float* cw, const float* cb, int c4, int row0, int gr, int gc0) {
    const bf16_t* gb = UG + DFF + 4 * c4;
#pragma unroll
    for (int di = -1; di <= 1; ++di) { const bool rok = gr + di >= 0 && gr + di < 16;
#pragma unroll
        for (int j = 0; j < 6; ++j) { const int col = gc0 + j - 1; const bool ok = rok && col >= 0 && col < 64;
            u2v u = *(const u2v*)(gb + (size_t)(ok ? row0 + di * 64 + j - 1 : row0) * NUP); if (!ok) u = (u2v){0u, 0u};
            I.raw[di + 1][j] = u; } }
#pragma unroll
    for (int it = 0; it < 4; ++it) I.ua[it] = *(const u2v*)(UG + (size_t)(row0 + it) * NUP + 4 * c4);
#pragma unroll
    for (int t = 0; t < 9; ++t) I.w[t] = *(const f32x4*)(cw + t * DFF + 4 * c4);
    I.bias = *(const f32x4*)(cb + 4 * c4);
}
__device__ __forceinline__ f32x4 unpack4(const u2v& u) { return (f32x4){__builtin_bit_cast(float, u.x << 16), __builtin_bit_cast(float, u.x & 0xffff0000u), __builtin_bit_cast(float, u.y << 16), __builtin_bit_cast(float, u.y & 0xffff0000u)}; }
__device__ __forceinline__ void conv_compute(const ConvItem& I, bf16_t* ACT, int c4, int row0) {
    f32x4 acc[4];
#pragma unroll
    for (int it = 0; it < 4; ++it) acc[it] = I.bias;
#pragma unroll
    for (int di = 0; di < 3; ++di)
#pragma unroll
        for (int j = 0; j < 6; ++j) { const f32x4 f = unpack4(I.raw[di][j]);
#pragma unroll
            for (int dj = -1; dj <= 1; ++dj) { const int it = j - 1 - dj; if (it >= 0 && it < 4) acc[it] = acc[it] + f * I.w[di * 3 + dj + 1]; } }
#pragma unroll
    for (int it = 0; it < 4; ++it) { const f32x4 a = unpack4(I.ua[it]); u2v o;
        o.x = cvtpk(silu_f(acc[it][0]) * a[0], silu_f(acc[it][1]) * a[1]); o.y = cvtpk(silu_f(acc[it][2]) * a[2], silu_f(acc[it][3]) * a[3]);
        st8_wt(ACT + (size_t)(row0 + it) * DFF + 4 * c4, o); }
}
__device__ __forceinline__ void ph_ffn_conv(Frame& F, int l) {
    const bf16_t* UG = (const bf16_t*)(F.big_() + BIG_UG); bf16_t* ACT = (bf16_t*)(F.big_() + BIG_ACT);
    const float* cw = F.inp(I_CW) + (size_t)l * 9 * DFF; const float* cb = F.inp(I_CB) + (size_t)l * DFF;
    const int tw = (F.wg * 8) & 1023, gr = tw >> 6, gcw = tw & 63, rowW = MCTX + F.wg * 8;
    const int i1 = F.tid + 512, i2 = F.tid + 1024;
    const int c0 = F.tid, h1 = i1 >= 704 ? 1 : 0, c1 = i1 - h1 * 704, c2 = i2 - 704;
    const bool v2 = F.wave < 6;
    ConvItem A, B;
    conv_load(A, UG, cw, cb, c0, rowW, gr, gcw);
    conv_load(B, UG, cw, cb, c1, rowW + 4 * h1, gr, gcw + 4 * h1);
    conv_compute(A, ACT, c0, rowW);
    if (v2) conv_load(A, UG, cw, cb, c2, rowW + 4, gr, gcw + 4);
    conv_compute(B, ACT, c1, rowW + 4 * h1);
    if (v2) conv_compute(A, ACT, c2, rowW + 4);
}
__device__ __forceinline__ void ph_gemm_slab(Frame& F, const bf16_t* A, int K, const void* WT) {
    pg8::SchedPlain S = mk_plain(F, A, K, WT, K, 4, 2, K / 128, F.slab_(), D, 2, SLAB_FULL, -1);
    pg8::EpiBf16 E{nullptr};
    pg8::gemm_phase<pg8::EpiBf16, pg8::SchedPlain, true>(F.lds, K, K, S, E);
}
__device__ __forceinline__ const char* firstB_slab(Frame& F, const bf16_t* A, int K, const void* WT) { pg8::SchedPlain S = mk_plain(F, A, K, WT, K, 4, 2, K / 128, F.slab_(), D, 2, SLAB_FULL, -1); pg8::Unit u; return S.next(0, u) ? u.B : nullptr; }

struct SchedF1 { int G, c; const char* A; const char* B; char* ZC; char* ZS;
    __device__ __forceinline__ bool next(int i, pg8::Unit& u) const { int pm, pn; if (!pg8::tile_order(i * G + c, 8, 24, pm, pn)) return false;
        u.A = A + (size_t)pm * 256 * D * 2; u.B = B + (size_t)pn * 256 * D * 2; u.nt = 16; u.flag = 0; u.row0 = 0;
        if (pn < 16) { u.out = ZC + (size_t)pn * 1024 * 512 * 2 + ((size_t)(pm & 3) * 256 * 512 + (pm >> 2) * 256) * 2; u.ldc = 512; }
        else { const int sq = (pn - 16) >> 2, tq = (pn - 16) & 3; u.out = ZS + (size_t)sq * 1024 * 2048 * 2 + ((size_t)(pm & 3) * 256 * 2048 + (pm >> 2) * 1024 + tq * 256) * 2; u.ldc = 2048; }
        return true; } };
__device__ __forceinline__ void ph_f1(Frame& F, int j) {
    SchedF1 S{F.G, F.wg, (const char*)(F.wt_() + WT_CS + (size_t)j * 2048 * D * 2), (const char*)F.H_(), (char*)(F.big_() + BIG_ZTC), (char*)(F.big_() + BIG_ZTS)};
    pg8::EpiBf16 E{nullptr};
    pg8::gemm_phase(F.lds, D, D, S, E);
}
struct SchedF2C { int G, c; const char* A; const char* B; char* O;
    __device__ __forceinline__ bool next(int i, pg8::Unit& u) const { const int L = i * G + c; if (L >= 64) return false; const int seq = L >> 2, pn = L & 3;
        u.A = A; u.B = B + (size_t)seq * 1024 * 512 * 2 + (size_t)pn * 256 * 512 * 2; u.out = O + ((size_t)seq * 256 * D + pn * 256) * 2; u.nt = 8; u.ldc = D; u.flag = 0; u.row0 = 0; return true; } };
struct SchedF2S { int G, c; const char* A; const char* B; char* O0; char* O2;
    __device__ __forceinline__ bool next(int i, pg8::Unit& u) const { const int L = i * G + c - 64; if (L < 0 || L >= 128) return false;
        const int ks = L & 3, r = L >> 2, seq = r >> 4, pm = (r >> 2) & 3, pn = r & 3;
        u.A = A + ((size_t)pm * 256 * 2048 + ks * 512) * 2; u.B = B + (size_t)seq * 1024 * 2048 * 2 + ((size_t)pn * 256 * 2048 + ks * 512) * 2;
        char* ob = ks < 2 ? O0 + (size_t)ks * SLAB_FULL + (size_t)MCTX * D * 2 : O2 + (size_t)(ks - 2) * SLAB_SMP;
        u.out = ob + ((size_t)(seq * 1024 + pm * 256) * D + pn * 256) * 2; u.nt = 8; u.ldc = D; u.flag = 0; u.row0 = 0; return true; } };
__device__ __forceinline__ void ph_f2(Frame& F) {
    pg8::EpiBf16 E{nullptr};
    { SchedF2C S{F.G, F.wg, (const char*)(F.tab_() + TAB_CST256), (const char*)(F.big_() + BIG_ZTC), (char*)F.slab_()}; pg8::gemm_phase(F.lds, 512, 512, S, E); }
    { SchedF2S S{F.G, F.wg, (const char*)(F.tab_() + TAB_CST1024), (const char*)(F.big_() + BIG_ZTS), (char*)F.slab_(), (char*)(F.slab_() + 2 * SLAB_FULL)}; pg8::gemm_phase(F.lds, 2048, 2048, S, E); }
}

struct SchedCols { int G, c, np, first, gate_p; const char* A; const char* B; char* O; int ldc;
    __device__ __forceinline__ bool next(int i, pg8::Unit& u) const { int pm, pp; if (c < 0 || !pg8::tile_order(i * G + c, 24, np, pm, pp)) return false;
        const int pn = (pp == gate_p) ? 12 : first + pp;
        u.A = A + (size_t)pm * 256 * D * 2; u.B = B + (size_t)pn * 256 * D * 2; u.out = O + ((size_t)pm * 256 * ldc + (size_t)pn * 256) * 2; u.nt = 16; u.ldc = ldc; u.flag = (pp == gate_p) ? 1 : 0; u.row0 = pm * 256; return true; } };
__device__ __forceinline__ void ph_proj(Frame& F, const void* WT, int nfull) {
    pg8::EpiBf16 E{(float*)(F.big_() + BIG_GATES)};
    if (nfull == 16) {
        pg8::SchedPlain S = mk_plain(F, F.H_(), D, WT, D, nfull + 1, 1, 16, F.big_() + BIG_PROJ, nfull * 256, 2, 0, nfull);
        pg8::gemm_phase<pg8::EpiBf16, pg8::SchedPlain, true>(F.lds, D, D, S, E);
    } else {
        SchedCols S{F.G, F.wg, 9, 0, 8, (const char*)F.H_(), (const char*)WT, (char*)(F.big_() + BIG_PROJ), nfull * 256};
        pg8::gemm_phase<pg8::EpiBf16, SchedCols, true>(F.lds, D, D, S, E);
    }
}
__device__ __forceinline__ const char* firstB_proj(Frame& F, const void* WT, int nfull) { pg8::Unit u;
    if (nfull == 16) { pg8::SchedPlain S = mk_plain(F, F.H_(), D, WT, D, nfull + 1, 1, 16, F.big_() + BIG_PROJ, nfull * 256, 2, 0, nfull); return S.next(0, u) ? u.B : nullptr; }
    SchedCols S{F.G, F.wg, 9, 0, 8, (const char*)F.H_(), (const char*)WT, (char*)(F.big_() + BIG_PROJ), nfull * 256}; return S.next(0, u) ? u.B : nullptr; }
__device__ __forceinline__ void ph_ml_ogate(Frame& F) {
    __syncthreads();
    SchedCols S{96, F.wg >= 160 ? F.wg - 160 : -1, 4, 8, -1, (const char*)F.H_(), (const char*)(F.wt_() + WT_MIN), (char*)(F.big_() + BIG_PROJ), 3072};
    pg8::EpiBf16 E{nullptr};
    pg8::gemm_phase<pg8::EpiBf16, SchedCols, true>(F.lds, D, D, S, E);
}
__device__ __forceinline__ const char* firstB_og(Frame& F) { pg8::Unit u;
    SchedCols S{96, F.wg >= 160 ? F.wg - 160 : -1, 4, 8, -1, (const char*)F.H_(), (const char*)(F.wt_() + WT_MIN), (char*)(F.big_() + BIG_PROJ), 3072}; return S.next(0, u) ? u.B : nullptr; }
__device__ __forceinline__ void chunk_pos(int ck, int& seq, int& t0, int& T) { if (ck < 64) { seq = ck >> 2; t0 = (ck & 3) * 64; T = 256; } else { const int u = ck - 64; seq = 16 + (u >> 4); t0 = (u & 15) * 64; T = 1024; } }

constexpr int DP_LQ = 0, DP_LK = 17408, DP_LQK = 34816, DP_LKK = 52224, DP_LKT = 69632, DP_LVT = 88064, DP_SC = 106496, DP_T = DP_LQK;
constexpr int DS_VEC_F = 192;
__device__ __forceinline__ void ph_dn_prep2(Frame& F) {
    const bf16_t* P = (const bf16_t*)(F.big_() + BIG_PROJ); const float* GT = (const float*)(F.big_() + BIG_GATES);
    LAS bf16_t* LQ = (LAS bf16_t*)(F.lds + DP_LQ); LAS bf16_t* LK = (LAS bf16_t*)(F.lds + DP_LK); LAS float* LQK = (LAS float*)(F.lds + DP_LQK); LAS float* LKK = (LAS float*)(F.lds + DP_LKK);
    LAS bf16_t* LKT = (LAS bf16_t*)(F.lds + DP_LKT); LAS bf16_t* LVT = (LAS bf16_t*)(F.lds + DP_LVT); LAS float* SC = (LAS float*)(F.lds + DP_SC);
    const int tid = F.tid, lane = F.lane, w = F.wave, r = lane & 15, g = lane >> 4;
    const float* cw = F.inp(I_DCW);
    unsigned xr[12][3];
    auto load_xr = [&](int task_) { const int ck_ = task_ >> 3, h_ = task_ & 7; int seq_, t0_, T_; chunk_pos(ck_, seq_, t0_, T_);
        unsigned rowv = (unsigned)(seq_row0(seq_) + t0_ + 8 * w - 2); asm volatile("" : "+v"(rowv));
#pragma unroll
        for (int rr = 0; rr < 12; ++rr) { const int tp = t0_ + 8 * w - 2 + rr; const bool ok = tp >= 0 && tp < T_;
#pragma unroll
            for (int wh = 0; wh < 3; ++wh) { xr[rr][wh] = 0u; if (ok) xr[rr][wh] = *(const unsigned*)(P + ((rowv + rr) * 4096u + (unsigned)(wh * 1024 + h_ * 128 + 2 * lane))); } } };
    if (F.wg < 96 * 8) load_xr(F.wg);
    for (int task = F.wg; task < 96 * 8; task += F.G) {
        const int ck = task >> 3, h = task & 7; int seq, t0, T; chunk_pos(ck, seq, t0, T); const int row0 = seq_row0(seq) + t0;
        __syncthreads();
        {
            float cwr[3][5][2];
#pragma unroll
            for (int wh = 0; wh < 3; ++wh)
#pragma unroll
                for (int j = 0; j < 5; ++j) { const f32x2 c = *(const f32x2*)(cw + j * 3072 + wh * 1024 + h * 128 + 2 * lane); cwr[wh][j][0] = c[0]; cwr[wh][j][1] = c[1]; }
            bf16_t* QSg = (bf16_t*)(F.big_() + BIG_QS) + (size_t)task * 64 * 128;
#pragma unroll
            for (int tt = 0; tt < 8; ++tt) { const int tk = 8 * w + tt;
                float val[3][2];
#pragma unroll
                for (int wh = 0; wh < 3; ++wh) { float a0 = 0.f, a1 = 0.f;
#pragma unroll
                    for (int j = 0; j < 5; ++j) { const unsigned x = xr[tt + j][wh]; a0 += bf2f(x & 0xffffu) * cwr[wh][j][0]; a1 += bf2f(x >> 16) * cwr[wh][j][1]; }
                    val[wh][0] = silu_f(a0); val[wh][1] = silu_f(a1); }
                const float qs = rsqrtf(wave_sum(val[0][0] * val[0][0] + val[0][1] * val[0][1]) + EPS) * 0.08838834764831845f;
                const float ks = rsqrtf(wave_sum(val[1][0] * val[1][0] + val[1][1] * val[1][1]) + EPS);
                const unsigned qp = cvtpk(val[0][0] * qs, val[0][1] * qs), kp = cvtpk(val[1][0] * ks, val[1][1] * ks), vp = cvtpk(val[2][0], val[2][1]);
                *(LAS unsigned*)(LQ + tk * 136 + 2 * lane) = qp; *(LAS unsigned*)(LK + tk * 136 + 2 * lane) = kp;
                *(unsigned*)(QSg + tk * 128 + 2 * lane) = qp;
                LKT[(2 * lane) * 72 + tk] = (bf16_t)(kp & 0xffffu); LKT[(2 * lane + 1) * 72 + tk] = (bf16_t)(kp >> 16);
                LVT[(2 * lane) * 72 + tk] = (bf16_t)(vp & 0xffffu); LVT[(2 * lane + 1) * 72 + tk] = (bf16_t)(vp >> 16);
            }
        }
        if (task + F.G < 96 * 8) load_xr(task + F.G);
        float gl_dir = 0.f;
        if (w < 2) { const int dir = w, c = dir ? 63 - lane : lane;
            const float graw = GT[(size_t)(row0 + c) * 32 + dir * 16 + h], braw = GT[(size_t)(row0 + c) * 32 + dir * 16 + 8 + h];
            float gsum = -expf(F.inp(I_DALOG)[dir * 8 + h]) * softplus_f(graw + F.inp(I_DDT)[dir * 8 + h]);
#pragma unroll
            for (int o = 1; o < 64; o <<= 1) { const float t = __shfl_up(gsum, o); if (lane >= o) gsum += t; }
            SC[dir * 64 + c] = gsum; SC[128 + dir * 64 + c] = sigmoid_f(braw);
            gl_dir = __shfl(gsum, 63);
        }
        __syncthreads();
        {
            const LAS bf16_t* Asrc = w < 4 ? LK : LQ; LAS float* Dst = w < 4 ? LKK : LQK; const int mi = w & 3;
            f32x4 acc[4];
#pragma unroll
            for (int ni = 0; ni < 4; ++ni) acc[ni] = (f32x4){0.f, 0.f, 0.f, 0.f};
#pragma unroll
            for (int kk = 0; kk < 4; ++kk) { const bf16x8_t a = frag_nat(Asrc, 136, 16 * mi + r, 32 * kk, g);
#pragma unroll
                for (int ni = 0; ni < 4; ++ni) acc[ni] = MFMA16(a, frag_nat(LK, 136, 16 * ni + r, 32 * kk, g), acc[ni]); }
#pragma unroll
            for (int ni = 0; ni < 4; ++ni)
#pragma unroll
                for (int i = 0; i < 4; ++i) Dst[(16 * mi + 4 * g + i) * 68 + 16 * ni + r] = acc[ni][i];
        }
        __syncthreads();
        {
            const size_t cd0 = (size_t)task * 2;
            bf16_t* QKMg = (bf16_t*)(F.big_() + BIG_QKM) + cd0 * 64 * 64;
#pragma unroll
            for (int it = 0; it < 4; ++it) { const int idx = tid + 512 * it, c = idx >> 5, s = (idx & 31) * 2;
                const float gFc = SC[c], gBc = SC[64 + c], bFc = SC[128 + c], bBc = SC[192 + c];
                float qf[2], qb[2];
#pragma unroll
                for (int e = 0; e < 2; ++e) { const int ss = s + e; const float qk = LQK[c * 68 + ss], kk = LKK[c * 68 + ss];
                    const float dF = __expf(gFc - SC[ss]), dB = __expf(gBc - SC[64 + ss]);
                    qf[e] = ss <= c ? qk * dF : 0.f; qb[e] = ss >= c ? qk * dB : 0.f;
                    LKK[c * 68 + ss] = ss < c ? bFc * kk * dF : (ss > c ? bBc * kk * dB : 0.f); }
                *(unsigned*)(QKMg + c * 64 + s) = pk2(qf[0], qf[1]); *(unsigned*)(QKMg + 4096 + c * 64 + s) = pk2(qb[0], qb[1]); }
            bf16_t* KTg = (bf16_t*)(F.big_() + BIG_KTG) + (size_t)task * 128 * 64;
#pragma unroll
            for (int it = 0; it < 2; ++it) { const int idx = tid + 512 * it, d = idx >> 3, c8 = (idx & 7) * 8; *(u4v*)(KTg + d * 64 + c8) = *(const LAS u4v*)(LKT + d * 72 + c8); }
            if (tid < 128) { const int dir = tid >> 6, c = tid & 63; float* VEC = (float*)(F.big_() + BIG_VEC) + (cd0 + dir) * DS_VEC_F;
                const float gc = SC[dir * 64 + c], gl = SC[dir * 64 + (dir ? 0 : 63)];
                VEC[c] = __expf(gc); VEC[64 + c] = __expf(gl - gc); if (c == 0) VEC[128] = __expf(gl); }
        }
        __syncthreads();
#pragma unroll
        for (int it = 0; it < 8; ++it) { const int idx = tid + 512 * it, p = idx >> 6, pj = idx & 63; LQK[p * 68 + pj] = LKK[(63 - p) * 68 + 63 - pj]; }
        __syncthreads();
        {
            LAS float* TF0 = (LAS float*)(F.lds + DP_LQ); LAS float* XS = (LAS float*)(F.lds + DP_SC + 1024) + w * 272;
            unsigned lofs = 0u; asm volatile("" : "+v"(lofs));
            const LAS float* Lf = (const LAS float*)(F.lds + DP_LKK + lofs); const LAS float* Lb = (const LAS float*)(F.lds + DP_LQK + lofs);
            const int lr = lane & 15, lg = lane >> 4;
            { const int dir = w >> 2, bi = w & 3; const LAS float* Ls = (dir ? Lb : Lf) + (16 * bi) * 68 + 16 * bi; LAS float* Td = TF0 + dir * 64 * 68 + (16 * bi) * 68 + 16 * bi + lofs;
                float Tr[16];
#pragma unroll
                for (int p = 0; p < 16; ++p) { float a0 = (p == lr) ? 1.f : 0.f;
#pragma unroll
                    for (int pj = 0; pj < p; ++pj) a0 -= Ls[p * 68 + pj] * Tr[pj];
                    Tr[p] = a0; }
                if (lane < 16) {
#pragma unroll
                    for (int p = 0; p < 16; ++p) Td[p * 68 + lr] = Tr[p]; } }
            __syncthreads();
#define MM16(acc, Ap, pa, Bp, pb) do { _Pragma("unroll") for (int s_ = 0; s_ < 4; ++s_) acc = __builtin_amdgcn_mfma_f32_16x16x4f32((Ap)[lr * (pa) + 4 * s_ + lg], (Bp)[(4 * s_ + lg) * (pb) + lr], acc, 0, 0, 0); } while (0)
#pragma unroll
            for (int lev = 1; lev < 4; ++lev) {
                const int ntask = 2 * (4 - lev);
                if (w < ntask) { const int dir = w / (4 - lev), bi = lev + w % (4 - lev), bj = bi - lev;
                    const LAS float* Ls = dir ? Lb : Lf; LAS float* Tf = TF0 + dir * 64 * 68 + lofs;
                    f32x4 x = (f32x4){0.f, 0.f, 0.f, 0.f};
#pragma unroll
                    for (int d = 0; d < 3; ++d) if (d < lev) { const int bk = bj + d;
                        MM16(x, Ls + (16 * bi) * 68 + 16 * bk, 68, Tf + (16 * bk) * 68 + 16 * bj, 68); }
#pragma unroll
                    for (int rr = 0; rr < 4; ++rr) XS[(4 * lg + rr) * 17 + lr] = x[rr];
                    f32x4 t = (f32x4){0.f, 0.f, 0.f, 0.f};
                    MM16(t, Tf + (16 * bi) * 68 + 16 * bi, 68, XS, 17);
#pragma unroll
                    for (int rr = 0; rr < 4; ++rr) Tf[(16 * bi + 4 * lg + rr) * 68 + 16 * bj + lr] = -t[rr]; }
                __syncthreads();
            }
#undef MM16
            LAS bf16_t* Tb = (LAS bf16_t*)(F.lds + DP_T);
#pragma unroll
            for (int it = 0; it < 8; ++it) { const int idx = tid + 512 * it, dir = idx >> 11, p = (idx >> 5) & 63, pj = (idx & 31) * 2;
                const f32x2 tv = *(const LAS f32x2*)(TF0 + dir * 64 * 68 + p * 68 + pj);
                const int c = dir ? 63 - p : p, s0 = dir ? 63 - pj : pj, s1 = dir ? 62 - pj : pj + 1;
                const float t0 = (pj >> 4) <= (p >> 4) ? tv[0] : 0.f, t1 = ((pj + 1) >> 4) <= (p >> 4) ? tv[1] : 0.f;
                const float b0 = SC[128 + dir * 64 + s0], b1 = SC[128 + dir * 64 + s1], e0 = b0 * __expf(SC[dir * 64 + s0]), e1 = b1 * __expf(SC[dir * 64 + s1]);
                LAS bf16_t* T1 = Tb + dir * 2 * 4096; LAS bf16_t* T2 = T1 + 4096;
                T1[c * 64 + s0] = (bf16_t)f2bf(t0 * b0); T1[c * 64 + s1] = (bf16_t)f2bf(t1 * b1); T2[c * 64 + s0] = (bf16_t)f2bf(t0 * e0); T2[c * 64 + s1] = (bf16_t)f2bf(t1 * e1); }
        }
        __syncthreads();
#pragma unroll
        for (int dir = 0; dir < 2; ++dir) { const size_t cd = (size_t)task * 2 + dir;
            const LAS bf16_t* T1 = (const LAS bf16_t*)(F.lds + DP_T) + dir * 2 * 4096; const LAS bf16_t* T2 = T1 + 4096;
            bf16_t* Ug = (bf16_t*)(F.big_() + BIG_U) + cd * 8192 + (size_t)w * 1024; bf16_t* WNg = (bf16_t*)(F.big_() + BIG_WN) + cd * 8192;
#pragma unroll
            for (int m = 0; m < 4; ++m) { f32x4 au = (f32x4){0.f, 0.f, 0.f, 0.f}, aw = (f32x4){0.f, 0.f, 0.f, 0.f};
#pragma unroll
                for (int kk = 0; kk < 2; ++kk) {
                    au = MFMA16(frag_nat(T1, 64, rowp(m, r), 32 * kk, g), frag_nat(LVT, 72, 16 * w + r, 32 * kk, g), au);
                    aw = MFMA16(frag_nat(LKT, 72, 16 * w + r, 32 * kk, g), frag_nat(T2, 64, 16 * m + r, 32 * kk, g), aw); }
                *(u2v*)(Ug + m * 256 + lane * 4) = pk4(au);
                u2v o; o.x = pk2(-aw[0], -aw[1]); o.y = pk2(-aw[2], -aw[3]);
                *(u2v*)(WNg + (16 * m + r) * 128 + 16 * w + 4 * g) = o; }
        }
    }
}

constexpr int DS_LWN = 0, DS_LQS = 17408, DS_LQKM = 34816, DS_LKT = 44032, DS_LVEC = 62464;
__device__ __forceinline__ void dn_scan_seq(Frame& F, int seq, int h, int dir, int esl0, int nact) {
    LAS bf16_t* LWN = (LAS bf16_t*)(F.lds + DS_LWN); LAS bf16_t* LQS = (LAS bf16_t*)(F.lds + DS_LQS); LAS bf16_t* LQKM = (LAS bf16_t*)(F.lds + DS_LQKM); LAS bf16_t* LKT = (LAS bf16_t*)(F.lds + DS_LKT);
    LAS float* LVEC = (LAS float*)(F.lds + DS_LVEC);
    const int tid = F.tid, lane = F.lane, w = F.wave, r = lane & 15, g = lane >> 4, ws = esl0 + (w < nact ? w : 0); const bool act = w < nact;
    const int NC = seq < 16 ? 4 : 16, ck0 = seq < 16 ? seq * 4 : 64 + (seq - 16) * 16, rowS = seq_row0(seq);
    bf16_t* O = (bf16_t*)(F.slab_() + (dir ? SLAB_FULL : 0));
    f32x4 Sacc[8];
    if (seq >= 16) { const float* s0 = F.inp(I_SD) + ((size_t)((seq - 16) * 2 + dir) * 8 + h) * 16384 + 16 * ws + r;
#pragma unroll
        for (int j = 0; j < 8; ++j)
#pragma unroll
            for (int i = 0; i < 4; ++i) Sacc[j][i] = s0[(32 * (j >> 1) + 8 * g + 4 * (j & 1) + i) * 128]; }
    else {
#pragma unroll
        for (int j = 0; j < 8; ++j) Sacc[j] = (f32x4){0.f, 0.f, 0.f, 0.f}; }
    struct DStage { u4v wn[2], qs[2], qkm, kt[2]; f32x4 vec; u2v U[4]; };
    constexpr int PD = 1;
    DStage st[PD];
#define DS_LOAD(S, n) do { const int ckn = ck0 + (dir ? NC - 1 - (n) : (n)); const size_t tk = (size_t)ckn * 8 + h, cd = tk * 2 + dir; \
        const u4v* gWN = (const u4v*)((const bf16_t*)(F.big_() + BIG_WN) + cd * 8192); const u4v* gQS = (const u4v*)((const bf16_t*)(F.big_() + BIG_QS) + tk * 8192); \
        const u4v* gQKM = (const u4v*)((const bf16_t*)(F.big_() + BIG_QKM) + cd * 4096); const u4v* gKT = (const u4v*)((const bf16_t*)(F.big_() + BIG_KTG) + tk * 8192); \
        S.wn[0] = gWN[tid]; S.wn[1] = gWN[tid + 512]; S.qs[0] = gQS[tid]; S.qs[1] = gQS[tid + 512]; S.qkm = gQKM[tid]; S.kt[0] = gKT[tid]; S.kt[1] = gKT[tid + 512]; \
        S.vec = (f32x4){0.f, 0.f, 0.f, 0.f}; if (tid < 48) S.vec = *(const f32x4*)((const float*)(F.big_() + BIG_VEC) + cd * DS_VEC_F + tid * 4); \
        const bf16_t* gU = (const bf16_t*)(F.big_() + BIG_U) + cd * 8192 + (size_t)ws * 1024 + lane * 4; \
        _Pragma("unroll") for (int m = 0; m < 4; ++m) S.U[m] = *(const u2v*)(gU + m * 256); } while (0)
#pragma unroll
    for (int k = 0; k < PD; ++k) DS_LOAD(st[k], k);
    for (int n0 = 0; n0 < NC; n0 += PD) {
#pragma unroll
      for (int k = 0; k < PD; ++k) { const int n = n0 + k;
        __syncthreads();
#pragma unroll
        for (int i = 0; i < 2; ++i) { const int idx = tid + 512 * i;
            const int r16 = idx >> 4, c16 = (idx & 15) ^ (((r16 >> 4) & 1) << 2), r8 = idx >> 3, c8 = (idx & 7) ^ (((r8 >> 4) & 1) << 2);
            *(LAS u4v*)(LWN + r16 * 136 + c16 * 8) = st[k].wn[i]; *(LAS u4v*)(LQS + r16 * 136 + c16 * 8) = st[k].qs[i];
            *(LAS u4v*)(LKT + r8 * 72 + c8 * 8) = st[k].kt[i]; }
        { const int r8 = tid >> 3, c8 = (tid & 7) ^ (((r8 >> 4) & 1) << 2); *(LAS u4v*)(LQKM + r8 * 72 + c8 * 8) = st[k].qkm; }
        if (tid < 48) *(LAS f32x4*)(LVEC + tid * 4) = st[k].vec;
        f32x4 vn[4];
#pragma unroll
        for (int m = 0; m < 4; ++m) vn[m] = up4(st[k].U[m]);
        const int ckc = ck0 + (dir ? NC - 1 - n : n);
        __syncthreads();
        if (n + PD < NC) DS_LOAD(st[k], n + PD);
        if (act) {
        bf16x8_t Sb[4];
#pragma unroll
        for (int kk = 0; kk < 4; ++kk) Sb[kk] = pack_acc(Sacc[2 * kk], Sacc[2 * kk + 1]);
        f32x4 o[4];
#pragma unroll
        for (int m = 0; m < 4; ++m) { o[m] = (f32x4){0.f, 0.f, 0.f, 0.f};
#pragma unroll
            for (int kk = 0; kk < 4; ++kk) { vn[m] = MFMA16(frag_sw(LWN, 136, rowp(m, r), 4 * kk, g), Sb[kk], vn[m]); o[m] = MFMA16(frag_sw(LQS, 136, rowp(m, r), 4 * kk, g), Sb[kk], o[m]); }
            o[m] = o[m] * *(const LAS f32x4*)(LVEC + 32 * (m >> 1) + 8 * g + 4 * (m & 1)); }
        bf16x8_t vb[2], vs[2];
#pragma unroll
        for (int k2 = 0; k2 < 2; ++k2) { vb[k2] = pack_acc(vn[2 * k2], vn[2 * k2 + 1]);
            const f32x4 e0 = *(const LAS f32x4*)(LVEC + 64 + 32 * k2 + 8 * g), e1 = *(const LAS f32x4*)(LVEC + 64 + 32 * k2 + 8 * g + 4);
            vs[k2] = pack_acc(vn[2 * k2] * e0, vn[2 * k2 + 1] * e1); }
#pragma unroll
        for (int m = 0; m < 4; ++m) {
#pragma unroll
            for (int k2 = 0; k2 < 2; ++k2) o[m] = MFMA16(frag_sw(LQKM, 72, rowp(m, r), 4 * k2, g), vb[k2], o[m]);
            bf16_t* op = O + (size_t)(rowS + (ckc - ck0) * 64 + 32 * (m >> 1) + 8 * g + 4 * (m & 1)) * D + h * 128 + 16 * ws + r;
            const unsigned p01 = cvtpk(o[m][0], o[m][1]), p23 = cvtpk(o[m][2], o[m][3]);
            op[0] = (bf16_t)p01; op[(size_t)D] = (bf16_t)(p01 >> 16); op[(size_t)2 * D] = (bf16_t)p23; op[(size_t)3 * D] = (bf16_t)(p23 >> 16); }
        const float egl = LVEC[128];
#pragma unroll
        for (int j = 0; j < 8; ++j) { Sacc[j] = Sacc[j] * egl;
#pragma unroll
            for (int k2 = 0; k2 < 2; ++k2) Sacc[j] = MFMA16(frag_sw(LKT, 72, rowp(j, r), 4 * k2, g), vs[k2], Sacc[j]); }
        }
      }
    }
#undef DS_LOAD
    if (seq < 16 && act) { float* nd = F.out + O_ND + ((size_t)(seq * 2 + dir) * 8 + h) * 16384 + 16 * ws + r;
#pragma unroll
        for (int j = 0; j < 8; ++j)
#pragma unroll
            for (int i = 0; i < 4; ++i) nd[(32 * (j >> 1) + 8 * g + 4 * (j & 1) + i) * 128] = Sacc[j][i]; }
}
__device__ __forceinline__ bool scan_slot(int wg, int rnd, int& seq, int& h, int& dir, int& esl0, int& nact) {
    int id;
    if (wg < 64) { if (rnd) return false; id = wg >> 1; esl0 = (wg & 1) * 4; nact = 4; seq = 16 + id / 16; }
    else { id = (wg - 64) + rnd * 192; if (id >= 256) return false; esl0 = 0; nact = 8; seq = id / 16; }
    h = (id >> 1) & 7; dir = id & 1; return true;
}
__device__ __forceinline__ void ph_dn_scan2(Frame& F) {
    for (int rnd = 0; rnd < 2; ++rnd) { int seq, h, dir, esl0, nact; if (!scan_slot(F.wg, rnd, seq, h, dir, esl0, nact)) break; dn_scan_seq(F, seq, h, dir, esl0, nact); }
}
constexpr size_t BIG_MINTRA = BIG_WN;
constexpr size_t BIG_MU = BIG_MINTRA + (size_t)1536 * 8192 * 4;
constexpr size_t BIG_MVEC = BIG_MU + (size_t)1536 * 8192 * 4;
constexpr size_t BIG_MQS = BIG_MVEC + (size_t)1536 * 272 * 4;
static_assert(BIG_MQS + (size_t)768 * 4096 * 2 <= BIG_END, "mLSTM buffers exceed the big region");
constexpr int MP_LQ = 0, MP_LK = 9216, MP_LKT = 18432, MP_LVT = 27648, MP_LQK = 46080, MP_LPM = 63488, MP_LKW = 81920, MP_SC = 100352;
__device__ __forceinline__ void ph_ml_prep(Frame& F) {
    const bf16_t* P = (const bf16_t*)(F.big_() + BIG_PROJ); const float* GT = (const float*)(F.big_() + BIG_GATES);
    LAS bf16_t* LQ = (LAS bf16_t*)(F.lds + MP_LQ); LAS bf16_t* LK = (LAS bf16_t*)(F.lds + MP_LK); LAS bf16_t* LKT = (LAS bf16_t*)(F.lds + MP_LKT); LAS bf16_t* LVT = (LAS bf16_t*)(F.lds + MP_LVT);
    LAS float* LQK = (LAS float*)(F.lds + MP_LQK); LAS bf16_t* LPM = (LAS bf16_t*)(F.lds + MP_LPM); LAS bf16_t* LKW = (LAS bf16_t*)(F.lds + MP_LKW);
    LAS float* SC = (LAS float*)(F.lds + MP_SC);
    const int tid = F.tid, lane = F.lane, w = F.wave, r = lane & 15, g = lane >> 4;
    unsigned xqk[8], xvv[8];
    auto load_x = [&](int task_) { const int ck_ = task_ >> 3, h_ = task_ & 7; int seq_, t0_, T_; chunk_pos(ck_, seq_, t0_, T_);
        unsigned rowv = (unsigned)(seq_row0(seq_) + t0_ + 8 * w); asm volatile("" : "+v"(rowv));
#pragma unroll
        for (int tt = 0; tt < 8; ++tt) {
            xqk[tt] = *(const unsigned*)(P + ((rowv + tt) * 3072u + (unsigned)((lane < 32 ? 0 : 512) + h_ * 64 + (lane & 31) * 2)));
            xvv[tt] = *(const unsigned*)(P + ((rowv + tt) * 3072u + (unsigned)(1024 + h_ * 128 + 2 * lane))); } };
    if (F.wg < 96 * 8) load_x(F.wg);
    for (int task = F.wg; task < 96 * 8; task += F.G) {
        const int ck = task >> 3, h = task & 7; int seq, t0, T; chunk_pos(ck, seq, t0, T); const int row0 = seq_row0(seq) + t0;
        __syncthreads();
        {
            bf16_t* QSg = (bf16_t*)(F.big_() + BIG_MQS) + (size_t)task * 4096;
#pragma unroll
            for (int tt = 0; tt < 8; ++tt) { const int tk = 8 * w + tt;
                const int l2 = (lane & 31) * 2;
                const unsigned qk = xqk[tt], vv = xvv[tt];
                if (lane < 32) { const unsigned qs = pk2(bf2f(qk & 0xffffu) * 0.125f, bf2f(qk >> 16) * 0.125f); *(LAS unsigned*)(LQ + tk * 72 + l2) = qs; *(unsigned*)(QSg + tk * 64 + l2) = qs; }
                else { *(LAS unsigned*)(LK + tk * 72 + l2) = qk; LKT[l2 * 72 + tk] = (bf16_t)(qk & 0xffffu); LKT[(l2 + 1) * 72 + tk] = (bf16_t)(qk >> 16); }
                LVT[(2 * lane) * 72 + tk] = (bf16_t)(vv & 0xffffu); LVT[(2 * lane + 1) * 72 + tk] = (bf16_t)(vv >> 16);
            }
        }
        if (task + F.G < 96 * 8) load_x(task + F.G);
        if (w < 2) { const int dir = w, c = dir ? 63 - lane : lane;
            const float li = GT[(size_t)(row0 + c) * 32 + dir * 16 + h] + F.inp(I_MBI)[dir * 8 + h];
            float bc = logsigmoid_f(GT[(size_t)(row0 + c) * 32 + dir * 16 + 8 + h] + F.inp(I_MBF)[dir * 8 + h]);
#pragma unroll
            for (int o = 1; o < 64; o <<= 1) { const float t = __shfl_up(bc, o); if (lane >= o) bc += t; }
            const float a = li - bc; float am = a;
#pragma unroll
            for (int o = 1; o < 64; o <<= 1) { const float t = __shfl_up(am, o); if (lane >= o) am = fmaxf(am, t); }
            SC[dir * 256 + c] = bc; SC[dir * 256 + 64 + c] = a; SC[dir * 256 + 128 + c] = am;
            if (lane == 63) { SC[512 + dir * 2] = bc; SC[512 + dir * 2 + 1] = am; }
        }
        __syncthreads();
        {
            const int mi = w >> 1;
            f32x4 acc[2] = {(f32x4){0.f, 0.f, 0.f, 0.f}, (f32x4){0.f, 0.f, 0.f, 0.f}};
#pragma unroll
            for (int kk = 0; kk < 2; ++kk) { const bf16x8_t a = frag_nat(LQ, 72, 16 * mi + r, 32 * kk, g);
#pragma unroll
                for (int nn = 0; nn < 2; ++nn) acc[nn] = MFMA16(a, frag_nat(LK, 72, 16 * (2 * (w & 1) + nn) + r, 32 * kk, g), acc[nn]); }
#pragma unroll
            for (int nn = 0; nn < 2; ++nn)
#pragma unroll
                for (int i = 0; i < 4; ++i) LQK[(16 * mi + 4 * g + i) * 68 + 16 * (2 * (w & 1) + nn) + r] = acc[nn][i];
        }
        __syncthreads();
        {
            const size_t cd0 = (size_t)task * 2;
#pragma unroll
            for (int it = 0; it < 4; ++it) { const int idx = tid + 512 * it, c = idx >> 5, s = (idx & 31) * 2;
#pragma unroll
                for (int dir = 0; dir < 2; ++dir) { const LAS float* sc = SC + dir * 256;
                    const float amc = sc[128 + c], amL = SC[512 + dir * 2 + 1];
                    float pm[2], kw[2];
#pragma unroll
                    for (int e = 0; e < 2; ++e) { const int ss = s + e; const bool ok = dir ? ss >= c : ss <= c;
                        pm[e] = ok ? LQK[c * 68 + ss] * __expf(sc[64 + ss] - amc) : 0.f;
                        kw[e] = bf2f(LKT[c * 72 + ss]) * __expf(sc[64 + ss] - amL); }
                    *(LAS unsigned*)(LPM + dir * 64 * 72 + c * 72 + s) = pk2(pm[0], pm[1]); *(LAS unsigned*)(LKW + dir * 64 * 72 + c * 72 + s) = pk2(kw[0], kw[1]);
                    float ps = pm[0] + pm[1], ks = kw[0] + kw[1];
#pragma unroll
                    for (int o = 1; o < 32; o <<= 1) { ps += __shfl_xor(ps, o); ks += __shfl_xor(ks, o); }
                    if ((lane & 31) == 0) { float* VEC = (float*)(F.big_() + BIG_MVEC) + (cd0 + dir) * 272; VEC[128 + (c & 15) * 4 + (c >> 4)] = ps; VEC[192 + c] = ks; }
                } }
            if (tid < 128) { const int dir = tid >> 6, c = tid & 63; float* VEC = (float*)(F.big_() + BIG_MVEC) + (cd0 + dir) * 272; const LAS float* sc = SC + dir * 256;
                VEC[(c & 15) * 4 + (c >> 4)] = sc[c]; VEC[64 + (c & 15) * 4 + (c >> 4)] = sc[c] + sc[128 + c];
                if (c == 0) { const float bl = SC[512 + dir * 2]; VEC[256] = bl; VEC[257] = bl + SC[512 + dir * 2 + 1]; } }
        }
        __syncthreads();
#pragma unroll
        for (int dir = 0; dir < 2; ++dir) { const size_t cd = (size_t)task * 2 + dir;
            bf16_t* Ig = (bf16_t*)(F.big_() + BIG_MINTRA) + cd * 8192 + (size_t)w * 1024 + lane * 4; bf16_t* Ug = (bf16_t*)(F.big_() + BIG_MU) + cd * 8192 + (size_t)w * 1024 + lane * 4;
            const bf16x8_t v0 = frag_nat(LVT, 72, 16 * w + r, 0, g), v1 = frag_nat(LVT, 72, 16 * w + r, 32, g);
#pragma unroll
            for (int m = 0; m < 4; ++m) { f32x4 ai = (f32x4){0.f, 0.f, 0.f, 0.f}, au = (f32x4){0.f, 0.f, 0.f, 0.f};
                ai = MFMA16(frag_nat(LPM + dir * 64 * 72, 72, 16 * m + r, 0, g), v0, ai); ai = MFMA16(frag_nat(LPM + dir * 64 * 72, 72, 16 * m + r, 32, g), v1, ai);
                au = MFMA16(frag_nat(LKW + dir * 64 * 72, 72, rowp(m, r), 0, g), v0, au); au = MFMA16(frag_nat(LKW + dir * 64 * 72, 72, rowp(m, r), 32, g), v1, au);
                *(u2v*)(Ig + m * 256) = pk4(ai); *(u2v*)(Ug + m * 256) = pk4(au); }
        }
    }
}
constexpr int MS_LQS = 0, MS_LVEC = 9216, MS_WSCR = 10304;
__device__ __forceinline__ void ml_scan_seq(Frame& F, int seq, int h, int dir, int esl0, int nact) {
    const int lane = F.lane, w = F.wave, r = lane & 15, g = lane >> 4, ws = esl0 + w;
    if (w >= nact) return;
    LAS float* WS = (LAS float*)(F.lds + MS_WSCR) + w * 192;
    const int NC = seq < 16 ? 4 : 16, ck0 = seq < 16 ? seq * 4 : 64 + (seq - 16) * 16, rowS = seq_row0(seq);
    bf16_t* O = (bf16_t*)(F.slab_() + (dir ? SLAB_FULL : 0));
    f32x4 Cacc[4]; float nst = 0.f, mst = 0.f;
    if (seq >= 16) { const size_t sidx = (size_t)((seq - 16) * 2 + dir) * 8 + h; const float* c0 = F.inp(I_SC) + sidx * 8192 + 16 * ws + r;
#pragma unroll
        for (int j = 0; j < 4; ++j)
#pragma unroll
            for (int i = 0; i < 4; ++i) Cacc[j][i] = c0[(32 * (j >> 1) + 8 * g + 4 * (j & 1) + i) * 128];
        nst = F.inp(I_SN)[sidx * 64 + lane]; mst = F.inp(I_SM)[sidx]; }
    else {
#pragma unroll
        for (int j = 0; j < 4; ++j) Cacc[j] = (f32x4){0.f, 0.f, 0.f, 0.f}; }
    struct MStage { bf16x8_t qf[4][2]; f32x4 vt[3]; float ks, bl, wm; u2v I[4], U[4]; };
    constexpr int PD = 2;
    MStage st[PD];
#define MS_LOAD(S, n) do { const int ckn = ck0 + (dir ? NC - 1 - (n) : (n)); const size_t tk = (size_t)ckn * 8 + h, cd = tk * 2 + dir; \
        const bf16_t* gQ = (const bf16_t*)(F.big_() + BIG_MQS) + tk * 4096 + r * 64 + 8 * g; const float* gV = (const float*)(F.big_() + BIG_MVEC) + cd * 272; \
        _Pragma("unroll") for (int m = 0; m < 4; ++m) { S.qf[m][0] = *(const bf16x8_t*)(gQ + m * 1024); S.qf[m][1] = *(const bf16x8_t*)(gQ + m * 1024 + 32); } \
        _Pragma("unroll") for (int q = 0; q < 3; ++q) S.vt[q] = *(const f32x4*)(gV + q * 64 + r * 4); \
        S.ks = gV[192 + lane]; S.bl = gV[256]; S.wm = gV[257]; \
        const bf16_t* gI = (const bf16_t*)(F.big_() + BIG_MINTRA) + cd * 8192 + (size_t)ws * 1024 + lane * 4; const bf16_t* gU = (const bf16_t*)(F.big_() + BIG_MU) + cd * 8192 + (size_t)ws * 1024 + lane * 4; \
        _Pragma("unroll") for (int m = 0; m < 4; ++m) { S.I[m] = *(const u2v*)(gI + m * 256); S.U[m] = *(const u2v*)(gU + m * 256); } } while (0)
#pragma unroll
    for (int k = 0; k < PD; ++k) MS_LOAD(st[k], k);
    for (int n0 = 0; n0 < NC; n0 += PD) {
#pragma unroll
      for (int k = 0; k < PD; ++k) { const int n = n0 + k; const int ckc = ck0 + (dir ? NC - 1 - n : n);
        WS[lane] = nst;
        const f32x4 na0 = *(const LAS f32x4*)(WS + 8 * g), na1 = *(const LAS f32x4*)(WS + 8 * g + 4), nb0 = *(const LAS f32x4*)(WS + 32 + 8 * g), nb1 = *(const LAS f32x4*)(WS + 32 + 8 * g + 4);
        float qn[4];
#pragma unroll
        for (int m = 0; m < 4; ++m) { const bf16x8_t qa = st[k].qf[m][0], qb = st[k].qf[m][1]; float p = 0.f;
#pragma unroll
            for (int e = 0; e < 4; ++e) { p += bf2f((unsigned short)qa[e]) * na0[e]; p += bf2f((unsigned short)qa[4 + e]) * na1[e]; p += bf2f((unsigned short)qb[e]) * nb0[e]; p += bf2f((unsigned short)qb[4 + e]) * nb1[e]; }
            p += __shfl_xor(p, 16); p += __shfl_xor(p, 32); qn[m] = p; }
#pragma unroll
        for (int m = 0; m < 4; ++m) { const float bc = st[k].vt[0][m], dm = st[k].vt[1][m], rs = st[k].vt[2][m];
            const float mt = fmaxf(bc + mst, dm), inter = __expf(bc + mst - mt), rr = __expf(dm - mt);
            const float inv = __builtin_amdgcn_rcpf(fmaxf(fabsf(inter * qn[m] + rr * rs), __expf(-mt)));
            if (g == 0) { WS[64 + 16 * m + r] = inter * inv; WS[128 + 16 * m + r] = rr * inv; } }
        const bf16x8_t Cb0 = pack_acc(Cacc[0], Cacc[1]), Cb1 = pack_acc(Cacc[2], Cacc[3]);
#pragma unroll
        for (int m = 0; m < 4; ++m) { f32x4 qc = (f32x4){0.f, 0.f, 0.f, 0.f};
            qc = MFMA16(st[k].qf[m][0], Cb0, qc); qc = MFMA16(st[k].qf[m][1], Cb1, qc);
            const f32x4 ac = *(const LAS f32x4*)(WS + 64 + 16 * m + 4 * g), bcf = *(const LAS f32x4*)(WS + 128 + 16 * m + 4 * g);
            const f32x4 hv = ac * qc + bcf * up4(st[k].I[m]);
            bf16_t* op = O + (size_t)(rowS + (ckc - ck0) * 64 + 16 * m + 4 * g) * D + h * 128 + 16 * ws + r;
            const unsigned p01 = cvtpk(hv[0], hv[1]), p23 = cvtpk(hv[2], hv[3]);
            op[0] = (bf16_t)p01; op[(size_t)D] = (bf16_t)(p01 >> 16); op[(size_t)2 * D] = (bf16_t)p23; op[(size_t)3 * D] = (bf16_t)(p23 >> 16); }
        const float bl = st[k].bl, wm = st[k].wm, mn = fmaxf(bl + mst, wm), dec = __expf(bl + mst - mn), fw = __expf(wm - mn);
#pragma unroll
        for (int j = 0; j < 4; ++j) Cacc[j] = Cacc[j] * dec + up4(st[k].U[j]) * fw;
        nst = dec * nst + fw * st[k].ks; mst = mn;
        if (n + PD < NC) MS_LOAD(st[k], n + PD);
      }
    }
#undef MS_LOAD
    if (seq < 16) { const size_t sidx = (size_t)(seq * 2 + dir) * 8 + h; float* nc = F.out + O_NC + sidx * 8192 + 16 * ws + r;
#pragma unroll
        for (int j = 0; j < 4; ++j)
#pragma unroll
            for (int i = 0; i < 4; ++i) nc[(32 * (j >> 1) + 8 * g + 4 * (j & 1) + i) * 128] = Cacc[j][i];
        if (w == 0) { F.out[O_NN + sidx * 64 + lane] = nst; if (lane == 0) F.out[O_NM + sidx] = mst; } }
}
__device__ __forceinline__ bool ml_scan_slot(int wg, int rnd, int& seq, int& h, int& dir, int& esl0, int& nact) {
    int id;
    if (wg < 64) { if (rnd) return false; id = wg >> 1; esl0 = (wg & 1) * 4; nact = 4; seq = 16 + id / 16; }
    else { if (wg >= 160) return false; id = (wg - 64) + rnd * 96; if (id >= 256) return false; esl0 = 0; nact = 8; seq = id / 16; }
    h = (id >> 1) & 7; dir = id & 1; return true;
}
__device__ __forceinline__ void ph_ml_scan2(Frame& F) {
    for (int rnd = 0; rnd < 3; ++rnd) { int seq, h, dir, esl0, nact; if (!ml_scan_slot(F.wg, rnd, seq, h, dir, esl0, nact)) break; ml_scan_seq(F, seq, h, dir, esl0, nact); }
}
__device__ __forceinline__ void ph_post(Frame& F, int NP, int gate_col0, int gate_kind, const float* nw) {
    const bf16_t* P = (const bf16_t*)(F.big_() + BIG_PROJ); const bf16_t* OF = (const bf16_t*)F.slab_(); const bf16_t* OB = (const bf16_t*)(F.slab_() + SLAB_FULL); bf16_t* OG = (bf16_t*)(F.big_() + BIG_OG);
    const int gw = F.wg * NWAVES + F.wave, NGW = F.G * NWAVES, lane = F.lane;
    const f32x2 w = *(const f32x2*)(nw + 2 * lane);
    constexpr int IU = 6;
    for (int ib = gw; ib < MTOT * 8; ib += IU * NGW) {
        f32x2 v[IU]; unsigned zz[IU];
#pragma unroll
        for (int q = 0; q < IU; ++q) { const int it = ib + q * NGW; const bool ok = it < MTOT * 8; const int row = ok ? it >> 3 : 0, h = it & 7; const size_t o = (size_t)row * D + h * 128 + 2 * lane;
            { const unsigned uf = *(const unsigned*)(OF + o), ub = *(const unsigned*)(OB + o); v[q] = (f32x2){bf2f(uf & 0xffffu) + bf2f(ub & 0xffffu), bf2f(uf >> 16) + bf2f(ub >> 16)}; } zz[q] = *(const unsigned*)(P + (size_t)row * NP + gate_col0 + h * 128 + 2 * lane); }
#pragma unroll
        for (int q = 0; q < IU; ++q) { const int it = ib + q * NGW; if (it >= MTOT * 8) continue; const int row = it >> 3, h = it & 7; const size_t o = (size_t)row * D + h * 128 + 2 * lane;
            const float rstd = rsqrtf(wave_sum(v[q][0] * v[q][0] + v[q][1] * v[q][1]) * (1.f / 128.f) + EPS);
            const float z0 = bf2f(zz[q] & 0xffffu), z1 = bf2f(zz[q] >> 16);
            const float g0 = gate_kind == 0 ? silu_f(z0) : sigmoid_f(z0), g1 = gate_kind == 0 ? silu_f(z1) : sigmoid_f(z1);
            st4_wt(OG + o, cvtpk(v[q][0] * rstd * w[0] * g0, v[q][1] * rstd * w[1] * g1)); }
    }
}

#define R(cls, call) do { call; if (PROBE_MASK & (1 << (cls))) { call; } } while (0)
constexpr int NPHASES = 36;
__global__ void __launch_bounds__(NTHR, 2) mega(Args args) {
    extern __shared__ __attribute__((aligned(16))) unsigned char lds_raw[];
    Frame F;
    F.out = args.out; F.ws = args.ws; F.lds = (LAS unsigned char*)lds_raw;
    F.tid = threadIdx.x; F.lane = F.tid & 63; F.wave = __builtin_amdgcn_readfirstlane(F.tid >> 6); F.G = gridDim.x; F.wg = blockIdx.x;
    volatile LAS unsigned* MISC = (volatile LAS unsigned*)(F.lds + MISC_OFF);
    if (F.tid < 64) MISC[F.tid] = 0u;
    if (F.tid >= 64 && F.tid < 64 + N_IN) ((LAS unsigned long long*)(F.lds + PTR_OFF))[F.tid - 64] = (unsigned long long)args.in[F.tid - 64];
    __syncthreads();
    const int lo = args.ph_lo, hi = args.ph_hi;
    XcdBarrier bar; bar.bar = (unsigned*)(args.ws + WS_CTL); bar.x = 0; bar.st = MISC + 8;
    if (hi - lo > 1) bar = xcd_barrier_post((unsigned*)(args.ws + WS_CTL), MISC + 8);
    int ph = 0;
#define PH_BEGIN if (ph >= lo && ph < hi) {
#define PH_END   if (ph + 1 < hi) xcd_barrier(bar); } ++ph;
#define PH_END_PRE(Bexpr, ldb) if (ph + 1 < hi) xcd_barrier_pre(bar, F.lds, Bexpr, ldb); } ++ph;
    #define in_nmix F.inp(I_NMIX)
#define in_nffn F.inp(I_NFFN)

    PH_BEGIN R(4, ph_prologue(F)); PH_END
    PH_BEGIN R(3, ph_wcs(F)); ph_norm(F, -1, 0, nullptr, 0, 0, 1.f, 1.f, 0, 0, in_nmix, true, 64); PH_END
#define MIX_FOURIER(j) \
    PH_BEGIN R(3, ph_f1(F, j)); PH_END \
    PH_BEGIN R(3, ph_f2(F)); PH_END
#define FFN_BLOCK(l, mbias, nsc, nss, sc_c, sc_s) \
    PH_BEGIN ph_norm(F, l, 2, mbias, nsc, nss, sc_c, sc_s, l, 3, in_nffn + (l) * D); PH_END_PRE(firstB_up(F, l), D) \
    PH_BEGIN ph_ffn_up(F, l); PH_END \
    PH_BEGIN R(2, ph_ffn_conv(F, l)); PH_END_PRE(firstB_slab(F, (const bf16_t*)(F.big_() + BIG_ACT), DFF, F.wt_() + WT_DN + (size_t)(l) * D * DFF * 2), DFF) \
    PH_BEGIN ph_gemm_slab(F, (const bf16_t*)(F.big_() + BIG_ACT), DFF, F.wt_() + WT_DN + (size_t)(l) * D * DFF * 2); PH_END
    MIX_FOURIER(0)
    FFN_BLOCK(0, F.inp(I_FB), 1, 4, 1.f / 256.f, 1.f / 512.f)
    PH_BEGIN ph_norm(F, 0, 5, nullptr, 2, 2, 1.f, 1.f, 1, 0, in_nmix + 1 * D); PH_END_PRE(firstB_proj(F, F.wt_() + WT_DIN, 16), D)
    PH_BEGIN ph_proj(F, F.wt_() + WT_DIN, 16); PH_END
    PH_BEGIN R(5, ph_dn_prep2(F)); PH_END
    PH_BEGIN R(0, ph_dn_scan2(F)); PH_END
    PH_BEGIN R(7, ph_post(F, 4096, 3072, 0, F.inp(I_DNORM))); PH_END_PRE(firstB_slab(F, (const bf16_t*)(F.big_() + BIG_OG), D, F.wt_() + WT_DOUT), D)
    PH_BEGIN ph_gemm_slab(F, (const bf16_t*)(F.big_() + BIG_OG), D, F.wt_() + WT_DOUT); PH_END
    FFN_BLOCK(1, nullptr, 2, 2, 1.f, 1.f)
    PH_BEGIN ph_norm(F, 1, 5, nullptr, 2, 2, 1.f, 1.f, 2, 0, in_nmix + 2 * D); PH_END_PRE(firstB_proj(F, F.wt_() + WT_MIN, 12), D)
    PH_BEGIN ph_proj(F, F.wt_() + WT_MIN, 12); PH_END
    PH_BEGIN R(6, ph_ml_prep(F)); PH_END_PRE(firstB_og(F), D)
    PH_BEGIN R(0, ph_ml_scan2(F)); ph_ml_ogate(F); PH_END
    PH_BEGIN R(7, ph_post(F, 3072, 2048, 1, F.inp(I_MNORM))); PH_END_PRE(firstB_slab(F, (const bf16_t*)(F.big_() + BIG_OG), D, F.wt_() + WT_MOUT), D)
    PH_BEGIN ph_gemm_slab(F, (const bf16_t*)(F.big_() + BIG_OG), D, F.wt_() + WT_MOUT); PH_END
    FFN_BLOCK(2, nullptr, 2, 2, 1.f, 1.f)
    PH_BEGIN ph_norm(F, 2, 5, nullptr, 2, 2, 1.f, 1.f, 3, 0, in_nmix + 3 * D); PH_END
    MIX_FOURIER(1)
    FFN_BLOCK(3, F.inp(I_FB) + D, 1, 4, 1.f / 256.f, 1.f / 512.f)
    PH_BEGIN ph_norm(F, 3, 5, nullptr, 2, 2, 1.f, 1.f, -1, 0, F.inp(I_NFIN)); PH_END
}

extern "C" void kernel_launch(void* const* d_in, const int* in_sizes, int n_in, void* d_out, int out_size, void* d_ws, size_t ws_size, hipStream_t stream) {
    static int grid = 0;
    if (grid == 0) {
        if (n_in != N_IN || ws_size < WS_END) { fprintf(stderr, "kernel_launch: unexpected n_in %d / ws %zu (need %zu)\n", n_in, ws_size, (size_t)WS_END); grid = -1; return; }
        int dev = 0, cus = 0, per_cu = 0;
        (void)hipGetDevice(&dev); (void)hipDeviceGetAttribute(&cus, hipDeviceAttributeMultiprocessorCount, dev);
        (void)hipFuncSetAttribute((const void*)mega, hipFuncAttributeMaxDynamicSharedMemorySize, LDS_BYTES);
        if (hipOccupancyMaxActiveBlocksPerMultiprocessor(&per_cu, (const void*)mega, NTHR, LDS_BYTES) != hipSuccess || per_cu < 1) per_cu = 1;
        (void)hipGetLastError();
        (void)cus; grid = 256;
    }
    if (grid < 0) return;
    (void)hipMemsetAsync((char*)d_ws + WS_CTL, 0, ZERO_BYTES, stream);
    Args a{};
    for (int i = 0; i < N_IN; ++i) a.in[i] = (const float*)d_in[i];
    a.out = (float*)d_out; a.ws = (unsigned char*)d_ws;
#if N_LAUNCH_MODE == 1
    a.ph_lo = 0; a.ph_hi = NPHASES;
    void* kargs[] = {&a};
    hipError_t e = hipLaunchCooperativeKernel((const void*)mega, dim3(grid), dim3(NTHR), kargs, LDS_BYTES, stream);
    if (e != hipSuccess) fprintf(stderr, "cooperative launch failed: %s (grid %d)\n", hipGetErrorString(e), grid);
#else
    for (int p = 0; p < NPHASES; ++p) { a.ph_lo = p; a.ph_hi = p + 1; hipLaunchKernelGGL(mega, dim3(grid), dim3(NTHR), LDS_BYTES, stream, a); }
#endif
}
```

```cpp
#include <hip/hip_runtime.h>
#include <cstdint>
#include <cstdio>

#ifndef PROBE_MASK
#define PROBE_MASK 0
#endif
#ifndef N_LAUNCH_MODE
#define N_LAUNCH_MODE 1
#endif

#define LAS __attribute__((address_space(3)))
#define GAS __attribute__((address_space(1)))
typedef unsigned short bf16_t;
typedef float f32x4 __attribute__((ext_vector_type(4)));
typedef float f32x2 __attribute__((ext_vector_type(2)));
typedef unsigned u4v __attribute__((ext_vector_type(4)));
typedef unsigned u2v __attribute__((ext_vector_type(2)));
typedef __bf16 bf16x2_t __attribute__((ext_vector_type(2)));
__device__ __forceinline__ unsigned cvtpk(float lo, float hi) { const f32x2 v = {lo, hi}; return __builtin_bit_cast(unsigned, __builtin_convertvector(v, bf16x2_t)); }

constexpr int D = 1024, MCTX = 4096, MTOT = 6144;
constexpr int DFF = 2816, NUP = 5632;
constexpr int DN_PROJ = 4128, ML_PROJ = 3104;
constexpr int NWAVES = 8, NTHR = 512;
constexpr float EPS = 1e-6f;
enum { I_XP = 0, I_XS, I_SD, I_SC, I_SN, I_SM, I_C, I_CCTX, I_WADA, I_BADA, I_NMIX, I_NFFN, I_NFIN, I_WUP, I_CW, I_CB, I_WDN,
       I_FW, I_FB, I_DWIN, I_DCW, I_DALOG, I_DDT, I_DNORM, I_DWOUT, I_MWIN, I_MBI, I_MBF, I_MNORM, I_MWOUT, N_IN };
constexpr size_t O_Y = 0, O_ND = 6291456, O_NC = 10485760, O_NN = 12582912, O_NM = 12599296;

constexpr size_t WS_CTL = 0;
constexpr size_t CTL_BYTES = 65536;
constexpr size_t ZERO_BYTES = CTL_BYTES;
constexpr size_t WS_MOD = WS_CTL + CTL_BYTES;
constexpr size_t MOD_BYTES = 4 * 3 * 6144 * 4;
constexpr size_t WS_X = WS_MOD + MOD_BYTES;
constexpr size_t WS_H = WS_X + (size_t)MTOT * D * 4;
constexpr size_t WS_TAB = WS_H + (size_t)MTOT * D * 2;
constexpr size_t TAB_CS256 = 0, TAB_CST256 = 512 * 256 * 2, TAB_CST1024 = TAB_CST256 + 256 * 512 * 2, TAB_BYTES = TAB_CST1024 + 1024 * 2048 * 2;
constexpr size_t WS_WT = WS_TAB + TAB_BYTES;
constexpr size_t WT_UP = 0;
constexpr size_t WT_DN = WT_UP + (size_t)4 * NUP * D * 2;
constexpr size_t WT_F = WT_DN + (size_t)4 * D * DFF * 2;
constexpr size_t WT_CS = WT_F + (size_t)2 * D * D * 2;
constexpr size_t WT_DIN = WT_CS + (size_t)2 * 2048 * D * 2;
constexpr size_t WT_DOUT = WT_DIN + (size_t)4352 * D * 2;
constexpr size_t WT_MIN = WT_DOUT + (size_t)D * D * 2;
constexpr size_t WT_MOUT = WT_MIN + (size_t)3328 * D * 2;
constexpr size_t WT_BYTES = WT_MOUT + (size_t)D * D * 2;
constexpr size_t WS_SLAB = WS_WT + WT_BYTES;
constexpr size_t SLAB_FULL = (size_t)MTOT * D * 4, SLAB_SMP = (size_t)2048 * D * 4;
constexpr size_t WS_BIG = WS_SLAB + 2 * SLAB_FULL + 2 * SLAB_SMP;
constexpr size_t BIG_UG = 0;
constexpr size_t BIG_ACT = BIG_UG + (size_t)MTOT * NUP * 2;
constexpr size_t BIG_ZTC = 0;
constexpr size_t BIG_ZTS = BIG_ZTC + (size_t)16 * 1024 * 512 * 2;
constexpr size_t BIG_PROJ = 0;
constexpr size_t BIG_GATES = BIG_PROJ + (size_t)MTOT * 4096 * 2;
constexpr size_t BIG_OG = BIG_GATES + (size_t)MTOT * 32 * 4;
constexpr size_t BIG_WN = BIG_OG + (size_t)MTOT * D * 2;
constexpr size_t BIG_QKM = BIG_WN + (size_t)1536 * 8192 * 2;
constexpr size_t BIG_U = BIG_QKM + (size_t)1536 * 4096 * 2;
constexpr size_t BIG_VEC = BIG_U + (size_t)1536 * 8192 * 4;
constexpr size_t BIG_QS = BIG_VEC + (size_t)1536 * 192 * 4;
constexpr size_t BIG_KTG = BIG_QS + (size_t)768 * 8192 * 2;
constexpr size_t BIG_END_DN = BIG_KTG + (size_t)768 * 8192 * 2;
constexpr size_t BIG_END = BIG_END_DN > (size_t)MTOT * NUP * 2 + (size_t)MTOT * DFF * 2 ? BIG_END_DN : (size_t)MTOT * NUP * 2 + (size_t)MTOT * DFF * 2;
constexpr size_t BIG_Q = 0, BIG_K = 0, BIG_V = 0, BIG_GA = 0, BIG_BE = 0;
constexpr size_t WS_END = WS_BIG + BIG_END;

constexpr int LDS_BYTES = 131072 + 1024 + 4096;
constexpr int MISC_OFF = 131072;

__device__ __forceinline__ unsigned f2bf(float f) { unsigned u = __builtin_bit_cast(unsigned, f); return (u + 0x7fffu + ((u >> 16) & 1u)) >> 16; }
__device__ __forceinline__ float bf2f(unsigned h) { return __builtin_bit_cast(float, h << 16); }
__device__ __forceinline__ unsigned pk2(float lo, float hi) { return cvtpk(lo, hi); }
__device__ __forceinline__ float dpp_add(float v, const int ctrl_sel) {
    int s;
    switch (ctrl_sel) {
        case 0: s = __builtin_amdgcn_update_dpp(0, __builtin_bit_cast(int, v), 0xB1, 0xF, 0xF, true); break;
        case 1: s = __builtin_amdgcn_update_dpp(0, __builtin_bit_cast(int, v), 0x4E, 0xF, 0xF, true); break;
        case 2: s = __builtin_amdgcn_update_dpp(0, __builtin_bit_cast(int, v), 0x141, 0xF, 0xF, true); break;
        default: s = __builtin_amdgcn_update_dpp(0, __builtin_bit_cast(int, v), 0x140, 0xF, 0xF, true); break;
    }
    return v + __builtin_bit_cast(float, s);
}
__device__ __forceinline__ float wave_sum(float v) {
    v = dpp_add(v, 0); v = dpp_add(v, 1); v = dpp_add(v, 2); v = dpp_add(v, 3);
    const int iv = __builtin_bit_cast(int, v);
    const float r0 = __builtin_bit_cast(float, __builtin_amdgcn_readlane(iv, 0)), r1 = __builtin_bit_cast(float, __builtin_amdgcn_readlane(iv, 16));
    const float r2 = __builtin_bit_cast(float, __builtin_amdgcn_readlane(iv, 32)), r3 = __builtin_bit_cast(float, __builtin_amdgcn_readlane(iv, 48));
    return (r0 + r1) + (r2 + r3);
}
__device__ __forceinline__ float silu_f(float x) { return x * __builtin_amdgcn_rcpf(1.f + __expf(-x)); }
__device__ __forceinline__ float sigmoid_f(float x) { return __builtin_amdgcn_rcpf(1.f + __expf(-x)); }
__device__ __forceinline__ float softplus_f(float x) { return x > 20.f ? x : log1pf(expf(x)); }
__device__ __forceinline__ float logsigmoid_f(float x) { return fminf(x, 0.f) - log1pf(expf(-fabsf(x))); }
__device__ __forceinline__ int row_cond(int r) { return r < MCTX ? 0 : 1 + ((r - MCTX) >> 10); }
__device__ __forceinline__ void row_seq(int r, int& seq, int& t, int& T) {
    if (r < MCTX) { seq = r >> 8; t = r & 255; T = 256; } else { seq = 16 + ((r - MCTX) >> 10); t = (r - MCTX) & 1023; T = 1024; }
}
__device__ __forceinline__ int seq_row0(int seq) { return seq < 16 ? seq * 256 : MCTX + (seq - 16) * 1024; }
__device__ __forceinline__ int seq_len(int seq) { return seq < 16 ? 256 : 1024; }

#define XB_TMO      128
#define XB_XCNT(j)  (256  + 64 * (j))
#define XB_XSUB(j)  (1280 + 64 * (j))
#define XB_XGEN(j)  (2304 + 64 * (j))
#define XB_TOP      3328
#define XB_TOPGEN   3392
#define XCD_BAR_WORDS 3456
#define XB_SPIN_CAP (1u << 20)
__device__ __forceinline__ unsigned xb_ld(unsigned* p)              { return __hip_atomic_load(p, __ATOMIC_RELAXED, __HIP_MEMORY_SCOPE_AGENT); }
__device__ __forceinline__ unsigned xb_add(unsigned* p, unsigned v) { return __hip_atomic_fetch_add(p, v, __ATOMIC_RELAXED, __HIP_MEMORY_SCOPE_AGENT); }
__device__ __forceinline__ unsigned xb_xcc_id() { return (unsigned)__builtin_amdgcn_s_getreg((3 << 11) | 20) & 0xFu; }
#define XB_SPIN(cond, bar) do { unsigned _sp = 0; while (cond) { __builtin_amdgcn_s_sleep(1); \
    if ((++_sp & 255u) == 0u) { if (xb_ld(&(bar)[XB_TMO])) break; if (_sp > XB_SPIN_CAP) { atomicAdd(&(bar)[XB_TMO], 1u); break; } } } } while (0)
struct XcdBarrier { unsigned* bar; unsigned x; volatile LAS unsigned* st; };
__device__ __forceinline__ XcdBarrier xcd_barrier_post(unsigned* bar, volatile LAS unsigned* st) {
    XcdBarrier b; b.bar = bar; b.x = xb_xcc_id(); b.st = st;
    if (threadIdx.x == 0) (void)xb_add(&bar[XB_XCNT(b.x)], 1u);
    return b;
}
__device__ __forceinline__ void xcd_barrier_complete(unsigned* bar, unsigned x, unsigned& nloc, unsigned& nx) {
    const unsigned G = gridDim.x * gridDim.y * gridDim.z;
    unsigned sum, cnt, mine, sp = 0u;
    for (;;) {
        sum = 0u; cnt = 0u; mine = 0u;
#pragma unroll
        for (unsigned j = 0; j < 16; ++j) { const unsigned c = xb_ld(&bar[XB_XCNT(j)]); sum += c; cnt += (c > 0u) ? 1u : 0u; mine = (j == x) ? c : mine; }
        if (sum == G) break;
        __builtin_amdgcn_s_sleep(1);
        if ((++sp & 255u) == 0u) { if (xb_ld(&bar[XB_TMO])) break; if (sp > XB_SPIN_CAP) { atomicAdd(&bar[XB_TMO], 1u); break; } }
    }
    nloc = mine > 0u ? mine : 1u; nx = cnt > 0u ? cnt : 1u;
}
__device__ __forceinline__ void xcd_barrier(const XcdBarrier& b) {
    asm volatile("s_waitcnt vmcnt(0)" ::: "memory");
    __syncthreads();
    if (threadIdx.x == 0) {
        unsigned* bar = b.bar;
        __builtin_amdgcn_s_waitcnt(0);
        unsigned nloc = b.st[0], nx = b.st[1];
        if (nloc == 0u) { xcd_barrier_complete(bar, b.x, nloc, nx); b.st[0] = nloc; b.st[1] = nx; }
        const unsigned old = xb_add(&bar[XB_XSUB(b.x)], 1u);
        const unsigned gen = old / nloc;
        if (old + 1u == (gen + 1u) * nloc) {
            __builtin_amdgcn_fence(__ATOMIC_RELEASE, "agent");
            asm volatile("s_waitcnt vmcnt(0)" ::: "memory");
            const unsigned og = xb_add(&bar[XB_TOP], 1u);
            const unsigned tg = og / nx;
            if (og + 1u == (tg + 1u) * nx) xb_add(&bar[XB_TOPGEN], 1u);
            else XB_SPIN(xb_ld(&bar[XB_TOPGEN]) == tg, bar);
            __builtin_amdgcn_fence(__ATOMIC_ACQUIRE, "agent");
            xb_add(&bar[XB_XGEN(b.x)], 1u);
            asm volatile("s_waitcnt vmcnt(0)" ::: "memory");
        } else {
            XB_SPIN(xb_ld(&bar[XB_XGEN(b.x)]) == gen, bar);
            __builtin_amdgcn_fence(__ATOMIC_ACQUIRE, "agent");
            asm volatile("s_waitcnt vmcnt(0)" ::: "memory");
        }
    }
    __syncthreads();
}

namespace pg8 {
typedef short bf16x8 __attribute__((ext_vector_type(8)));
typedef unsigned u32x4 __attribute__((ext_vector_type(4)));
constexpr int BM = 256, BK = 64, HALF = 128, HTB = HALF * BK * 2, STAGE_BYTES = 8 * HTB, NXCD = 8, WGM = 8;
__device__ __forceinline__ int lds_byte(int r, int c) { const int st = (r >> 4) * 2 + (c >> 5), rr = r & 15, cc = c & 31, ob = rr * 64 + cc * 2; return st * 1024 + (ob ^ (((ob >> 9) & 1) << 5)); }
__device__ __forceinline__ void stage_rc(int b, int& R, int& C) { const int st = b / 1024, sb = b % 1024, swz = sb ^ (((sb >> 9) & 1) << 5); R = (st >> 1) * 16 + swz / 64; C = (st & 1) * 32 + (swz % 64) / 2; }
__device__ __forceinline__ int perm32(int rho) { const int n = rho >> 4, i = rho & 15; return 8 * (i >> 2) + 4 * n + (i & 3); }
__device__ __forceinline__ unsigned cvt_pk_bf16(float lo, float hi) { unsigned r; asm volatile("v_cvt_pk_bf16_f32 %0, %1, %2" : "=v"(r) : "v"(lo), "v"(hi)); return r; }

struct Unit { const char* A; const char* B; char* out; int nt, ldc, flag, row0; };
__device__ __forceinline__ bool tile_order(int L, int nM, int nN, int& pm, int& pn) {
    const int nwg = nM * nN; if (L >= nwg || L < 0) return false;
    int wgid = L; { const int q = nwg / NXCD, r = nwg % NXCD, xcd = wgid % NXCD, off = wgid / NXCD; wgid = (xcd < r ? xcd * (q + 1) : r * (q + 1) + (xcd - r) * q) + off; }
    const int nig = WGM * nN, gid = wgid / nig, fm = gid * WGM, gsz = (nM - fm) < WGM ? (nM - fm) : WGM;
    pm = fm + ((wgid % nig) % gsz); pn = (wgid % nig) / gsz; return true;
}
struct SchedPlain {
    int G, c, nM, nN, ns, lda, ldb, ldc, nt, osz, gate_pn, lim; const char* A; const char* B; char* O; size_t osplit;
    __device__ __forceinline__ bool next(int i, Unit& u) const {
        int pm, pq; if (i * G + c >= lim || !tile_order(i * G + c, nM, nN * ns, pm, pq)) return false;
        const int pn = pq % nN, ks = pq / nN;
        u.A = A + ((size_t)pm * 256 * lda + (size_t)ks * nt * 64) * 2; u.B = B + ((size_t)pn * 256 * ldb + (size_t)ks * nt * 64) * 2;
        u.out = O + (size_t)ks * osplit + ((size_t)pm * 256 * ldc + (size_t)pn * 256) * osz; u.nt = nt; u.ldc = ldc; u.flag = (pn == gate_pn) ? 1 : 0; u.row0 = pm * 256; return true;
    }
};
struct EpiF32 {
    static constexpr bool PERM = false;
    __device__ __forceinline__ void operator()(const f32x4 (&acc)[2][2][4][2], const Unit& u, int wr, int wc, int fr, int fq) const {
        char* outp = u.out; asm volatile("" : "+v"(outp)); GAS float* C = (GAS float*)outp; int tl = threadIdx.x; asm volatile("" : "+v"(tl)); fr = tl & 15; fq = (tl >> 4) & 3; const int row0 = wr * 64 + fr; const int col0 = wc * 32 + 4 * fq;
#pragma unroll
        for (int ai = 0; ai < 2; ++ai)
#pragma unroll
            for (int m = 0; m < 4; ++m) { GAS float* rowp = C + (size_t)(row0 + ai * HALF + m * 16) * u.ldc + col0;
#pragma unroll
                for (int bj = 0; bj < 2; ++bj)
#pragma unroll
                    for (int n = 0; n < 2; ++n) *(GAS f32x4*)(rowp + bj * HALF + n * 16) = acc[ai][bj][m][n]; }
    }
};
template <int OFF> __device__ __forceinline__ void st16_wt(GAS u32x4* p, const u32x4& v) { asm volatile("global_store_dwordx4 %0, %1, off offset:%2 sc1\n\ts_nop 1" :: "v"(p), "v"(v), "n"(OFF) : "memory"); }
struct EpiBf16 {
    static constexpr bool PERM = true;
    float* gates;
    __device__ __forceinline__ void operator()(const f32x4 (&acc)[2][2][4][2], const Unit& u, int wr, int wc, int fr, int fq) const {
        int tl = threadIdx.x; asm volatile("" : "+v"(tl)); fr = tl & 15; fq = (tl >> 4) & 3; const int row0 = wr * 64 + fr; const int col0 = wc * 32 + 8 * fq;
        if (u.flag) {
            if (wc == 0) {
#pragma unroll
                for (int ai = 0; ai < 2; ++ai)
#pragma unroll
                    for (int m = 0; m < 4; ++m) { GAS float* gp = (GAS float*)gates + (size_t)(u.row0 + row0 + ai * HALF + m * 16) * 32 + 8 * fq;
                        *(GAS f32x4*)gp = acc[ai][0][m][0]; *(GAS f32x4*)(gp + 4) = acc[ai][0][m][1]; }
            }
            return;
        }
        char* outp = u.out; asm volatile("" : "+v"(outp)); GAS bf16_t* O = (GAS bf16_t*)outp;
#pragma unroll
        for (int ai = 0; ai < 2; ++ai)
#pragma unroll
            for (int m = 0; m < 4; ++m) { GAS bf16_t* rowp = O + (size_t)(row0 + ai * HALF + m * 16) * u.ldc + col0;
#pragma unroll
                for (int bj = 0; bj < 2; ++bj) { const f32x4 v0 = acc[ai][bj][m][0], v1 = acc[ai][bj][m][1];
                    u32x4 w; w.x = cvt_pk_bf16(v0[0], v0[1]); w.y = cvt_pk_bf16(v0[2], v0[3]); w.z = cvt_pk_bf16(v1[0], v1[1]); w.w = cvt_pk_bf16(v1[2], v1[3]);
                    if (bj == 0) st16_wt<0>((GAS u32x4*)rowp, w); else st16_wt<HALF * 2>((GAS u32x4*)rowp, w); } }
    }
};

template <bool PERM>
__device__ __forceinline__ void prestage_B(LAS unsigned char* lds, const char* B, int ldb) {
    const int tid = threadIdx.x, wid = __builtin_amdgcn_readfirstlane(tid >> 6), lane = tid & 63;
    if (wid == 0 || B == nullptr) return;
    const size_t hstepB = (size_t)HALF * ldb * 2;
#pragma unroll 1
    for (int pass = 0; pass < (wid == 1 ? 2 : 1); ++pass) { const int vw = pass ? 0 : wid; const unsigned ldsw = (unsigned)vw * 1024u;
#pragma unroll
        for (int i = 0; i < 2; ++i) { int R, C; stage_rc((vw * 64 + lane) * 16 + i * 8192, R, C); const int Rb = PERM ? ((R & ~31) + perm32(R & 31)) : R;
            const char* src = B + (unsigned)(Rb * ldb + C) * 2u;
            __builtin_amdgcn_global_load_lds((const unsigned*)src, (LAS unsigned*)(lds + (4 + 0) * HTB + ldsw + i * 8192), 16, 0, 0);
            __builtin_amdgcn_global_load_lds((const unsigned*)(src + hstepB), (LAS unsigned*)(lds + (4 + 1) * HTB + ldsw + i * 8192), 16, 0, 0);
            __builtin_amdgcn_global_load_lds((const unsigned*)(src + BK * 2), (LAS unsigned*)(lds + (4 + 2) * HTB + ldsw + i * 8192), 16, 0, 0);
            __builtin_amdgcn_global_load_lds((const unsigned*)(src + hstepB + BK * 2), (LAS unsigned*)(lds + (4 + 3) * HTB + ldsw + i * 8192), 16, 0, 0); } }
}
template <class Epi, class Sched, bool PRE = false>
__device__ __forceinline__ void gemm_phase(LAS unsigned char* lds, int lda, int ldb, const Sched& S, const Epi& E) {
    const int tid = threadIdx.x, wid = __builtin_amdgcn_readfirstlane(tid >> 6), lane = tid & 63, wr = wid >> 2, wc = wid & 3, fr = lane & 15, fq = lane >> 4;
    unsigned voffA[2], voffB[2];
#pragma unroll
    for (int i = 0; i < 2; ++i) { int R, C; stage_rc(tid * 16 + i * 8192, R, C); const int Rb = Epi::PERM ? ((R & ~31) + perm32(R & 31)) : R;
        voffA[i] = (unsigned)(R * lda + C) * 2u; voffB[i] = (unsigned)(Rb * ldb + C) * 2u; }
    const size_t kstep = (size_t)(BK * 2);
    const size_t hstepA = (size_t)HALF * lda * 2, hstepB = (size_t)HALF * ldb * 2;
    const unsigned ldsw = (unsigned)wid * 1024u;
    const int aoff = lds_byte(wr * 64 + fr, fq * 8), boff = lds_byte(wc * 32 + fr, fq * 8);
#define PG8_SA(b, h) (((b) * 2 + (h)) * HTB)
#define PG8_SB(b, h) ((4 + (b) * 2 + (h)) * HTB)
#define PG8_STAGE(bufoff, gbase, voff) do { _Pragma("unroll") for (int _i = 0; _i < 2; ++_i) \
        __builtin_amdgcn_global_load_lds((const unsigned*)((const char*)(gbase) + (voff)[_i]), (LAS unsigned*)(lds + (bufoff) + ldsw + _i * 8192), 16, 0, 0); } while (0)
#define PG8_LDA(dst, b, h) do { _Pragma("unroll") for (int m = 0; m < 4; ++m) _Pragma("unroll") for (int k = 0; k < 2; ++k) dst[m][k] = *(const LAS bf16x8*)(lds + PG8_SA(b, h) + aoff + m * 2048 + k * 1024); } while (0)
#define PG8_LDB(dst, b, h) do { _Pragma("unroll") for (int n = 0; n < 2; ++n) _Pragma("unroll") for (int k = 0; k < 2; ++k) dst[n][k] = *(const LAS bf16x8*)(lds + PG8_SB(b, h) + boff + n * 2048 + k * 1024); } while (0)
#define PG8_MMA(ai, bj, At, Bt) do { __builtin_amdgcn_s_setprio(1); _Pragma("unroll") for (int m = 0; m < 4; ++m) _Pragma("unroll") for (int n = 0; n < 2; ++n) _Pragma("unroll") for (int k = 0; k < 2; ++k) \
        acc[ai][bj][m][n] = __builtin_amdgcn_mfma_f32_16x16x32_bf16(Bt[n][k], At[m][k], acc[ai][bj][m][n], 0, 0, 0); __builtin_amdgcn_s_setprio(0); } while (0)
#define PG8_WAIT_V(n) asm volatile("s_waitcnt vmcnt(" #n ")" ::: "memory")
#define PG8_WAIT_L(n) asm volatile("s_waitcnt lgkmcnt(" #n ")" ::: "memory")
#define PG8_BAR __builtin_amdgcn_s_barrier()
#define PG8_SCHED __builtin_amdgcn_sched_barrier(0)
    Unit cur, nxt; int ui = 0;
    if (!S.next(0, cur)) return;
    f32x4 acc[2][2][4][2];
#pragma unroll
    for (int a = 0; a < 2; ++a)
#pragma unroll
        for (int b = 0; b < 2; ++b)
#pragma unroll
            for (int m = 0; m < 4; ++m)
#pragma unroll
                for (int n = 0; n < 2; ++n) acc[a][b][m][n] = (f32x4){0.f, 0.f, 0.f, 0.f};
    bf16x8 At[4][2], B0[2][2], B1[2][2];
    const char* cA = cur.A; const char* cB = cur.B; int nt = cur.nt;
    if constexpr (PRE) {
        PG8_STAGE(PG8_SA(0, 0), cA, voffA); PG8_STAGE(PG8_SA(0, 1), cA + hstepA, voffA);
        if (wr == 1) PG8_BAR;
        PG8_WAIT_V(2); PG8_BAR;
        PG8_STAGE(PG8_SA(1, 0), cA + kstep, voffA);
        PG8_WAIT_V(2); PG8_BAR;
    } else {
    PG8_STAGE(PG8_SB(0, 0), cB, voffB); PG8_STAGE(PG8_SB(0, 1), cB + hstepB, voffB); PG8_STAGE(PG8_SA(0, 0), cA, voffA); PG8_STAGE(PG8_SA(0, 1), cA + hstepA, voffA);
    if (wr == 1) PG8_BAR;
    PG8_WAIT_V(2); PG8_BAR;
    PG8_STAGE(PG8_SB(1, 0), cB + kstep, voffB); PG8_STAGE(PG8_SA(1, 0), cA + kstep, voffA); PG8_STAGE(PG8_SB(1, 1), cB + hstepB + kstep, voffB);
    PG8_WAIT_V(6); PG8_BAR;
    }
    for (;;) {
        const bool has_next = S.next(ui + 1, nxt);
        const char* nA = has_next ? nxt.A : cA; const char* nB = has_next ? nxt.B : cB;
        for (int t = 0; t < nt; t += 2) {
            const bool last = (t == nt - 2);
            const char* a1 = cA + (size_t)(t + 1) * kstep;
            const char* a2 = last ? nA : cA + (size_t)(t + 2) * kstep; const char* b2 = last ? nB : cB + (size_t)(t + 2) * kstep;
            const char* a3 = a2 + kstep; const char* b3 = b2 + kstep;
            PG8_LDB(B0, 0, 0); PG8_LDB(B1, 0, 1); PG8_SCHED; PG8_LDA(At, 0, 0); PG8_STAGE(PG8_SA(1, 1), a1 + hstepA, voffA);
            PG8_WAIT_V(8); PG8_WAIT_L(0); PG8_BAR; PG8_MMA(0, 0, At, B0); PG8_MMA(0, 1, At, B1); PG8_BAR; PG8_SCHED;
            PG8_LDA(At, 0, 1); PG8_STAGE(PG8_SB(0, 0), b2, voffB); PG8_STAGE(PG8_SB(0, 1), b2 + hstepB, voffB); PG8_STAGE(PG8_SA(0, 0), a2, voffA);
            PG8_WAIT_V(8); PG8_WAIT_L(0); PG8_BAR; PG8_MMA(1, 0, At, B0); PG8_MMA(1, 1, At, B1); PG8_BAR; PG8_SCHED;
            PG8_LDB(B0, 1, 0); PG8_LDB(B1, 1, 1); PG8_SCHED; PG8_LDA(At, 1, 0); PG8_STAGE(PG8_SA(0, 1), a2 + hstepA, voffA);
            PG8_WAIT_V(8); PG8_WAIT_L(0); PG8_BAR; PG8_MMA(0, 0, At, B0); PG8_MMA(0, 1, At, B1); PG8_BAR; PG8_SCHED;
            PG8_LDA(At, 1, 1); PG8_STAGE(PG8_SB(1, 0), b3, voffB); PG8_STAGE(PG8_SB(1, 1), b3 + hstepB, voffB); PG8_STAGE(PG8_SA(1, 0), a3, voffA);
            PG8_WAIT_V(8); PG8_WAIT_L(0); PG8_BAR; PG8_MMA(1, 0, At, B0); PG8_MMA(1, 1, At, B1); PG8_BAR; PG8_SCHED;
        }
        if (wr == 0) PG8_BAR;
        E(acc, cur, wr, wc, fr, fq);
        if (!has_next) break;
#pragma unroll
        for (int a = 0; a < 2; ++a)
#pragma unroll
            for (int b = 0; b < 2; ++b)
#pragma unroll
                for (int m = 0; m < 4; ++m)
#pragma unroll
                    for (int n = 0; n < 2; ++n) acc[a][b][m][n] = (f32x4){0.f, 0.f, 0.f, 0.f};
        cur = nxt; cA = nA; cB = nB; nt = cur.nt; ++ui;
        if (wr == 1) PG8_BAR;
    }
    PG8_WAIT_V(0);
    PG8_BAR;
#undef PG8_SA
#undef PG8_SB
#undef PG8_STAGE
#undef PG8_LDA
#undef PG8_LDB
#undef PG8_MMA
#undef PG8_WAIT_V
#undef PG8_WAIT_L
#undef PG8_BAR
#undef PG8_SCHED
}
}

__device__ __forceinline__ void xcd_barrier_pre(const XcdBarrier& b, LAS unsigned char* lds, const char* B, int ldb) {
    asm volatile("s_waitcnt vmcnt(0)" ::: "memory");
    __syncthreads();
    pg8::prestage_B<true>(lds, B, ldb);
    if (threadIdx.x == 0) {
        unsigned* bar = b.bar;
        __builtin_amdgcn_s_waitcnt(0);
        unsigned nloc = b.st[0], nx = b.st[1];
        if (nloc == 0u) { xcd_barrier_complete(bar, b.x, nloc, nx); b.st[0] = nloc; b.st[1] = nx; }
        const unsigned old = xb_add(&bar[XB_XSUB(b.x)], 1u);
        const unsigned gen = old / nloc;
        if (old + 1u == (gen + 1u) * nloc) {
            __builtin_amdgcn_fence(__ATOMIC_RELEASE, "agent");
            asm volatile("s_waitcnt vmcnt(0)" ::: "memory");
            const unsigned og = xb_add(&bar[XB_TOP], 1u);
            const unsigned tg = og / nx;
            if (og + 1u == (tg + 1u) * nx) xb_add(&bar[XB_TOPGEN], 1u);
            else XB_SPIN(xb_ld(&bar[XB_TOPGEN]) == tg, bar);
            __builtin_amdgcn_fence(__ATOMIC_ACQUIRE, "agent");
            xb_add(&bar[XB_XGEN(b.x)], 1u);
            asm volatile("s_waitcnt vmcnt(0)" ::: "memory");
        } else {
            XB_SPIN(xb_ld(&bar[XB_XGEN(b.x)]) == gen, bar);
            __builtin_amdgcn_fence(__ATOMIC_ACQUIRE, "agent");
            asm volatile("s_waitcnt vmcnt(0)" ::: "memory");
        }
    }
    __syncthreads();
}
struct Args { const float* in[N_IN]; float* out; unsigned char* ws; int ph_lo, ph_hi; };
constexpr int PTR_OFF = MISC_OFF + 256;
struct Frame {
    float* out; unsigned char* ws; LAS unsigned char* lds;
    int tid, lane, wave, G, wg;
    __device__ __forceinline__ const float* inp(int i) const {
        const unsigned long long v = ((const LAS unsigned long long*)(lds + PTR_OFF))[i];
        const unsigned lo = __builtin_amdgcn_readfirstlane((unsigned)v), hi = __builtin_amdgcn_readfirstlane((unsigned)(v >> 32));
        return (const float*)(const __attribute__((address_space(1))) float*)(((unsigned long long)hi << 32) | lo); }
    __device__ __forceinline__ float* mod_() const { return (float*)(ws + WS_MOD); }
    __device__ __forceinline__ bf16_t* X_() const { return (bf16_t*)(ws + WS_X); }
    __device__ __forceinline__ bf16_t* H_() const { return (bf16_t*)(ws + WS_H); }
    __device__ __forceinline__ unsigned char* slab_() const { return ws + WS_SLAB; }
    __device__ __forceinline__ unsigned char* big_() const { return ws + WS_BIG; }
    __device__ __forceinline__ unsigned char* tab_() const { return ws + WS_TAB; }
    __device__ __forceinline__ unsigned char* wt_() const { return ws + WS_WT; }
};

typedef short bf16x8_t __attribute__((ext_vector_type(8)));
typedef short bf16x4_t __attribute__((ext_vector_type(4)));
__device__ __forceinline__ bf16x8_t frag_nat(const LAS bf16_t* base, int pitch, int row, int k0, int g) { return *(const LAS bf16x8_t*)(base + row * pitch + k0 + 8 * g); }
__device__ __forceinline__ bf16x8_t frag_perm(const LAS bf16_t* base, int pitch, int row, int kb, int g) {
    const bf16x4_t lo = *(const LAS bf16x4_t*)(base + row * pitch + kb + 4 * g), hi = *(const LAS bf16x4_t*)(base + row * pitch + kb + 16 + 4 * g);
    return __builtin_shufflevector(lo, hi, 0, 1, 2, 3, 4, 5, 6, 7);
}
__device__ __forceinline__ int rowp(int t, int r) { return 32 * (t >> 1) + 8 * (r >> 2) + 4 * (t & 1) + (r & 3); }
__device__ __forceinline__ bf16x8_t frag_sw(const LAS bf16_t* base, int pitch, int row, int kc, int g) { return *(const LAS bf16x8_t*)(base + row * pitch + (((kc + g) ^ (((row >> 4) & 1) << 2)) << 3)); }
__device__ __forceinline__ bf16x8_t pack_acc(const f32x4& a, const f32x4& b) {
    typedef unsigned u32x4_t __attribute__((ext_vector_type(4)));
    u32x4_t w; w.x = cvtpk(a[0], a[1]); w.y = cvtpk(a[2], a[3]); w.z = cvtpk(b[0], b[1]); w.w = cvtpk(b[2], b[3]);
    return __builtin_bit_cast(bf16x8_t, w);
}
#define MFMA16(a, b, c) __builtin_amdgcn_mfma_f32_16x16x32_bf16((a), (b), (c), 0, 0, 0)
__device__ __forceinline__ f32x4 up4(const u2v& u) { return (f32x4){__builtin_bit_cast(float, u.x << 16), __builtin_bit_cast(float, u.x & 0xffff0000u), __builtin_bit_cast(float, u.y << 16), __builtin_bit_cast(float, u.y & 0xffff0000u)}; }
__device__ __forceinline__ u2v pk4(const f32x4& v) { u2v o; o.x = cvtpk(v[0], v[1]); o.y = cvtpk(v[2], v[3]); return o; }

__device__ __forceinline__ const bf16_t* slab_ptr(Frame& F, int s) {
    return s < 2 ? (const bf16_t*)(F.slab_() + (size_t)s * SLAB_FULL) : (const bf16_t*)(F.slab_() + 2 * SLAB_FULL + (size_t)(s - 2) * SLAB_SMP) - (size_t)MCTX * D;
}
__device__ __forceinline__ void st4_wt(void* p, unsigned v) { asm volatile("global_store_dword %0, %1, off sc1" :: "v"((GAS void*)p), "v"(v) : "memory"); }
__device__ __forceinline__ void st16f_wt(void* p, const f32x4& v) { asm volatile("global_store_dwordx4 %0, %1, off sc1\n\ts_nop 1" :: "v"((GAS void*)p), "v"(v) : "memory"); }
__device__ __forceinline__ void st8_wt(void* p, const u2v& v) { asm volatile("global_store_dwordx2 %0, %1, off sc1" :: "v"((GAS void*)p), "v"(v) : "memory"); }
__device__ __forceinline__ void st16_wt(void* p, const u4v& v) { asm volatile("global_store_dwordx4 %0, %1, off sc1\n\ts_nop 1" :: "v"((GAS void*)p), "v"(v) : "memory"); }
__device__ __forceinline__ void p0_transpose_item(const float* W, int K, int N, bf16_t* WT, LAS float* scr, int item, int lane, bool up_il = false) {
    const int nblk = N / 32, kb = item / nblk, nb = item % nblk, k0 = 64 * kb, n0 = 32 * nb;
#pragma unroll
    for (int i = 0; i < 32; ++i) { const int kk = 2 * i + (lane >> 5); scr[kk * 33 + (lane & 31)] = W[(size_t)(k0 + kk) * N + n0 + (lane & 31)]; }
    asm volatile("s_waitcnt lgkmcnt(0)" ::: "memory");
    const int c = lane & 7;
#pragma unroll
    for (int j = 0; j < 4; ++j) { const int n = (lane >> 3) + 8 * j; const LAS float* s = scr + (8 * c) * 33 + n;
        u4v o; o.x = pk2(s[0 * 33], s[1 * 33]); o.y = pk2(s[2 * 33], s[3 * 33]); o.z = pk2(s[4 * 33], s[5 * 33]); o.w = pk2(s[6 * 33], s[7 * 33]);
        int orow = n0 + n; if (up_il) { const int gte = orow >= DFF ? 1 : 0, ch = orow - gte * DFF; orow = (ch >> 7) * 256 + gte * 128 + (ch & 127); }
        *(u4v*)(WT + (size_t)orow * K + k0 + 8 * c) = o; }
    asm volatile("s_waitcnt lgkmcnt(0)" ::: "memory");
}
__device__ __forceinline__ void ph_prologue(Frame& F) {
    const int lane = F.lane;
    const float* c_smp = F.inp(I_C); const float* c_ctx = F.inp(I_CCTX);
    for (int task = F.wg; task < 4 * 48; task += F.G) {
        const int l = task / 48, cc = task % 48, col = cc * 128 + lane * 2;
        const float* W = F.inp(I_WADA) + (size_t)l * D * 6144 + col;
        float acc[3][2] = {};
#pragma unroll 16
        for (int k = F.wave * 128; k < F.wave * 128 + 128; ++k) {
            const f32x2 w = *(const f32x2*)(W + (size_t)k * 6144);
            const float s0 = silu_f(c_ctx[k]), s1 = silu_f(c_smp[k]), s2 = silu_f(c_smp[D + k]);
            acc[0][0] += s0 * w[0]; acc[0][1] += s0 * w[1]; acc[1][0] += s1 * w[0]; acc[1][1] += s1 * w[1]; acc[2][0] += s2 * w[0]; acc[2][1] += s2 * w[1];
        }
        LAS float* red = (LAS float*)(F.lds + 8 * 8448);
        __syncthreads();
#pragma unroll
        for (int c = 0; c < 3; ++c) { red[(F.wave * 3 + c) * 128 + lane * 2] = acc[c][0]; red[(F.wave * 3 + c) * 128 + lane * 2 + 1] = acc[c][1]; }
        __syncthreads();
        if (F.tid < 384) { const int c = F.tid >> 7, j = F.tid & 127; float v = F.inp(I_BADA)[l * 6144 + cc * 128 + j];
#pragma unroll
            for (int w = 0; w < 8; ++w) v += red[(w * 3 + c) * 128 + j];
            F.mod_()[((size_t)l * 3 + c) * 6144 + cc * 128 + j] = v; }
    }
    {
        LAS float* scr = (LAS float*)(F.lds + F.wave * 8448);
        const int gw = F.wg * NWAVES + F.wave, NGW = F.G * NWAVES;
        constexpr int I_UP = 16 * 176, I_DNW = 44 * 32, I_FWT = 16 * 32, I_DIN = 16 * 129, I_MIN = 16 * 97;
        constexpr int NITEMS = 4 * I_UP + 4 * I_DNW + 2 * I_FWT + I_DIN + I_FWT + I_MIN + I_FWT;
        for (int it = gw; it < NITEMS; it += NGW) {
            int r = it;
            if (r < 4 * I_UP) { const int l = r / I_UP; p0_transpose_item(F.inp(I_WUP) + (size_t)l * D * NUP, D, NUP, (bf16_t*)(F.wt_() + WT_UP) + (size_t)l * NUP * D, scr, r % I_UP, lane, true); continue; } r -= 4 * I_UP;
            if (r < 4 * I_DNW) { const int l = r / I_DNW; p0_transpose_item(F.inp(I_WDN) + (size_t)l * DFF * D, DFF, D, (bf16_t*)(F.wt_() + WT_DN) + (size_t)l * D * DFF, scr, r % I_DNW, lane); continue; } r -= 4 * I_DNW;
            if (r < 2 * I_FWT) { const int j = r / I_FWT; p0_transpose_item(F.inp(I_FW) + (size_t)j * D * D, D, D, (bf16_t*)(F.wt_() + WT_F) + (size_t)j * D * D, scr, r % I_FWT, lane); continue; } r -= 2 * I_FWT;
            if (r < I_DIN) { p0_transpose_item(F.inp(I_DWIN), D, DN_PROJ, (bf16_t*)(F.wt_() + WT_DIN), scr, r, lane); continue; } r -= I_DIN;
            if (r < I_FWT) { p0_transpose_item(F.inp(I_DWOUT), D, D, (bf16_t*)(F.wt_() + WT_DOUT), scr, r, lane); continue; } r -= I_FWT;
            if (r < I_MIN) { p0_transpose_item(F.inp(I_MWIN), D, ML_PROJ, (bf16_t*)(F.wt_() + WT_MIN), scr, r, lane); continue; } r -= I_MIN;
            p0_transpose_item(F.inp(I_MWOUT), D, D, (bf16_t*)(F.wt_() + WT_MOUT), scr, r, lane);
        }
    }
    const int gt = F.wg * NTHR + F.tid, NGT = F.G * NTHR;
    bf16_t* cs256 = (bf16_t*)(F.tab_() + TAB_CS256); bf16_t* cst256 = (bf16_t*)(F.tab_() + TAB_CST256); bf16_t* cst1024 = (bf16_t*)(F.tab_() + TAB_CST1024);
    for (int i = gt; i < 256 * 256; i += NGT) { const int a = i >> 8, b = i & 255; const int m = (a * b) & 255; float s, c; sincospif(2.0f * (float)m / 256.0f, &s, &c);
        cs256[a * 256 + b] = (bf16_t)f2bf(c); cs256[(256 + a) * 256 + b] = (bf16_t)f2bf(s); cst256[a * 512 + b] = (bf16_t)f2bf(c); cst256[a * 512 + 256 + b] = (bf16_t)f2bf(-s); }
    for (int i = gt; i < 1024 * 1024; i += NGT) { const int a = i >> 10, b = i & 1023; const int m = (a * b) & 1023; float s, c; sincospif(2.0f * (float)m / 1024.0f, &s, &c);
        cst1024[a * 2048 + b] = (bf16_t)f2bf(c); cst1024[a * 2048 + 1024 + b] = (bf16_t)f2bf(-s); }
}
struct SchedWcs { int G, c, nun; const char* WT; const char* CS; char* O;
    __device__ __forceinline__ bool next(int i, pg8::Unit& u) const { const int L = i * G + c; if (L >= nun) return false;
        const int j = L >> 5, cs = (L >> 4) & 1, pm = (L >> 2) & 3, g = L & 3;
        u.A = WT + (size_t)j * D * D * 2 + ((size_t)pm * 256 * D + g * 256) * 2; u.B = CS + (size_t)cs * 256 * 256 * 2;
        u.out = O + (size_t)j * 2048 * D * 2 + ((size_t)(cs * 1024 + pm * 256) * D + g * 256) * 2; u.nt = 4; u.ldc = D; u.flag = 0; u.row0 = 0; return true; } };
__device__ __forceinline__ void ph_wcs(Frame& F) {
    int nun = 64; asm volatile("" : "+s"(nun));
    SchedWcs S{F.G, F.wg, nun, (const char*)(F.wt_() + WT_F), (const char*)(F.tab_() + TAB_CS256), (char*)(F.wt_() + WT_CS)};
    pg8::EpiBf16 E{nullptr};
    pg8::gemm_phase(F.lds, D, 256, S, E);
}

__device__ __forceinline__ void ph_norm(Frame& F, int pl, int pgj, const float* pbias, int nsc, int nss, float sc_ctx, float sc_smp, int nl, int nsh, const float* nw, bool first = false, int wg0 = 0) {
    const int gw = F.wg >= wg0 ? (F.wg - wg0) * NWAVES + F.wave : MTOT, NGW = (F.G - wg0) * NWAVES, lane = F.lane;
    const float* xin_p = F.inp(I_XP); const float* xin_s = F.inp(I_XS);
    const bf16_t* s0 = slab_ptr(F, 0); const bf16_t* s1 = slab_ptr(F, 1); const bf16_t* s2 = slab_ptr(F, 2); const bf16_t* s3 = slab_ptr(F, 3);
    auto ld4 = [](const bf16_t* p) { const u2v u = *(const u2v*)p; return (f32x4){__builtin_bit_cast(float, u.x << 16), __builtin_bit_cast(float, u.x & 0xffff0000u), __builtin_bit_cast(float, u.y << 16), __builtin_bit_cast(float, u.y & 0xffff0000u)}; };
    constexpr int RU = 3;
    for (int rb = gw; rb < MTOT; rb += RU * NGW) {
        f32x4 v[RU][4], sl[RU][4];
#pragma unroll
        for (int q = 0; q < RU; ++q) { const int row = rb + q * NGW; const bool ok = row < MTOT; const int ns = row < MCTX ? nsc : nss;
#pragma unroll
            for (int j = 0; j < 4; ++j) { const size_t o = (size_t)(ok ? row : 0) * D + 4 * lane + 256 * j;
                v[q][j] = first ? ((ok ? row : 0) < MCTX ? *(const f32x4*)(xin_p + o) : *(const f32x4*)(xin_s + o - (size_t)MCTX * D)) : ld4(F.X_() + o);
                if (pl >= 0) { f32x4 s = ld4(s0 + o);
                    if (ns > 1) s = s + ld4(s1 + o);
                    if (ns > 2) s = s + ld4(s2 + o) + ld4(s3 + o);
                    sl[q][j] = s; } } }
#pragma unroll
        for (int q = 0; q < RU; ++q) { const int row = rb + q * NGW; if (row >= MTOT) continue;
            const int cond = row_cond(row); const float scl = row < MCTX ? sc_ctx : sc_smp;
            float ss = 0.f;
#pragma unroll
            for (int j = 0; j < 4; ++j) { const int col = 4 * lane + 256 * j; const size_t o = (size_t)row * D + col;
                f32x4 x = v[q][j];
                if (pl >= 0) {
                    const f32x4 g = *(const f32x4*)(F.mod_() + ((size_t)pl * 3 + cond) * 6144 + pgj * D + col);
                    f32x4 s = sl[q][j] * scl;
                    if (pbias) s = s + *(const f32x4*)(pbias + col);
                    x = x + g * s;
                    st8_wt(F.X_() + o, pk4(x));
                }
                if (first) st8_wt(F.X_() + o, pk4(x));
                v[q][j] = x; ss += (x[0] * x[0] + x[1] * x[1]) + (x[2] * x[2] + x[3] * x[3]); }
            const float rstd = rsqrtf(wave_sum(ss) * (1.f / D) + EPS);
#pragma unroll
            for (int j = 0; j < 4; ++j) { const int col = 4 * lane + 256 * j;
                const f32x4 w = *(const f32x4*)(nw + col);
                f32x4 y = v[q][j] * rstd * w;
                if (nl >= 0) {
                    const float* m = F.mod_() + ((size_t)nl * 3 + cond) * 6144 + nsh * D + col;
                    const f32x4 sh = *(const f32x4*)m, sc = *(const f32x4*)(m + D);
                    y = y * (sc + 1.f) + sh;
                    u2v o; o.x = cvtpk(y[0], y[1]); o.y = cvtpk(y[2], y[3]);
                    st8_wt(F.H_() + (size_t)row * D + col, o);
                } else st16f_wt(F.out + O_Y + (size_t)row * D + col, y);
            }
        }
    }
}

__device__ __forceinline__ pg8::SchedPlain mk_plain(Frame& F, const void* A, int lda, const void* Bt, int ldb, int nN, int ns, int nt, void* O, int ldc, int osz, size_t osplit, int gate_pn) {
    pg8::SchedPlain S; S.G = F.G; S.c = F.wg; S.nM = 24; S.nN = nN; S.ns = ns; S.lda = lda; S.ldb = ldb; S.ldc = ldc; S.nt = nt; S.osz = osz; S.gate_pn = gate_pn;
    S.A = (const char*)A; S.B = (const char*)Bt; S.O = (char*)O; S.osplit = osplit; S.lim = 1 << 30; return S;
}
__device__ __forceinline__ void gemm64(Frame& F, const bf16_t* A, int lda, const bf16_t* Bt, int ldb, bf16_t* C, int ldc) {
    LAS bf16_t* LA = (LAS bf16_t*)F.lds; LAS bf16_t* LB = LA + 64 * 264;
    const int tid = F.tid, lane = F.lane, w = F.wave, r = lane & 15, g = lane >> 4, wr = w >> 1, wc = w & 1;
    u4v ra[4][4], rb[4][4];
#pragma unroll
    for (int kc = 0; kc < 4; ++kc)
#pragma unroll
        for (int i = 0; i < 4; ++i) { const int idx = tid + 512 * i, row = idx >> 5, pc = idx & 31;
            ra[kc][i] = *(const u4v*)(A + (size_t)row * lda + kc * 256 + pc * 8); rb[kc][i] = *(const u4v*)(Bt + (size_t)row * ldb + kc * 256 + pc * 8); }
    f32x4 acc0 = (f32x4){0.f, 0.f, 0.f, 0.f}, acc1 = (f32x4){0.f, 0.f, 0.f, 0.f};
#pragma unroll
    for (int kc = 0; kc < 4; ++kc) {
        __syncthreads();
#pragma unroll
        for (int i = 0; i < 4; ++i) { const int idx = tid + 512 * i, row = idx >> 5, pc = idx & 31; *(LAS u4v*)(LA + row * 264 + pc * 8) = ra[kc][i]; *(LAS u4v*)(LB + row * 264 + pc * 8) = rb[kc][i]; }
        __syncthreads();
#pragma unroll
        for (int kk = 0; kk < 8; ++kk) { const bf16x8_t a = frag_nat(LA, 264, 16 * wr + r, 32 * kk, g);
            acc0 = MFMA16(frag_nat(LB, 264, 32 * wc + r, 32 * kk, g), a, acc0); acc1 = MFMA16(frag_nat(LB, 264, 32 * wc + 16 + r, 32 * kk, g), a, acc1); }
    }
    bf16_t* cp = C + (size_t)(16 * wr + r) * ldc + 32 * wc + 4 * g;
    *(u2v*)cp = pk4(acc0); *(u2v*)(cp + 16) = pk4(acc1);
    __syncthreads();
}
constexpr int XR_OFF = MISC_OFF + 1024;
struct SchedUp { int G, c, lim; const char* A; const char* B; char* UGp; char* ACTp;
    __device__ __forceinline__ bool next(int i, pg8::Unit& u) const { const int L = i * G + c; if (L >= lim) return false; int pm, pn;
        if (L < 352) pg8::tile_order(L, 16, 22, pm, pn); else { pg8::tile_order(L - 352, 8, 22, pm, pn); pm += 16; }
        u.A = A + (size_t)pm * 256 * D * 2; u.B = B + (size_t)pn * 256 * D * 2; u.nt = 16; u.row0 = pm * 256;
        if (pm < 16) { u.flag = 2 + pn * 4; u.out = ACTp + ((size_t)pm * 256 * DFF + pn * 128) * 2; u.ldc = DFF; }
        else { u.flag = 0; u.out = UGp + ((size_t)pm * 256 * NUP + pn * 128) * 2; u.ldc = NUP; }
        return true; } };
__device__ __forceinline__ float dpp_ror1(float v) { return __builtin_bit_cast(float, __builtin_amdgcn_update_dpp(0, __builtin_bit_cast(int, v), 0x121, 0xF, 0xF, false)); }
__device__ __forceinline__ float dpp_ror15(float v) { return __builtin_bit_cast(float, __builtin_amdgcn_update_dpp(0, __builtin_bit_cast(int, v), 0x12F, 0xF, 0xF, false)); }
struct EpiUp {
    static constexpr bool PERM = true;
    const float* cw; const float* cb; LAS unsigned char* lds;
    __device__ __forceinline__ void operator()(f32x4 (&acc)[2][2][4][2], const pg8::Unit& u, int wr, int wc, int fr, int fq) const {
        char* outp = u.out; asm volatile("" : "+v"(outp)); int tl = threadIdx.x; asm volatile("" : "+v"(tl)); fr = tl & 15; fq = (tl >> 4) & 3;
        const int row0 = wr * 64 + fr, col0 = wc * 32 + 8 * fq;
        GAS bf16_t* O = (GAS bf16_t*)outp;
        if ((u.flag & 3) == 0) {
#pragma unroll
            for (int ai = 0; ai < 2; ++ai)
#pragma unroll
                for (int m = 0; m < 4; ++m) { GAS bf16_t* rowp = O + (size_t)(row0 + ai * 128 + m * 16) * u.ldc + col0;
#pragma unroll
                    for (int bj = 0; bj < 2; ++bj) { const f32x4 v0 = acc[ai][bj][m][0], v1 = acc[ai][bj][m][1];
                        pg8::u32x4 w; w.x = cvtpk(v0[0], v0[1]); w.y = cvtpk(v0[2], v0[3]); w.z = cvtpk(v1[0], v1[1]); w.w = cvtpk(v1[2], v1[3]);
                        pg8::st16_wt<0>((GAS pg8::u32x4*)(rowp + bj * DFF), w); } }
            return;
        }
        const int pn = u.flag >> 2, ch0 = pn * 128 + col0;
        LAS float* XR = (LAS float*)(lds + XR_OFF);
#pragma unroll
        for (int ai = 0; ai < 2; ++ai) {
            if (fr == 0) { LAS float* p = XR + (((wr * 4 + wc) * 2 + ai) * 2 + 0) * 32 + 8 * fq; *(LAS f32x4*)p = acc[ai][1][0][0]; *(LAS f32x4*)(p + 4) = acc[ai][1][0][1]; }
            if (fr == 15) { LAS float* p = XR + (((wr * 4 + wc) * 2 + ai) * 2 + 1) * 32 + 8 * fq; *(LAS f32x4*)p = acc[ai][1][3][0]; *(LAS f32x4*)(p + 4) = acc[ai][1][3][1]; } }
        asm volatile("s_waitcnt lgkmcnt(0)" ::: "memory"); __builtin_amdgcn_s_barrier(); asm volatile("" ::: "memory");
#pragma unroll
        for (int ai = 0; ai < 2; ++ai) {
            const int wrp = 1 - wr, aip = wr ? ai : ai - 1, ain = wr ? ai + 1 : ai;
            f32x4 bp[2], bn[2];
#pragma unroll
            for (int n = 0; n < 2; ++n) {
                bp[n] = aip >= 0 ? *(const LAS f32x4*)(XR + (((wrp * 4 + wc) * 2 + aip) * 2 + 1) * 32 + 8 * fq + 4 * n) : (f32x4){0.f, 0.f, 0.f, 0.f};
                bn[n] = ain <= 1 ? *(const LAS f32x4*)(XR + (((wrp * 4 + wc) * 2 + ain) * 2 + 0) * 32 + 8 * fq + 4 * n) : (f32x4){0.f, 0.f, 0.f, 0.f}; }
#pragma unroll
            for (int n = 0; n < 2; ++n) {
                const f32x4 w0 = *(const f32x4*)(cw + 3 * DFF + ch0 + 4 * n), w1 = *(const f32x4*)(cw + 4 * DFF + ch0 + 4 * n), w2 = *(const f32x4*)(cw + 5 * DFF + ch0 + 4 * n), bb = *(const f32x4*)(cb + ch0 + 4 * n);
#pragma unroll
                for (int j = 0; j < 4; ++j) {
                    float R[4], L[4];
#pragma unroll
                    for (int m = 0; m < 4; ++m) { R[m] = dpp_ror1(acc[ai][1][m][n][j]); L[m] = dpp_ror15(acc[ai][1][m][n][j]); }
#pragma unroll
                    for (int m = 0; m < 4; ++m) {
                        const float prev = fr == 0 ? (m == 0 ? bp[n][j] : R[m - 1]) : R[m];
                        const float next = fr == 15 ? (m == 3 ? bn[n][j] : L[m + 1]) : L[m];
                        const float cv = w0[j] * prev + w1[j] * acc[ai][1][m][n][j] + w2[j] * next + bb[j];
                        acc[ai][0][m][n][j] = silu_f(cv) * acc[ai][0][m][n][j]; }
                } }
#pragma unroll
            for (int m = 0; m < 4; ++m) { const f32x4 v0 = acc[ai][0][m][0], v1 = acc[ai][0][m][1];
                pg8::u32x4 w; w.x = cvtpk(v0[0], v0[1]); w.y = cvtpk(v0[2], v0[3]); w.z = cvtpk(v1[0], v1[1]); w.w = cvtpk(v1[2], v1[3]);
                pg8::st16_wt<0>((GAS pg8::u32x4*)(O + (size_t)(row0 + ai * 128 + m * 16) * u.ldc + col0), w); }
        }
    }
};
__device__ __forceinline__ void ph_ffn_up(Frame& F, int l) {
    SchedUp S{F.G, F.wg, 2 * F.G, (const char*)F.H_(), (const char*)(F.wt_() + WT_UP + (size_t)l * NUP * D * 2), (char*)(F.big_() + BIG_UG), (char*)(F.big_() + BIG_ACT)};
    EpiUp E{F.inp(I_CW) + (size_t)l * 9 * DFF, F.inp(I_CB) + (size_t)l * DFF, F.lds};
    for (int sk = 0; sk < (int)((blockIdx.x >> 3) & 7); ++sk) __builtin_amdgcn_s_sleep(36);
    pg8::gemm_phase<EpiUp, SchedUp, true>(F.lds, D, D, S, E);
    const int ntail = 24 * 22 - 2 * F.G;
    for (int st = F.wg; st < ntail * 16; st += F.G) { int pm, pn; pg8::tile_order(2 * F.G + (st >> 4) - 352, 8, 22, pm, pn); pm += 16;
        const int r0 = pm * 256 + ((st >> 2) & 3) * 64, sn = st & 3, c0 = (sn >> 1) * DFF + pn * 128 + (sn & 1) * 64;
        gemm64(F, F.H_() + (size_t)r0 * D, D, (const bf16_t*)(F.wt_() + WT_UP + (size_t)l * NUP * D * 2) + (size_t)(pn * 256 + sn * 64) * D, D, (bf16_t*)(F.big_() + BIG_UG) + (size_t)r0 * NUP + c0, NUP); }
}
__device__ __forceinline__ const char* firstB_up(Frame& F, int l) { SchedUp S{F.G, F.wg, 2 * F.G, (const char*)F.H_(), (const char*)(F.wt_() + WT_UP + (size_t)l * NUP * D * 2), (char*)(F.big_() + BIG_UG), (char*)(F.big_() + BIG_ACT)}; pg8::Unit u; return S.next(0, u) ? u.B : nullptr; }
__device__ __forceinline__ void unpack8(const u4v& u, float (&f)[8]) {
#pragma unroll
    for (int i = 0; i < 4; ++i) { f[2 * i] = __builtin_bit_cast(float, u[i] << 16); f[2 * i + 1] = __builtin_bit_cast(float, u[i] & 0xffff0000u); }
}
struct ConvItem { u2v raw[3][6]; u2v ua[4]; f32x4 w[9]; f32x4 bias; };
__device__ __forceinline__ void conv_load(ConvItem& I, const bf16_t* UG, const float* cw, const float* cb, int c4, int row0, int gr, int gc0) {
    const bf16_t* gb = UG + DFF + 4 * c4;
#pragma unroll
    for (int di = -1; di <= 1; ++di) { const bool rok = gr + di >= 0 && gr + di < 16;
#pragma unroll
        for (int j = 0; j < 6; ++j) { const int col = gc0 + j - 1; const bool ok = rok && col >= 0 && col < 64;
            u2v u = *(const u2v*)(gb + (size_t)(ok ? row0 + di * 64 + j - 1 : row0) * NUP); if (!ok) u = (u2v){0u, 0u};
            I.raw[di + 1][j] = u; } }
#pragma unroll
    for (int it = 0; it < 4; ++it) I.ua[it] = *(const u2v*)(UG + (size_t)(row0 + it) * NUP + 4 * c4);
#pragma unroll
    for (int t = 0; t < 9; ++t) I.w[t] = *(const f32x4*)(cw + t * DFF + 4 * c4);
    I.bias = *(const f32x4*)(cb + 4 * c4);
}
__device__ __forceinline__ f32x4 unpack4(const u2v& u) { return (f32x4){__builtin_bit_cast(float, u.x << 16), __builtin_bit_cast(float, u.x & 0xffff0000u), __builtin_bit_cast(float, u.y << 16), __builtin_bit_cast(float, u.y & 0xffff0000u)}; }
__device__ __forceinline__ void conv_compute(const ConvItem& I, bf16_t* ACT, int c4, int row0) {
    f32x4 acc[4];
#pragma unroll
    for (int it = 0; it < 4; ++it) acc[it] = I.bias;
#pragma unroll
    for (int di = 0; di < 3; ++di)
#pragma unroll
        for (int j = 0; j < 6; ++j) { const f32x4 f = unpack4(I.raw[di][j]);
#pragma unroll
            for (int dj = -1; dj <= 1; ++dj) { const int it = j - 1 - dj; if (it >= 0 && it < 4) acc[it] = acc[it] + f * I.w[di * 3 + dj + 1]; } }
#pragma unroll
    for (int it = 0; it < 4; ++it) { const f32x4 a = unpack4(I.ua[it]); u2v o;
        o.x = cvtpk(silu_f(acc[it][0]) * a[0], silu_f(acc[it][1]) * a[1]); o.y = cvtpk(silu_f(acc[it][2]) * a[2], silu_f(acc[it][3]) * a[3]);
        st8_wt(ACT + (size_t)(row0 + it) * DFF + 4 * c4, o); }
}
__device__ __forceinline__ void ph_ffn_conv(Frame& F, int l) {
    const bf16_t* UG = (const bf16_t*)(F.big_() + BIG_UG); bf16_t* ACT = (bf16_t*)(F.big_() + BIG_ACT);
    const float* cw = F.inp(I_CW) + (size_t)l * 9 * DFF; const float* cb = F.inp(I_CB) + (size_t)l * DFF;
    const int tw = (F.wg * 8) & 1023, gr = tw >> 6, gcw = tw & 63, rowW = MCTX + F.wg * 8;
    const int i1 = F.tid + 512, i2 = F.tid + 1024;
    const int c0 = F.tid, h1 = i1 >= 704 ? 1 : 0, c1 = i1 - h1 * 704, c2 = i2 - 704;
    const bool v2 = F.wave < 6;
    ConvItem A, B;
    conv_load(A, UG, cw, cb, c0, rowW, gr, gcw);
    conv_load(B, UG, cw, cb, c1, rowW + 4 * h1, gr, gcw + 4 * h1);
    conv_compute(A, ACT, c0, rowW);
    if (v2) conv_load(A, UG, cw, cb, c2, rowW + 4, gr, gcw + 4);
    conv_compute(B, ACT, c1, rowW + 4 * h1);
    if (v2) conv_compute(A, ACT, c2, rowW + 4);
}
__device__ __forceinline__ void ph_gemm_slab(Frame& F, const bf16_t* A, int K, const void* WT) {
    pg8::SchedPlain S = mk_plain(F, A, K, WT, K, 4, 2, K / 128, F.slab_(), D, 2, SLAB_FULL, -1);
    pg8::EpiBf16 E{nullptr};
    pg8::gemm_phase<pg8::EpiBf16, pg8::SchedPlain, true>(F.lds, K, K, S, E);
}
__device__ __forceinline__ const char* firstB_slab(Frame& F, const bf16_t* A, int K, const void* WT) { pg8::SchedPlain S = mk_plain(F, A, K, WT, K, 4, 2, K / 128, F.slab_(), D, 2, SLAB_FULL, -1); pg8::Unit u; return S.next(0, u) ? u.B : nullptr; }

struct SchedF1 { int G, c; const char* A; const char* B; char* ZC; char* ZS;
    __device__ __forceinline__ bool next(int i, pg8::Unit& u) const { int pm, pn; if (!pg8::tile_order(i * G + c, 8, 24, pm, pn)) return false;
        u.A = A + (size_t)pm * 256 * D * 2; u.B = B + (size_t)pn * 256 * D * 2; u.nt = 16; u.flag = 0; u.row0 = 0;
        if (pn < 16) { u.out = ZC + (size_t)pn * 1024 * 512 * 2 + ((size_t)(pm & 3) * 256 * 512 + (pm >> 2) * 256) * 2; u.ldc = 512; }
        else { const int sq = (pn - 16) >> 2, tq = (pn - 16) & 3; u.out = ZS + (size_t)sq * 1024 * 2048 * 2 + ((size_t)(pm & 3) * 256 * 2048 + (pm >> 2) * 1024 + tq * 256) * 2; u.ldc = 2048; }
        return true; } };
__device__ __forceinline__ void ph_f1(Frame& F, int j) {
    SchedF1 S{F.G, F.wg, (const char*)(F.wt_() + WT_CS + (size_t)j * 2048 * D * 2), (const char*)F.H_(), (char*)(F.big_() + BIG_ZTC), (char*)(F.big_() + BIG_ZTS)};
    pg8::EpiBf16 E{nullptr};
    pg8::gemm_phase(F.lds, D, D, S, E);
}
struct SchedF2C { int G, c; const char* A; const char* B; char* O;
    __device__ __forceinline__ bool next(int i, pg8::Unit& u) const { const int L = i * G + c; if (L >= 64) return false; const int seq = L >> 2, pn = L & 3;
        u.A = A; u.B = B + (size_t)seq * 1024 * 512 * 2 + (size_t)pn * 256 * 512 * 2; u.out = O + ((size_t)seq * 256 * D + pn * 256) * 2; u.nt = 8; u.ldc = D; u.flag = 0; u.row0 = 0; return true; } };
struct SchedF2S { int G, c; const char* A; const char* B; char* O0; char* O2;
    __device__ __forceinline__ bool next(int i, pg8::Unit& u) const { const int L = i * G + c - 64; if (L < 0 || L >= 128) return false;
        const int ks = L & 3, r = L >> 2, seq = r >> 4, pm = (r >> 2) & 3, pn = r & 3;
        u.A = A + ((size_t)pm * 256 * 2048 + ks * 512) * 2; u.B = B + (size_t)seq * 1024 * 2048 * 2 + ((size_t)pn * 256 * 2048 + ks * 512) * 2;
        char* ob = ks < 2 ? O0 + (size_t)ks * SLAB_FULL + (size_t)MCTX * D * 2 : O2 + (size_t)(ks - 2) * SLAB_SMP;
        u.out = ob + ((size_t)(seq * 1024 + pm * 256) * D + pn * 256) * 2; u.nt = 8; u.ldc = D; u.flag = 0; u.row0 = 0; return true; } };
__device__ __forceinline__ void ph_f2(Frame& F) {
    pg8::EpiBf16 E{nullptr};
    { SchedF2C S{F.G, F.wg, (const char*)(F.tab_() + TAB_CST256), (const char*)(F.big_() + BIG_ZTC), (char*)F.slab_()}; pg8::gemm_phase(F.lds, 512, 512, S, E); }
    { SchedF2S S{F.G, F.wg, (const char*)(F.tab_() + TAB_CST1024), (const char*)(F.big_() + BIG_ZTS), (char*)F.slab_(), (char*)(F.slab_() + 2 * SLAB_FULL)}; pg8::gemm_phase(F.lds, 2048, 2048, S, E); }
}

struct SchedCols { int G, c, np, first, gate_p; const char* A; const char* B; char* O; int ldc;
    __device__ __forceinline__ bool next(int i, pg8::Unit& u) const { int pm, pp; if (c < 0 || !pg8::tile_order(i * G + c, 24, np, pm, pp)) return false;
        const int pn = (pp == gate_p) ? 12 : first + pp;
        u.A = A + (size_t)pm * 256 * D * 2; u.B = B + (size_t)pn * 256 * D * 2; u.out = O + ((size_t)pm * 256 * ldc + (size_t)pn * 256) * 2; u.nt = 16; u.ldc = ldc; u.flag = (pp == gate_p) ? 1 : 0; u.row0 = pm * 256; return true; } };
__device__ __forceinline__ void ph_proj(Frame& F, const void* WT, int nfull) {
    pg8::EpiBf16 E{(float*)(F.big_() + BIG_GATES)};
    if (nfull == 16) {
        pg8::SchedPlain S = mk_plain(F, F.H_(), D, WT, D, nfull + 1, 1, 16, F.big_() + BIG_PROJ, nfull * 256, 2, 0, nfull);
        pg8::gemm_phase<pg8::EpiBf16, pg8::SchedPlain, true>(F.lds, D, D, S, E);
    } else {
        SchedCols S{F.G, F.wg, 9, 0, 8, (const char*)F.H_(), (const char*)WT, (char*)(F.big_() + BIG_PROJ), nfull * 256};
        pg8::gemm_phase<pg8::EpiBf16, SchedCols, true>(F.lds, D, D, S, E);
    }
}
__device__ __forceinline__ const char* firstB_proj(Frame& F, const void* WT, int nfull) { pg8::Unit u;
    if (nfull == 16) { pg8::SchedPlain S = mk_plain(F, F.H_(), D, WT, D, nfull + 1, 1, 16, F.big_() + BIG_PROJ, nfull * 256, 2, 0, nfull); return S.next(0, u) ? u.B : nullptr; }
    SchedCols S{F.G, F.wg, 9, 0, 8, (const char*)F.H_(), (const char*)WT, (char*)(F.big_() + BIG_PROJ), nfull * 256}; return S.next(0, u) ? u.B : nullptr; }
__device__ __forceinline__ void ph_ml_ogate(Frame& F) {
    __syncthreads();
    SchedCols S{96, F.wg >= 160 ? F.wg - 160 : -1, 4, 8, -1, (const char*)F.H_(), (const char*)(F.wt_() + WT_MIN), (char*)(F.big_() + BIG_PROJ), 3072};
    pg8::EpiBf16 E{nullptr};
    pg8::gemm_phase<pg8::EpiBf16, SchedCols, true>(F.lds, D, D, S, E);
}
__device__ __forceinline__ const char* firstB_og(Frame& F) { pg8::Unit u;
    SchedCols S{96, F.wg >= 160 ? F.wg - 160 : -1, 4, 8, -1, (const char*)F.H_(), (const char*)(F.wt_() + WT_MIN), (char*)(F.big_() + BIG_PROJ), 3072}; return S.next(0, u) ? u.B : nullptr; }
__device__ __forceinline__ void chunk_pos(int ck, int& seq, int& t0, int& T) { if (ck < 64) { seq = ck >> 2; t0 = (ck & 3) * 64; T = 256; } else { const int u = ck - 64; seq = 16 + (u >> 4); t0 = (u & 15) * 64; T = 1024; } }

constexpr int DP_LQ = 0, DP_LK = 17408, DP_LQK = 34816, DP_LKK = 52224, DP_LKT = 69632, DP_LVT = 88064, DP_SC = 106496, DP_T = DP_LQK;
constexpr int DS_VEC_F = 192;
__device__ __forceinline__ void ph_dn_prep2(Frame& F) {
    const bf16_t* P = (const bf16_t*)(F.big_() + BIG_PROJ); const float* GT = (const float*)(F.big_() + BIG_GATES);
    LAS bf16_t* LQ = (LAS bf16_t*)(F.lds + DP_LQ); LAS bf16_t* LK = (LAS bf16_t*)(F.lds + DP_LK); LAS float* LQK = (LAS float*)(F.lds + DP_LQK); LAS float* LKK = (LAS float*)(F.lds + DP_LKK);
    LAS bf16_t* LKT = (LAS bf16_t*)(F.lds + DP_LKT); LAS bf16_t* LVT = (LAS bf16_t*)(F.lds + DP_LVT); LAS float* SC = (LAS float*)(F.lds + DP_SC);
    const int tid = F.tid, lane = F.lane, w = F.wave, r = lane & 15, g = lane >> 4;
    const float* cw = F.inp(I_DCW);
    unsigned xr[12][3];
    auto load_xr = [&](int task_) { const int ck_ = task_ >> 3, h_ = task_ & 7; int seq_, t0_, T_; chunk_pos(ck_, seq_, t0_, T_);
        unsigned rowv = (unsigned)(seq_row0(seq_) + t0_ + 8 * w - 2); asm volatile("" : "+v"(rowv));
#pragma unroll
        for (int rr = 0; rr < 12; ++rr) { const int tp = t0_ + 8 * w - 2 + rr; const bool ok = tp >= 0 && tp < T_;
#pragma unroll
            for (int wh = 0; wh < 3; ++wh) { xr[rr][wh] = 0u; if (ok) xr[rr][wh] = *(const unsigned*)(P + ((rowv + rr) * 4096u + (unsigned)(wh * 1024 + h_ * 128 + 2 * lane))); } } };
    if (F.wg < 96 * 8) load_xr(F.wg);
    for (int task = F.wg; task < 96 * 8; task += F.G) {
        const int ck = task >> 3, h = task & 7; int seq, t0, T; chunk_pos(ck, seq, t0, T); const int row0 = seq_row0(seq) + t0;
        __syncthreads();
        {
            float cwr[3][5][2];
#pragma unroll
            for (int wh = 0; wh < 3; ++wh)
#pragma unroll
                for (int j = 0; j < 5; ++j) { const f32x2 c = *(const f32x2*)(cw + j * 3072 + wh * 1024 + h * 128 + 2 * lane); cwr[wh][j][0] = c[0]; cwr[wh][j][1] = c[1]; }
            bf16_t* QSg = (bf16_t*)(F.big_() + BIG_QS) + (size_t)task * 64 * 128;
#pragma unroll
            for (int tt = 0; tt < 8; ++tt) { const int tk = 8 * w + tt;
                float val[3][2];
#pragma unroll
                for (int wh = 0; wh < 3; ++wh) { float a0 = 0.f, a1 = 0.f;
#pragma unroll
                    for (int j = 0; j < 5; ++j) { const unsigned x = xr[tt + j][wh]; a0 += bf2f(x & 0xffffu) * cwr[wh][j][0]; a1 += bf2f(x >> 16) * cwr[wh][j][1]; }
                    val[wh][0] = silu_f(a0); val[wh][1] = silu_f(a1); }
                const float qs = rsqrtf(wave_sum(val[0][0] * val[0][0] + val[0][1] * val[0][1]) + EPS) * 0.08838834764831845f;
                const float ks = rsqrtf(wave_sum(val[1][0] * val[1][0] + val[1][1] * val[1][1]) + EPS);
                const unsigned qp = cvtpk(val[0][0] * qs, val[0][1] * qs), kp = cvtpk(val[1][0] * ks, val[1][1] * ks), vp = cvtpk(val[2][0], val[2][1]);
                *(LAS unsigned*)(LQ + tk * 136 + 2 * lane) = qp; *(LAS unsigned*)(LK + tk * 136 + 2 * lane) = kp;
                *(unsigned*)(QSg + tk * 128 + 2 * lane) = qp;
                LKT[(2 * lane) * 72 + tk] = (bf16_t)(kp & 0xffffu); LKT[(2 * lane + 1) * 72 + tk] = (bf16_t)(kp >> 16);
                LVT[(2 * lane) * 72 + tk] = (bf16_t)(vp & 0xffffu); LVT[(2 * lane + 1) * 72 + tk] = (bf16_t)(vp >> 16);
            }
        }
        if (task + F.G < 96 * 8) load_xr(task + F.G);
        float gl_dir = 0.f;
        if (w < 2) { const int dir = w, c = dir ? 63 - lane : lane;
            const float graw = GT[(size_t)(row0 + c) * 32 + dir * 16 + h], braw = GT[(size_t)(row0 + c) * 32 + dir * 16 + 8 + h];
            float gsum = -expf(F.inp(I_DALOG)[dir * 8 + h]) * softplus_f(graw + F.inp(I_DDT)[dir * 8 + h]);
#pragma unroll
            for (int o = 1; o < 64; o <<= 1) { const float t = __shfl_up(gsum, o); if (lane >= o) gsum += t; }
            SC[dir * 64 + c] = gsum; SC[128 + dir * 64 + c] = sigmoid_f(braw);
            gl_dir = __shfl(gsum, 63);
        }
        __syncthreads();
        {
            const LAS bf16_t* Asrc = w < 4 ? LK : LQ; LAS float* Dst = w < 4 ? LKK : LQK; const int mi = w & 3;
            f32x4 acc[4];
#pragma unroll
            for (int ni = 0; ni < 4; ++ni) acc[ni] = (f32x4){0.f, 0.f, 0.f, 0.f};
#pragma unroll
            for (int kk = 0; kk < 4; ++kk) { const bf16x8_t a = frag_nat(Asrc, 136, 16 * mi + r, 32 * kk, g);
#pragma unroll
                for (int ni = 0; ni < 4; ++ni) acc[ni] = MFMA16(a, frag_nat(LK, 136, 16 * ni + r, 32 * kk, g), acc[ni]); }
#pragma unroll
            for (int ni = 0; ni < 4; ++ni)
#pragma unroll
                for (int i = 0; i < 4; ++i) Dst[(16 * mi + 4 * g + i) * 68 + 16 * ni + r] = acc[ni][i];
        }
        __syncthreads();
        {
            const size_t cd0 = (size_t)task * 2;
            bf16_t* QKMg = (bf16_t*)(F.big_() + BIG_QKM) + cd0 * 64 * 64;
#pragma unroll
            for (int it = 0; it < 4; ++it) { const int idx = tid + 512 * it, c = idx >> 5, s = (idx & 31) * 2;
                const float gFc = SC[c], gBc = SC[64 + c], bFc = SC[128 + c], bBc = SC[192 + c];
                float qf[2], qb[2];
#pragma unroll
                for (int e = 0; e < 2; ++e) { const int ss = s + e; const float qk = LQK[c * 68 + ss], kk = LKK[c * 68 + ss];
                    const float dF = __expf(gFc - SC[ss]), dB = __expf(gBc - SC[64 + ss]);
                    qf[e] = ss <= c ? qk * dF : 0.f; qb[e] = ss >= c ? qk * dB : 0.f;
                    LKK[c * 68 + ss] = ss < c ? bFc * kk * dF : (ss > c ? bBc * kk * dB : 0.f); }
                *(unsigned*)(QKMg + c * 64 + s) = pk2(qf[0], qf[1]); *(unsigned*)(QKMg + 4096 + c * 64 + s) = pk2(qb[0], qb[1]); }
            bf16_t* KTg = (bf16_t*)(F.big_() + BIG_KTG) + (size_t)task * 128 * 64;
#pragma unroll
            for (int it = 0; it < 2; ++it) { const int idx = tid + 512 * it, d = idx >> 3, c8 = (idx & 7) * 8; *(u4v*)(KTg + d * 64 + c8) = *(const LAS u4v*)(LKT + d * 72 + c8); }
            if (tid < 128) { const int dir = tid >> 6, c = tid & 63; float* VEC = (float*)(F.big_() + BIG_VEC) + (cd0 + dir) * DS_VEC_F;
                const float gc = SC[dir * 64 + c], gl = SC[dir * 64 + (dir ? 0 : 63)];
                VEC[c] = __expf(gc); VEC[64 + c] = __expf(gl - gc); if (c == 0) VEC[128] = __expf(gl); }
        }
        __syncthreads();
#pragma unroll
        for (int it = 0; it < 8; ++it) { const int idx = tid + 512 * it, p = idx >> 6, pj = idx & 63; LQK[p * 68 + pj] = LKK[(63 - p) * 68 + 63 - pj]; }
        __syncthreads();
        {
            LAS float* TF0 = (LAS float*)(F.lds + DP_LQ); LAS float* XS = (LAS float*)(F.lds + DP_SC + 1024) + w * 272;
            unsigned lofs = 0u; asm volatile("" : "+v"(lofs));
            const LAS float* Lf = (const LAS float*)(F.lds + DP_LKK + lofs); const LAS float* Lb = (const LAS float*)(F.lds + DP_LQK + lofs);
            const int lr = lane & 15, lg = lane >> 4;
            { const int dir = w >> 2, bi = w & 3; const LAS float* Ls = (dir ? Lb : Lf) + (16 * bi) * 68 + 16 * bi; LAS float* Td = TF0 + dir * 64 * 68 + (16 * bi) * 68 + 16 * bi + lofs;
                float Tr[16];
#pragma unroll
                for (int p = 0; p < 16; ++p) { float a0 = (p == lr) ? 1.f : 0.f;
#pragma unroll
                    for (int pj = 0; pj < p; ++pj) a0 -= Ls[p * 68 + pj] * Tr[pj];
                    Tr[p] = a0; }
                if (lane < 16) {
#pragma unroll
                    for (int p = 0; p < 16; ++p) Td[p * 68 + lr] = Tr[p]; } }
            __syncthreads();
#define MM16(acc, Ap, pa, Bp, pb) do { _Pragma("unroll") for (int s_ = 0; s_ < 4; ++s_) acc = __builtin_amdgcn_mfma_f32_16x16x4f32((Ap)[lr * (pa) + 4 * s_ + lg], (Bp)[(4 * s_ + lg) * (pb) + lr], acc, 0, 0, 0); } while (0)
#pragma unroll
            for (int lev = 1; lev < 4; ++lev) {
                const int ntask = 2 * (4 - lev);
                if (w < ntask) { const int dir = w / (4 - lev), bi = lev + w % (4 - lev), bj = bi - lev;
                    const LAS float* Ls = dir ? Lb : Lf; LAS float* Tf = TF0 + dir * 64 * 68 + lofs;
                    f32x4 x = (f32x4){0.f, 0.f, 0.f, 0.f};
#pragma unroll
                    for (int d = 0; d < 3; ++d) if (d < lev) { const int bk = bj + d;
                        MM16(x, Ls + (16 * bi) * 68 + 16 * bk, 68, Tf + (16 * bk) * 68 + 16 * bj, 68); }
#pragma unroll
                    for (int rr = 0; rr < 4; ++rr) XS[(4 * lg + rr) * 17 + lr] = x[rr];
                    f32x4 t = (f32x4){0.f, 0.f, 0.f, 0.f};
                    MM16(t, Tf + (16 * bi) * 68 + 16 * bi, 68, XS, 17);
#pragma unroll
                    for (int rr = 0; rr < 4; ++rr) Tf[(16 * bi + 4 * lg + rr) * 68 + 16 * bj + lr] = -t[rr]; }
                __syncthreads();
            }
#undef MM16
            LAS bf16_t* Tb = (LAS bf16_t*)(F.lds + DP_T);
#pragma unroll
            for (int it = 0; it < 8; ++it) { const int idx = tid + 512 * it, dir = idx >> 11, p = (idx >> 5) & 63, pj = (idx & 31) * 2;
                const f32x2 tv = *(const LAS f32x2*)(TF0 + dir * 64 * 68 + p * 68 + pj);
                const int c = dir ? 63 - p : p, s0 = dir ? 63 - pj : pj, s1 = dir ? 62 - pj : pj + 1;
                const float t0 = (pj >> 4) <= (p >> 4) ? tv[0] : 0.f, t1 = ((pj + 1) >> 4) <= (p >> 4) ? tv[1] : 0.f;
                const float b0 = SC[128 + dir * 64 + s0], b1 = SC[128 + dir * 64 + s1], e0 = b0 * __expf(SC[dir * 64 + s0]), e1 = b1 * __expf(SC[dir * 64 + s1]);
                LAS bf16_t* T1 = Tb + dir * 2 * 4096; LAS bf16_t* T2 = T1 + 4096;
                T1[c * 64 + s0] = (bf16_t)f2bf(t0 * b0); T1[c * 64 + s1] = (bf16_t)f2bf(t1 * b1); T2[c * 64 + s0] = (bf16_t)f2bf(t0 * e0); T2[c * 64 + s1] = (bf16_t)f2bf(t1 * e1); }
        }
        __syncthreads();
#pragma unroll
        for (int dir = 0; dir < 2; ++dir) { const size_t cd = (size_t)task * 2 + dir;
            const LAS bf16_t* T1 = (const LAS bf16_t*)(F.lds + DP_T) + dir * 2 * 4096; const LAS bf16_t* T2 = T1 + 4096;
            bf16_t* Ug = (bf16_t*)(F.big_() + BIG_U) + cd * 8192 + (size_t)w * 1024; bf16_t* WNg = (bf16_t*)(F.big_() + BIG_WN) + cd * 8192;
#pragma unroll
            for (int m = 0; m < 4; ++m) { f32x4 au = (f32x4){0.f, 0.f, 0.f, 0.f}, aw = (f32x4){0.f, 0.f, 0.f, 0.f};
#pragma unroll
                for (int kk = 0; kk < 2; ++kk) {
                    au = MFMA16(frag_nat(T1, 64, rowp(m, r), 32 * kk, g), frag_nat(LVT, 72, 16 * w + r, 32 * kk, g), au);
                    aw = MFMA16(frag_nat(LKT, 72, 16 * w + r, 32 * kk, g), frag_nat(T2, 64, 16 * m + r, 32 * kk, g), aw); }
                *(u2v*)(Ug + m * 256 + lane * 4) = pk4(au);
                u2v o; o.x = pk2(-aw[0], -aw[1]); o.y = pk2(-aw[2], -aw[3]);
                *(u2v*)(WNg + (16 * m + r) * 128 + 16 * w + 4 * g) = o; }
        }
    }
}

constexpr int DS_LWN = 0, DS_LQS = 17408, DS_LQKM = 34816, DS_LKT = 44032, DS_LVEC = 62464;
__device__ __forceinline__ void dn_scan_seq(Frame& F, int seq, int h, int dir, int esl0, int nact) {
    LAS bf16_t* LWN = (LAS bf16_t*)(F.lds + DS_LWN); LAS bf16_t* LQS = (LAS bf16_t*)(F.lds + DS_LQS); LAS bf16_t* LQKM = (LAS bf16_t*)(F.lds + DS_LQKM); LAS bf16_t* LKT = (LAS bf16_t*)(F.lds + DS_LKT);
    LAS float* LVEC = (LAS float*)(F.lds + DS_LVEC);
    const int tid = F.tid, lane = F.lane, w = F.wave, r = lane & 15, g = lane >> 4, ws = esl0 + (w < nact ? w : 0); const bool act = w < nact;
    const int NC = seq < 16 ? 4 : 16, ck0 = seq < 16 ? seq * 4 : 64 + (seq - 16) * 16, rowS = seq_row0(seq);
    bf16_t* O = (bf16_t*)(F.slab_() + (dir ? SLAB_FULL : 0));
    f32x4 Sacc[8];
    if (seq >= 16) { const float* s0 = F.inp(I_SD) + ((size_t)((seq - 16) * 2 + dir) * 8 + h) * 16384 + 16 * ws + r;
#pragma unroll
        for (int j = 0; j < 8; ++j)
#pragma unroll
            for (int i = 0; i < 4; ++i) Sacc[j][i] = s0[(32 * (j >> 1) + 8 * g + 4 * (j & 1) + i) * 128]; }
    else {
#pragma unroll
        for (int j = 0; j < 8; ++j) Sacc[j] = (f32x4){0.f, 0.f, 0.f, 0.f}; }
    struct DStage { u4v wn[2], qs[2], qkm, kt[2]; f32x4 vec; u2v U[4]; };
    constexpr int PD = 1;
    DStage st[PD];
#define DS_LOAD(S, n) do { const int ckn = ck0 + (dir ? NC - 1 - (n) : (n)); const size_t tk = (size_t)ckn * 8 + h, cd = tk * 2 + dir; \
        const u4v* gWN = (const u4v*)((const bf16_t*)(F.big_() + BIG_WN) + cd * 8192); const u4v* gQS = (const u4v*)((const bf16_t*)(F.big_() + BIG_QS) + tk * 8192); \
        const u4v* gQKM = (const u4v*)((const bf16_t*)(F.big_() + BIG_QKM) + cd * 4096); const u4v* gKT = (const u4v*)((const bf16_t*)(F.big_() + BIG_KTG) + tk * 8192); \
        S.wn[0] = gWN[tid]; S.wn[1] = gWN[tid + 512]; S.qs[0] = gQS[tid]; S.qs[1] = gQS[tid + 512]; S.qkm = gQKM[tid]; S.kt[0] = gKT[tid]; S.kt[1] = gKT[tid + 512]; \
        S.vec = (f32x4){0.f, 0.f, 0.f, 0.f}; if (tid < 48) S.vec = *(const f32x4*)((const float*)(F.big_() + BIG_VEC) + cd * DS_VEC_F + tid * 4); \
        const bf16_t* gU = (const bf16_t*)(F.big_() + BIG_U) + cd * 8192 + (size_t)ws * 1024 + lane * 4; \
        _Pragma("unroll") for (int m = 0; m < 4; ++m) S.U[m] = *(const u2v*)(gU + m * 256); } while (0)
#pragma unroll
    for (int k = 0; k < PD; ++k) DS_LOAD(st[k], k);
    for (int n0 = 0; n0 < NC; n0 += PD) {
#pragma unroll
      for (int k = 0; k < PD; ++k) { const int n = n0 + k;
        __syncthreads();
#pragma unroll
        for (int i = 0; i < 2; ++i) { const int idx = tid + 512 * i;
            const int r16 = idx >> 4, c16 = (idx & 15) ^ (((r16 >> 4) & 1) << 2), r8 = idx >> 3, c8 = (idx & 7) ^ (((r8 >> 4) & 1) << 2);
            *(LAS u4v*)(LWN + r16 * 136 + c16 * 8) = st[k].wn[i]; *(LAS u4v*)(LQS + r16 * 136 + c16 * 8) = st[k].qs[i];
            *(LAS u4v*)(LKT + r8 * 72 + c8 * 8) = st[k].kt[i]; }
        { const int r8 = tid >> 3, c8 = (tid & 7) ^ (((r8 >> 4) & 1) << 2); *(LAS u4v*)(LQKM + r8 * 72 + c8 * 8) = st[k].qkm; }
        if (tid < 48) *(LAS f32x4*)(LVEC + tid * 4) = st[k].vec;
        f32x4 vn[4];
#pragma unroll
        for (int m = 0; m < 4; ++m) vn[m] = up4(st[k].U[m]);
        const int ckc = ck0 + (dir ? NC - 1 - n : n);
        __syncthreads();
        if (n + PD < NC) DS_LOAD(st[k], n + PD);
        if (act) {
        bf16x8_t Sb[4];
#pragma unroll
        for (int kk = 0; kk < 4; ++kk) Sb[kk] = pack_acc(Sacc[2 * kk], Sacc[2 * kk + 1]);
        f32x4 o[4];
#pragma unroll
        for (int m = 0; m < 4; ++m) { o[m] = (f32x4){0.f, 0.f, 0.f, 0.f};
#pragma unroll
            for (int kk = 0; kk < 4; ++kk) { vn[m] = MFMA16(frag_sw(LWN, 136, rowp(m, r), 4 * kk, g), Sb[kk], vn[m]); o[m] = MFMA16(frag_sw(LQS, 136, rowp(m, r), 4 * kk, g), Sb[kk], o[m]); }
            o[m] = o[m] * *(const LAS f32x4*)(LVEC + 32 * (m >> 1) + 8 * g + 4 * (m & 1)); }
        bf16x8_t vb[2], vs[2];
#pragma unroll
        for (int k2 = 0; k2 < 2; ++k2) { vb[k2] = pack_acc(vn[2 * k2], vn[2 * k2 + 1]);
            const f32x4 e0 = *(const LAS f32x4*)(LVEC + 64 + 32 * k2 + 8 * g), e1 = *(const LAS f32x4*)(LVEC + 64 + 32 * k2 + 8 * g + 4);
            vs[k2] = pack_acc(vn[2 * k2] * e0, vn[2 * k2 + 1] * e1); }
#pragma unroll
        for (int m = 0; m < 4; ++m) {
#pragma unroll
            for (int k2 = 0; k2 < 2; ++k2) o[m] = MFMA16(frag_sw(LQKM, 72, rowp(m, r), 4 * k2, g), vb[k2], o[m]);
            bf16_t* op = O + (size_t)(rowS + (ckc - ck0) * 64 + 32 * (m >> 1) + 8 * g + 4 * (m & 1)) * D + h * 128 + 16 * ws + r;
            const unsigned p01 = cvtpk(o[m][0], o[m][1]), p23 = cvtpk(o[m][2], o[m][3]);
            op[0] = (bf16_t)p01; op[(size_t)D] = (bf16_t)(p01 >> 16); op[(size_t)2 * D] = (bf16_t)p23; op[(size_t)3 * D] = (bf16_t)(p23 >> 16); }
        const float egl = LVEC[128];
#pragma unroll
        for (int j = 0; j < 8; ++j) { Sacc[j] = Sacc[j] * egl;
#pragma unroll
            for (int k2 = 0; k2 < 2; ++k2) Sacc[j] = MFMA16(frag_sw(LKT, 72, rowp(j, r), 4 * k2, g), vs[k2], Sacc[j]); }
        }
      }
    }
#undef DS_LOAD
    if (seq < 16 && act) { float* nd = F.out + O_ND + ((size_t)(seq * 2 + dir) * 8 + h) * 16384 + 16 * ws + r;
#pragma unroll
        for (int j = 0; j < 8; ++j)
#pragma unroll
            for (int i = 0; i < 4; ++i) nd[(32 * (j >> 1) + 8 * g + 4 * (j & 1) + i) * 128] = Sacc[j][i]; }
}
__device__ __forceinline__ bool scan_slot(int wg, int rnd, int& seq, int& h, int& dir, int& esl0, int& nact) {
    int id;
    if (wg < 64) { if (rnd) return false; id = wg >> 1; esl0 = (wg & 1) * 4; nact = 4; seq = 16 + id / 16; }
    else { id = (wg - 64) + rnd * 192; if (id >= 256) return false; esl0 = 0; nact = 8; seq = id / 16; }
    h = (id >> 1) & 7; dir = id & 1; return true;
}
__device__ __forceinline__ void ph_dn_scan2(Frame& F) {
    for (int rnd = 0; rnd < 2; ++rnd) { int seq, h, dir, esl0, nact; if (!scan_slot(F.wg, rnd, seq, h, dir, esl0, nact)) break; dn_scan_seq(F, seq, h, dir, esl0, nact); }
}
constexpr size_t BIG_MINTRA = BIG_WN;
constexpr size_t BIG_MU = BIG_MINTRA + (size_t)1536 * 8192 * 4;
constexpr size_t BIG_MVEC = BIG_MU + (size_t)1536 * 8192 * 4;
constexpr size_t BIG_MQS = BIG_MVEC + (size_t)1536 * 272 * 4;
static_assert(BIG_MQS + (size_t)768 * 4096 * 2 <= BIG_END, "mLSTM buffers exceed the big region");
constexpr int MP_LQ = 0, MP_LK = 9216, MP_LKT = 18432, MP_LVT = 27648, MP_LQK = 46080, MP_LPM = 63488, MP_LKW = 81920, MP_SC = 100352;
__device__ __forceinline__ void ph_ml_prep(Frame& F) {
    const bf16_t* P = (const bf16_t*)(F.big_() + BIG_PROJ); const float* GT = (const float*)(F.big_() + BIG_GATES);
    LAS bf16_t* LQ = (LAS bf16_t*)(F.lds + MP_LQ); LAS bf16_t* LK = (LAS bf16_t*)(F.lds + MP_LK); LAS bf16_t* LKT = (LAS bf16_t*)(F.lds + MP_LKT); LAS bf16_t* LVT = (LAS bf16_t*)(F.lds + MP_LVT);
    LAS float* LQK = (LAS float*)(F.lds + MP_LQK); LAS bf16_t* LPM = (LAS bf16_t*)(F.lds + MP_LPM); LAS bf16_t* LKW = (LAS bf16_t*)(F.lds + MP_LKW);
    LAS float* SC = (LAS float*)(F.lds + MP_SC);
    const int tid = F.tid, lane = F.lane, w = F.wave, r = lane & 15, g = lane >> 4;
    unsigned xqk[8], xvv[8];
    auto load_x = [&](int task_) { const int ck_ = task_ >> 3, h_ = task_ & 7; int seq_, t0_, T_; chunk_pos(ck_, seq_, t0_, T_);
        unsigned rowv = (unsigned)(seq_row0(seq_) + t0_ + 8 * w); asm volatile("" : "+v"(rowv));
#pragma unroll
        for (int tt = 0; tt < 8; ++tt) {
            xqk[tt] = *(const unsigned*)(P + ((rowv + tt) * 3072u + (unsigned)((lane < 32 ? 0 : 512) + h_ * 64 + (lane & 31) * 2)));
            xvv[tt] = *(const unsigned*)(P + ((rowv + tt) * 3072u + (unsigned)(1024 + h_ * 128 + 2 * lane))); } };
    if (F.wg < 96 * 8) load_x(F.wg);
    for (int task = F.wg; task < 96 * 8; task += F.G) {
        const int ck = task >> 3, h = task & 7; int seq, t0, T; chunk_pos(ck, seq, t0, T); const int row0 = seq_row0(seq) + t0;
        __syncthreads();
        {
            bf16_t* QSg = (bf16_t*)(F.big_() + BIG_MQS) + (size_t)task * 4096;
#pragma unroll
            for (int tt = 0; tt < 8; ++tt) { const int tk = 8 * w + tt;
                const int l2 = (lane & 31) * 2;
                const unsigned qk = xqk[tt], vv = xvv[tt];
                if (lane < 32) { const unsigned qs = pk2(bf2f(qk & 0xffffu) * 0.125f, bf2f(qk >> 16) * 0.125f); *(LAS unsigned*)(LQ + tk * 72 + l2) = qs; *(unsigned*)(QSg + tk * 64 + l2) = qs; }
                else { *(LAS unsigned*)(LK + tk * 72 + l2) = qk; LKT[l2 * 72 + tk] = (bf16_t)(qk & 0xffffu); LKT[(l2 + 1) * 72 + tk] = (bf16_t)(qk >> 16); }
                LVT[(2 * lane) * 72 + tk] = (bf16_t)(vv & 0xffffu); LVT[(2 * lane + 1) * 72 + tk] = (bf16_t)(vv >> 16);
            }
        }
        if (task + F.G < 96 * 8) load_x(task + F.G);
        if (w < 2) { const int dir = w, c = dir ? 63 - lane : lane;
            const float li = GT[(size_t)(row0 + c) * 32 + dir * 16 + h] + F.inp(I_MBI)[dir * 8 + h];
            float bc = logsigmoid_f(GT[(size_t)(row0 + c) * 32 + dir * 16 + 8 + h] + F.inp(I_MBF)[dir * 8 + h]);
#pragma unroll
            for (int o = 1; o < 64; o <<= 1) { const float t = __shfl_up(bc, o); if (lane >= o) bc += t; }
            const float a = li - bc; float am = a;
#pragma unroll
            for (int o = 1; o < 64; o <<= 1) { const float t = __shfl_up(am, o); if (lane >= o) am = fmaxf(am, t); }
            SC[dir * 256 + c] = bc; SC[dir * 256 + 64 + c] = a; SC[dir * 256 + 128 + c] = am;
            if (lane == 63) { SC[512 + dir * 2] = bc; SC[512 + dir * 2 + 1] = am; }
        }
        __syncthreads();
        {
            const int mi = w >> 1;
            f32x4 acc[2] = {(f32x4){0.f, 0.f, 0.f, 0.f}, (f32x4){0.f, 0.f, 0.f, 0.f}};
#pragma unroll
            for (int kk = 0; kk < 2; ++kk) { const bf16x8_t a = frag_nat(LQ, 72, 16 * mi + r, 32 * kk, g);
#pragma unroll
                for (int nn = 0; nn < 2; ++nn) acc[nn] = MFMA16(a, frag_nat(LK, 72, 16 * (2 * (w & 1) + nn) + r, 32 * kk, g), acc[nn]); }
#pragma unroll
            for (int nn = 0; nn < 2; ++nn)
#pragma unroll
                for (int i = 0; i < 4; ++i) LQK[(16 * mi + 4 * g + i) * 68 + 16 * (2 * (w & 1) + nn) + r] = acc[nn][i];
        }
        __syncthreads();
        {
            const size_t cd0 = (size_t)task * 2;
#pragma unroll
            for (int it = 0; it < 4; ++it) { const int idx = tid + 512 * it, c = idx >> 5, s = (idx & 31) * 2;
#pragma unroll
                for (int dir = 0; dir < 2; ++dir) { const LAS float* sc = SC + dir * 256;
                    const float amc = sc[128 + c], amL = SC[512 + dir * 2 + 1];
                    float pm[2], kw[2];
#pragma unroll
                    for (int e = 0; e < 2; ++e) { const int ss = s + e; const bool ok = dir ? ss >= c : ss <= c;
                        pm[e] = ok ? LQK[c * 68 + ss] * __expf(sc[64 + ss] - amc) : 0.f;
                        kw[e] = bf2f(LKT[c * 72 + ss]) * __expf(sc[64 + ss] - amL); }
                    *(LAS unsigned*)(LPM + dir * 64 * 72 + c * 72 + s) = pk2(pm[0], pm[1]); *(LAS unsigned*)(LKW + dir * 64 * 72 + c * 72 + s) = pk2(kw[0], kw[1]);
                    float ps = pm[0] + pm[1], ks = kw[0] + kw[1];
#pragma unroll
                    for (int o = 1; o < 32; o <<= 1) { ps += __shfl_xor(ps, o); ks += __shfl_xor(ks, o); }
                    if ((lane & 31) == 0) { float* VEC = (float*)(F.big_() + BIG_MVEC) + (cd0 + dir) * 272; VEC[128 + (c & 15) * 4 + (c >> 4)] = ps; VEC[192 + c] = ks; }
                } }
            if (tid < 128) { const int dir = tid >> 6, c = tid & 63; float* VEC = (float*)(F.big_() + BIG_MVEC) + (cd0 + dir) * 272; const LAS float* sc = SC + dir * 256;
                VEC[(c & 15) * 4 + (c >> 4)] = sc[c]; VEC[64 + (c & 15) * 4 + (c >> 4)] = sc[c] + sc[128 + c];
                if (c == 0) { const float bl = SC[512 + dir * 2]; VEC[256] = bl; VEC[257] = bl + SC[512 + dir * 2 + 1]; } }
        }
        __syncthreads();
#pragma unroll
        for (int dir = 0; dir < 2; ++dir) { const size_t cd = (size_t)task * 2 + dir;
            bf16_t* Ig = (bf16_t*)(F.big_() + BIG_MINTRA) + cd * 8192 + (size_t)w * 1024 + lane * 4; bf16_t* Ug = (bf16_t*)(F.big_() + BIG_MU) + cd * 8192 + (size_t)w * 1024 + lane * 4;
            const bf16x8_t v0 = frag_nat(LVT, 72, 16 * w + r, 0, g), v1 = frag_nat(LVT, 72, 16 * w + r, 32, g);
#pragma unroll
            for (int m = 0; m < 4; ++m) { f32x4 ai = (f32x4){0.f, 0.f, 0.f, 0.f}, au = (f32x4){0.f, 0.f, 0.f, 0.f};
                ai = MFMA16(frag_nat(LPM + dir * 64 * 72, 72, 16 * m + r, 0, g), v0, ai); ai = MFMA16(frag_nat(LPM + dir * 64 * 72, 72, 16 * m + r, 32, g), v1, ai);
                au = MFMA16(frag_nat(LKW + dir * 64 * 72, 72, rowp(m, r), 0, g), v0, au); au = MFMA16(frag_nat(LKW + dir * 64 * 72, 72, rowp(m, r), 32, g), v1, au);
                *(u2v*)(Ig + m * 256) = pk4(ai); *(u2v*)(Ug + m * 256) = pk4(au); }
        }
    }
}
constexpr int MS_LQS = 0, MS_LVEC = 9216, MS_WSCR = 10304;
__device__ __forceinline__ void ml_scan_seq(Frame& F, int seq, int h, int dir, int esl0, int nact) {
    const int lane = F.lane, w = F.wave, r = lane & 15, g = lane >> 4, ws = esl0 + w;
    if (w >= nact) return;
    LAS float* WS = (LAS float*)(F.lds + MS_WSCR) + w * 192;
    const int NC = seq < 16 ? 4 : 16, ck0 = seq < 16 ? seq * 4 : 64 + (seq - 16) * 16, rowS = seq_row0(seq);
    bf16_t* O = (bf16_t*)(F.slab_() + (dir ? SLAB_FULL : 0));
    f32x4 Cacc[4]; float nst = 0.f, mst = 0.f;
    if (seq >= 16) { const size_t sidx = (size_t)((seq - 16) * 2 + dir) * 8 + h; const float* c0 = F.inp(I_SC) + sidx * 8192 + 16 * ws + r;
#pragma unroll
        for (int j = 0; j < 4; ++j)
#pragma unroll
            for (int i = 0; i < 4; ++i) Cacc[j][i] = c0[(32 * (j >> 1) + 8 * g + 4 * (j & 1) + i) * 128];
        nst = F.inp(I_SN)[sidx * 64 + lane]; mst = F.inp(I_SM)[sidx]; }
    else {
#pragma unroll
        for (int j = 0; j < 4; ++j) Cacc[j] = (f32x4){0.f, 0.f, 0.f, 0.f}; }
    struct MStage { bf16x8_t qf[4][2]; f32x4 vt[3]; float ks, bl, wm; u2v I[4], U[4]; };
    constexpr int PD = 2;
    MStage st[PD];
#define MS_LOAD(S, n) do { const int ckn = ck0 + (dir ? NC - 1 - (n) : (n)); const size_t tk = (size_t)ckn * 8 + h, cd = tk * 2 + dir; \
        const bf16_t* gQ = (const bf16_t*)(F.big_() + BIG_MQS) + tk * 4096 + r * 64 + 8 * g; const float* gV = (const float*)(F.big_() + BIG_MVEC) + cd * 272; \
        _Pragma("unroll") for (int m = 0; m < 4; ++m) { S.qf[m][0] = *(const bf16x8_t*)(gQ + m * 1024); S.qf[m][1] = *(const bf16x8_t*)(gQ + m * 1024 + 32); } \
        _Pragma("unroll") for (int q = 0; q < 3; ++q) S.vt[q] = *(const f32x4*)(gV + q * 64 + r * 4); \
        S.ks = gV[192 + lane]; S.bl = gV[256]; S.wm = gV[257]; \
        const bf16_t* gI = (const bf16_t*)(F.big_() + BIG_MINTRA) + cd * 8192 + (size_t)ws * 1024 + lane * 4; const bf16_t* gU = (const bf16_t*)(F.big_() + BIG_MU) + cd * 8192 + (size_t)ws * 1024 + lane * 4; \
        _Pragma("unroll") for (int m = 0; m < 4; ++m) { S.I[m] = *(const u2v*)(gI + m * 256); S.U[m] = *(const u2v*)(gU + m * 256); } } while (0)
#pragma unroll
    for (int k = 0; k < PD; ++k) MS_LOAD(st[k], k);
    for (int n0 = 0; n0 < NC; n0 += PD) {
#pragma unroll
      for (int k = 0; k < PD; ++k) { const int n = n0 + k; const int ckc = ck0 + (dir ? NC - 1 - n : n);
        WS[lane] = nst;
        const f32x4 na0 = *(const LAS f32x4*)(WS + 8 * g), na1 = *(const LAS f32x4*)(WS + 8 * g + 4), nb0 = *(const LAS f32x4*)(WS + 32 + 8 * g), nb1 = *(const LAS f32x4*)(WS + 32 + 8 * g + 4);
        float qn[4];
#pragma unroll
        for (int m = 0; m < 4; ++m) { const bf16x8_t qa = st[k].qf[m][0], qb = st[k].qf[m][1]; float p = 0.f;
#pragma unroll
            for (int e = 0; e < 4; ++e) { p += bf2f((unsigned short)qa[e]) * na0[e]; p += bf2f((unsigned short)qa[4 + e]) * na1[e]; p += bf2f((unsigned short)qb[e]) * nb0[e]; p += bf2f((unsigned short)qb[4 + e]) * nb1[e]; }
            p += __shfl_xor(p, 16); p += __shfl_xor(p, 32); qn[m] = p; }
#pragma unroll
        for (int m = 0; m < 4; ++m) { const float bc = st[k].vt[0][m], dm = st[k].vt[1][m], rs = st[k].vt[2][m];
            const float mt = fmaxf(bc + mst, dm), inter = __expf(bc + mst - mt), rr = __expf(dm - mt);
            const float inv = __builtin_amdgcn_rcpf(fmaxf(fabsf(inter * qn[m] + rr * rs), __expf(-mt)));
            if (g == 0) { WS[64 + 16 * m + r] = inter * inv; WS[128 + 16 * m + r] = rr * inv; } }
        const bf16x8_t Cb0 = pack_acc(Cacc[0], Cacc[1]), Cb1 = pack_acc(Cacc[2], Cacc[3]);
#pragma unroll
        for (int m = 0; m < 4; ++m) { f32x4 qc = (f32x4){0.f, 0.f, 0.f, 0.f};
            qc = MFMA16(st[k].qf[m][0], Cb0, qc); qc = MFMA16(st[k].qf[m][1], Cb1, qc);
            const f32x4 ac = *(const LAS f32x4*)(WS + 64 + 16 * m + 4 * g), bcf = *(const LAS f32x4*)(WS + 128 + 16 * m + 4 * g);
            const f32x4 hv = ac * qc + bcf * up4(st[k].I[m]);
            bf16_t* op = O + (size_t)(rowS + (ckc - ck0) * 64 + 16 * m + 4 * g) * D + h * 128 + 16 * ws + r;
            const unsigned p01 = cvtpk(hv[0], hv[1]), p23 = cvtpk(hv[2], hv[3]);
            op[0] = (bf16_t)p01; op[(size_t)D] = (bf16_t)(p01 >> 16); op[(size_t)2 * D] = (bf16_t)p23; op[(size_t)3 * D] = (bf16_t)(p23 >> 16); }
        const float bl = st[k].bl, wm = st[k].wm, mn = fmaxf(bl + mst, wm), dec = __expf(bl + mst - mn), fw = __expf(wm - mn);
#pragma unroll
        for (int j = 0; j < 4; ++j) Cacc[j] = Cacc[j] * dec + up4(st[k].U[j]) * fw;
        nst = dec * nst + fw * st[k].ks; mst = mn;
        if (n + PD < NC) MS_LOAD(st[k], n + PD);
      }
    }
#undef MS_LOAD
    if (seq < 16) { const size_t sidx = (size_t)(seq * 2 + dir) * 8 + h; float* nc = F.out + O_NC + sidx * 8192 + 16 * ws + r;
#pragma unroll
        for (int j = 0; j < 4; ++j)
#pragma unroll
            for (int i = 0; i < 4; ++i) nc[(32 * (j >> 1) + 8 * g + 4 * (j & 1) + i) * 128] = Cacc[j][i];
        if (w == 0) { F.out[O_NN + sidx * 64 + lane] = nst; if (lane == 0) F.out[O_NM + sidx] = mst; } }
}
__device__ __forceinline__ bool ml_scan_slot(int wg, int rnd, int& seq, int& h, int& dir, int& esl0, int& nact) {
    int id;
    if (wg < 64) { if (rnd) return false; id = wg >> 1; esl0 = (wg & 1) * 4; nact = 4; seq = 16 + id / 16; }
    else { if (wg >= 160) return false; id = (wg - 64) + rnd * 96; if (id >= 256) return false; esl0 = 0; nact = 8; seq = id / 16; }
    h = (id >> 1) & 7; dir = id & 1; return true;
}
__device__ __forceinline__ void ph_ml_scan2(Frame& F) {
    for (int rnd = 0; rnd < 3; ++rnd) { int seq, h, dir, esl0, nact; if (!ml_scan_slot(F.wg, rnd, seq, h, dir, esl0, nact)) break; ml_scan_seq(F, seq, h, dir, esl0, nact); }
}
__device__ __forceinline__ void ph_post(Frame& F, int NP, int gate_col0, int gate_kind, const float* nw) {
    const bf16_t* P = (const bf16_t*)(F.big_() + BIG_PROJ); const bf16_t* OF = (const bf16_t*)F.slab_(); const bf16_t* OB = (const bf16_t*)(F.slab_() + SLAB_FULL); bf16_t* OG = (bf16_t*)(F.big_() + BIG_OG);
    const int gw = F.wg * NWAVES + F.wave, NGW = F.G * NWAVES, lane = F.lane;
    const f32x2 w = *(const f32x2*)(nw + 2 * lane);
    constexpr int IU = 6;
    for (int ib = gw; ib < MTOT * 8; ib += IU * NGW) {
        f32x2 v[IU]; unsigned zz[IU];
#pragma unroll
        for (int q = 0; q < IU; ++q) { const int it = ib + q * NGW; const bool ok = it < MTOT * 8; const int row = ok ? it >> 3 : 0, h = it & 7; const size_t o = (size_t)row * D + h * 128 + 2 * lane;
            { const unsigned uf = *(const unsigned*)(OF + o), ub = *(const unsigned*)(OB + o); v[q] = (f32x2){bf2f(uf & 0xffffu) + bf2f(ub & 0xffffu), bf2f(uf >> 16) + bf2f(ub >> 16)}; } zz[q] = *(const unsigned*)(P + (size_t)row * NP + gate_col0 + h * 128 + 2 * lane); }
#pragma unroll
        for (int q = 0; q < IU; ++q) { const int it = ib + q * NGW; if (it >= MTOT * 8) continue; const int row = it >> 3, h = it & 7; const size_t o = (size_t)row * D + h * 128 + 2 * lane;
            const float rstd = rsqrtf(wave_sum(v[q][0] * v[q][0] + v[q][1] * v[q][1]) * (1.f / 128.f) + EPS);
            const float z0 = bf2f(zz[q] & 0xffffu), z1 = bf2f(zz[q] >> 16);
            const float g0 = gate_kind == 0 ? silu_f(z0) : sigmoid_f(z0), g1 = gate_kind == 0 ? silu_f(z1) : sigmoid_f(z1);
            st4_wt(OG + o, cvtpk(v[q][0] * rstd * w[0] * g0, v[q][1] * rstd * w[1] * g1)); }
    }
}

#define R(cls, call) do { call; if (PROBE_MASK & (1 << (cls))) { call; } } while (0)
constexpr int NPHASES = 36;
__global__ void __launch_bounds__(NTHR, 2) mega(Args args) {
    extern __shared__ __attribute__((aligned(16))) unsigned char lds_raw[];
    Frame F;
    F.out = args.out; F.ws = args.ws; F.lds = (LAS unsigned char*)lds_raw;
    F.tid = threadIdx.x; F.lane = F.tid & 63; F.wave = __builtin_amdgcn_readfirstlane(F.tid >> 6); F.G = gridDim.x; F.wg = blockIdx.x;
    volatile LAS unsigned* MISC = (volatile LAS unsigned*)(F.lds + MISC_OFF);
    if (F.tid < 64) MISC[F.tid] = 0u;
    if (F.tid >= 64 && F.tid < 64 + N_IN) ((LAS unsigned long long*)(F.lds + PTR_OFF))[F.tid - 64] = (unsigned long long)args.in[F.tid - 64];
    __syncthreads();
    const int lo = args.ph_lo, hi = args.ph_hi;
    XcdBarrier bar; bar.bar = (unsigned*)(args.ws + WS_CTL); bar.x = 0; bar.st = MISC + 8;
    if (hi - lo > 1) bar = xcd_barrier_post((unsigned*)(args.ws + WS_CTL), MISC + 8);
    int ph = 0;
#define PH_BEGIN if (ph >= lo && ph < hi) {
#define PH_END   if (ph + 1 < hi) xcd_barrier(bar); } ++ph;
#define PH_END_PRE(Bexpr, ldb) if (ph + 1 < hi) xcd_barrier_pre(bar, F.lds, Bexpr, ldb); } ++ph;
    #define in_nmix F.inp(I_NMIX)
#define in_nffn F.inp(I_NFFN)

    PH_BEGIN R(4, ph_prologue(F)); PH_END
    PH_BEGIN R(3, ph_wcs(F)); ph_norm(F, -1, 0, nullptr, 0, 0, 1.f, 1.f, 0, 0, in_nmix, true, 64); PH_END
#define MIX_FOURIER(j) \
    PH_BEGIN R(3, ph_f1(F, j)); PH_END \
    PH_BEGIN R(3, ph_f2(F)); PH_END
#define FFN_BLOCK(l, mbias, nsc, nss, sc_c, sc_s) \
    PH_BEGIN ph_norm(F, l, 2, mbias, nsc, nss, sc_c, sc_s, l, 3, in_nffn + (l) * D); PH_END_PRE(firstB_up(F, l), D) \
    PH_BEGIN ph_ffn_up(F, l); PH_END \
    PH_BEGIN R(2, ph_ffn_conv(F, l)); PH_END_PRE(firstB_slab(F, (const bf16_t*)(F.big_() + BIG_ACT), DFF, F.wt_() + WT_DN + (size_t)(l) * D * DFF * 2), DFF) \
    PH_BEGIN ph_gemm_slab(F, (const bf16_t*)(F.big_() + BIG_ACT), DFF, F.wt_() + WT_DN + (size_t)(l) * D * DFF * 2); PH_END
    MIX_FOURIER(0)
    FFN_BLOCK(0, F.inp(I_FB), 1, 4, 1.f / 256.f, 1.f / 512.f)
    PH_BEGIN ph_norm(F, 0, 5, nullptr, 2, 2, 1.f, 1.f, 1, 0, in_nmix + 1 * D); PH_END_PRE(firstB_proj(F, F.wt_() + WT_DIN, 16), D)
    PH_BEGIN ph_proj(F, F.wt_() + WT_DIN, 16); PH_END
    PH_BEGIN R(5, ph_dn_prep2(F)); PH_END
    PH_BEGIN R(0, ph_dn_scan2(F)); PH_END
    PH_BEGIN R(7, ph_post(F, 4096, 3072, 0, F.inp(I_DNORM))); PH_END_PRE(firstB_slab(F, (const bf16_t*)(F.big_() + BIG_OG), D, F.wt_() + WT_DOUT), D)
    PH_BEGIN ph_gemm_slab(F, (const bf16_t*)(F.big_() + BIG_OG), D, F.wt_() + WT_DOUT); PH_END
    FFN_BLOCK(1, nullptr, 2, 2, 1.f, 1.f)
    PH_BEGIN ph_norm(F, 1, 5, nullptr, 2, 2, 1.f, 1.f, 2, 0, in_nmix + 2 * D); PH_END_PRE(firstB_proj(F, F.wt_() + WT_MIN, 12), D)
    PH_BEGIN ph_proj(F, F.wt_() + WT_MIN, 12); PH_END
    PH_BEGIN R(6, ph_ml_prep(F)); PH_END_PRE(firstB_og(F), D)
    PH_BEGIN R(0, ph_ml_scan2(F)); ph_ml_ogate(F); PH_END
    PH_BEGIN R(7, ph_post(F, 3072, 2048, 1, F.inp(I_MNORM))); PH_END_PRE(firstB_slab(F, (const bf16_t*)(F.big_() + BIG_OG), D, F.wt_() + WT_MOUT), D)
    PH_BEGIN ph_gemm_slab(F, (const bf16_t*)(F.big_() + BIG_OG), D, F.wt_() + WT_MOUT); PH_END
    FFN_BLOCK(2, nullptr, 2, 2, 1.f, 1.f)
    PH_BEGIN ph_norm(F, 2, 5, nullptr, 2, 2, 1.f, 1.f, 3, 0, in_nmix + 3 * D); PH_END
    MIX_FOURIER(1)
    FFN_BLOCK(3, F.inp(I_FB) + D, 1, 4, 1.f / 256.f, 1.f / 512.f)
    PH_BEGIN ph_norm(F, 3, 5, nullptr, 2, 2, 1.f, 1.f, -1, 0, F.inp(I_NFIN)); PH_END
}

extern "C" void kernel_launch(void* const* d_in, const int* in_sizes, int n_in, void* d_out, int out_size, void* d_ws, size_t ws_size, hipStream_t stream) {
    static int grid = 0;
    if (grid == 0) {
        if (n_in != N_IN || ws_size < WS_END) { fprintf(stderr, "kernel_launch: unexpected n_in %d / ws %zu (need %zu)\n", n_in, ws_size, (size_t)WS_END); grid = -1; return; }
        int dev = 0, cus = 0, per_cu = 0;
        (void)hipGetDevice(&dev); (void)hipDeviceGetAttribute(&cus, hipDeviceAttributeMultiprocessorCount, dev);
        (void)hipFuncSetAttribute((const void*)mega, hipFuncAttributeMaxDynamicSharedMemorySize, LDS_BYTES);
        if (hipOccupancyMaxActiveBlocksPerMultiprocessor(&per_cu, (const void*)mega, NTHR, LDS_BYTES) != hipSuccess || per_cu < 1) per_cu = 1;
        (void)hipGetLastError();
        (void)cus; grid = 256;
    }
    if (grid < 0) return;
    (void)hipMemsetAsync((char*)d_ws + WS_CTL, 0, ZERO_BYTES, stream);
    Args a{};
    for (int i = 0; i < N_IN; ++i) a.in[i] = (const float*)d_in[i];
    a.out = (float*)d_out; a.ws = (unsigned char*)d_ws;
#if N_LAUNCH_MODE == 1
    a.ph_lo = 0; a.ph_hi = NPHASES;
    void* kargs[] = {&a};
    hipError_t e = hipLaunchCooperativeKernel((const void*)mega, dim3(grid), dim3(NTHR), kargs, LDS_BYTES, stream);
    if (e != hipSuccess) fprintf(stderr, "cooperative launch failed: %s (grid %d)\n", hipGetErrorString(e), grid);
#else
    for (int p = 0; p < NPHASES; ++p) { a.ph_lo = p; a.ph_hi = p + 1; hipLaunchKernelGGL(mega, dim3(grid), dim3(NTHR), LDS_BYTES, stream, a); }
#endif
}
```

```cpp
#include <hip/hip_runtime.h>
#include <cstdint>
#include <cstdio>

#ifndef PROBE_MASK
#define PROBE_MASK 0
#endif
#ifndef N_LAUNCH_MODE
#define N_LAUNCH_MODE 1
#endif

#define LAS __attribute__((address_space(3)))
#define GAS __attribute__((address_space(1)))
typedef unsigned short bf16_t;
typedef float f32x4 __attribute__((ext_vector_type(4)));
typedef float f32x2 __attribute__((ext_vector_type(2)));
typedef unsigned u4v __attribute__((ext_vector_type(4)));
typedef unsigned u2v __attribute__((ext_vector_type(2)));
typedef __bf16 bf16x2_t __attribute__((ext_vector_type(2)));
__device__ __forceinline__ unsigned cvtpk(float lo, float hi) { const f32x2 v = {lo, hi}; return __builtin_bit_cast(unsigned, __builtin_convertvector(v, bf16x2_t)); }

constexpr int D = 1024, MCTX = 4096, MTOT = 6144;
constexpr int DFF = 2816, NUP = 5632;
constexpr int DN_PROJ = 4128, ML_PROJ = 3104;
constexpr int NWAVES = 8, NTHR = 512;
constexpr float EPS = 1e-6f;
enum { I_XP = 0, I_XS, I_SD, I_SC, I_SN, I_SM, I_C, I_CCTX, I_WADA, I_BADA, I_NMIX, I_NFFN, I_NFIN, I_WUP, I_CW, I_CB, I_WDN,
       I_FW, I_FB, I_DWIN, I_DCW, I_DALOG, I_DDT, I_DNORM, I_DWOUT, I_MWIN, I_MBI, I_MBF, I_MNORM, I_MWOUT, N_IN };
constexpr size_t O_Y = 0, O_ND = 6291456, O_NC = 10485760, O_NN = 12582912, O_NM = 12599296;

constexpr size_t WS_CTL = 0;
constexpr size_t CTL_BYTES = 65536;
constexpr size_t ZERO_BYTES = CTL_BYTES;
constexpr size_t WS_MOD = WS_CTL + CTL_BYTES;
constexpr size_t MOD_BYTES = 4 * 3 * 6144 * 4;
constexpr size_t WS_X = WS_MOD + MOD_BYTES;
constexpr size_t WS_H = WS_X + (size_t)MTOT * D * 4;
constexpr size_t WS_TAB = WS_H + (size_t)MTOT * D * 2;
constexpr size_t TAB_CS256 = 0, TAB_CST256 = 512 * 256 * 2, TAB_CST1024 = TAB_CST256 + 256 * 512 * 2, TAB_BYTES = TAB_CST1024 + 1024 * 2048 * 2;
constexpr size_t WS_WT = WS_TAB + TAB_BYTES;
constexpr size_t WT_UP = 0;
constexpr size_t WT_DN = WT_UP + (size_t)4 * NUP * D * 2;
constexpr size_t WT_F = WT_DN + (size_t)4 * D * DFF * 2;
constexpr size_t WT_CS = WT_F + (size_t)2 * D * D * 2;
constexpr size_t WT_DIN = WT_CS + (size_t)2 * 2048 * D * 2;
constexpr size_t WT_DOUT = WT_DIN + (size_t)4352 * D * 2;
constexpr size_t WT_MIN = WT_DOUT + (size_t)D * D * 2;
constexpr size_t WT_MOUT = WT_MIN + (size_t)3328 * D * 2;
constexpr size_t WT_BYTES = WT_MOUT + (size_t)D * D * 2;
constexpr size_t WS_SLAB = WS_WT + WT_BYTES;
constexpr size_t SLAB_FULL = (size_t)MTOT * D * 4, SLAB_SMP = (size_t)2048 * D * 4;
constexpr size_t WS_BIG = WS_SLAB + 2 * SLAB_FULL + 2 * SLAB_SMP;
constexpr size_t BIG_UG = 0;
constexpr size_t BIG_ACT = BIG_UG + (size_t)MTOT * NUP * 2;
constexpr size_t BIG_ZTC = 0;
constexpr size_t BIG_ZTS = BIG_ZTC + (size_t)16 * 1024 * 512 * 2;
constexpr size_t BIG_PROJ = 0;
constexpr size_t BIG_GATES = BIG_PROJ + (size_t)MTOT * 4096 * 2;
constexpr size_t BIG_OG = BIG_GATES + (size_t)MTOT * 32 * 4;
constexpr size_t BIG_WN = BIG_OG + (size_t)MTOT * D * 2;
constexpr size_t BIG_QKM = BIG_WN + (size_t)1536 * 8192 * 2;
constexpr size_t BIG_U = BIG_QKM + (size_t)1536 * 4096 * 2;
constexpr size_t BIG_VEC = BIG_U + (size_t)1536 * 8192 * 4;
constexpr size_t BIG_QS = BIG_VEC + (size_t)1536 * 192 * 4;
constexpr size_t BIG_KTG = BIG_QS + (size_t)768 * 8192 * 2;
constexpr size_t BIG_END_DN = BIG_KTG + (size_t)768 * 8192 * 2;
constexpr size_t BIG_END = BIG_END_DN > (size_t)MTOT * NUP * 2 + (size_t)MTOT * DFF * 2 ? BIG_END_DN : (size_t)MTOT * NUP * 2 + (size_t)MTOT * DFF * 2;
constexpr size_t BIG_Q = 0, BIG_K = 0, BIG_V = 0, BIG_GA = 0, BIG_BE = 0;
constexpr size_t WS_END = WS_BIG + BIG_END;

constexpr int LDS_BYTES = 131072 + 1024 + 4096;
constexpr int MISC_OFF = 131072;

__device__ __forceinline__ unsigned f2bf(float f) { unsigned u = __builtin_bit_cast(unsigned, f); return (u + 0x7fffu + ((u >> 16) & 1u)) >> 16; }
__device__ __forceinline__ float bf2f(unsigned h) { return __builtin_bit_cast(float, h << 16); }
__device__ __forceinline__ unsigned pk2(float lo, float hi) { return cvtpk(lo, hi); }
__device__ __forceinline__ float dpp_add(float v, const int ctrl_sel) {
    int s;
    switch (ctrl_sel) {
        case 0: s = __builtin_amdgcn_update_dpp(0, __builtin_bit_cast(int, v), 0xB1, 0xF, 0xF, true); break;
        case 1: s = __builtin_amdgcn_update_dpp(0, __builtin_bit_cast(int, v), 0x4E, 0xF, 0xF, true); break;
        case 2: s = __builtin_amdgcn_update_dpp(0, __builtin_bit_cast(int, v), 0x141, 0xF, 0xF, true); break;
        default: s = __builtin_amdgcn_update_dpp(0, __builtin_bit_cast(int, v), 0x140, 0xF, 0xF, true); break;
    }
    return v + __builtin_bit_cast(float, s);
}
__device__ __forceinline__ float wave_sum(float v) {
    v = dpp_add(v, 0); v = dpp_add(v, 1); v = dpp_add(v, 2); v = dpp_add(v, 3);
    const int iv = __builtin_bit_cast(int, v);
    const float r0 = __builtin_bit_cast(float, __builtin_amdgcn_readlane(iv, 0)), r1 = __builtin_bit_cast(float, __builtin_amdgcn_readlane(iv, 16));
    const float r2 = __builtin_bit_cast(float, __builtin_amdgcn_readlane(iv, 32)), r3 = __builtin_bit_cast(float, __builtin_amdgcn_readlane(iv, 48));
    return (r0 + r1) + (r2 + r3);
}
__device__ __forceinline__ float silu_f(float x) { return x * __builtin_amdgcn_rcpf(1.f + __expf(-x)); }
__device__ __forceinline__ float sigmoid_f(float x) { return __builtin_amdgcn_rcpf(1.f + __expf(-x)); }
__device__ __forceinline__ float softplus_f(float x) { return x > 20.f ? x : log1pf(expf(x)); }
__device__ __forceinline__ float logsigmoid_f(float x) { return fminf(x, 0.f) - log1pf(expf(-fabsf(x))); }
__device__ __forceinline__ int row_cond(int r) { return r < MCTX ? 0 : 1 + ((r - MCTX) >> 10); }
__device__ __forceinline__ void row_seq(int r, int& seq, int& t, int& T) {
    if (r < MCTX) { seq = r >> 8; t = r & 255; T = 256; } else { seq = 16 + ((r - MCTX) >> 10); t = (r - MCTX) & 1023; T = 1024; }
}
__device__ __forceinline__ int seq_row0(int seq) { return seq < 16 ? seq * 256 : MCTX + (seq - 16) * 1024; }
__device__ __forceinline__ int seq_len(int seq) { return seq < 16 ? 256 : 1024; }

#define XB_TMO      128
#define XB_XCNT(j)  (256  + 64 * (j))
#define XB_XSUB(j)  (1280 + 64 * (j))
#define XB_XGEN(j)  (2304 + 64 * (j))
#define XB_TOP      3328
#define XB_TOPGEN   3392
#define XCD_BAR_WORDS 3456
#define XB_SPIN_CAP (1u << 20)
__device__ __forceinline__ unsigned xb_ld(unsigned* p)              { return __hip_atomic_load(p, __ATOMIC_RELAXED, __HIP_MEMORY_SCOPE_AGENT); }
__device__ __forceinline__ unsigned xb_add(unsigned* p, unsigned v) { return __hip_atomic_fetch_add(p, v, __ATOMIC_RELAXED, __HIP_MEMORY_SCOPE_AGENT); }
__device__ __forceinline__ unsigned xb_xcc_id() { return (unsigned)__builtin_amdgcn_s_getreg((3 << 11) | 20) & 0xFu; }
#define XB_SPIN(cond, bar) do { unsigned _sp = 0; while (cond) { __builtin_amdgcn_s_sleep(1); \
    if ((++_sp & 255u) == 0u) { if (xb_ld(&(bar)[XB_TMO])) break; if (_sp > XB_SPIN_CAP) { atomicAdd(&(bar)[XB_TMO], 1u); break; } } } } while (0)
struct XcdBarrier { unsigned* bar; unsigned x; volatile LAS unsigned* st; };
__device__ __forceinline__ XcdBarrier xcd_barrier_post(unsigned* bar, volatile LAS unsigned* st) {
    XcdBarrier b; b.bar = bar; b.x = xb_xcc_id(); b.st = st;
    if (threadIdx.x == 0) (void)xb_add(&bar[XB_XCNT(b.x)], 1u);
    return b;
}
__device__ __forceinline__ void xcd_barrier_complete(unsigned* bar, unsigned x, unsigned& nloc, unsigned& nx) {
    const unsigned G = gridDim.x * gridDim.y * gridDim.z;
    unsigned sum, cnt, mine, sp = 0u;
    for (;;) {
        sum = 0u; cnt = 0u; mine = 0u;
#pragma unroll
        for (unsigned j = 0; j < 16; ++j) { const unsigned c = xb_ld(&bar[XB_XCNT(j)]); sum += c; cnt += (c > 0u) ? 1u : 0u; mine = (j == x) ? c : mine; }
        if (sum == G) break;
        __builtin_amdgcn_s_sleep(1);
        if ((++sp & 255u) == 0u) { if (xb_ld(&bar[XB_TMO])) break; if (sp > XB_SPIN_CAP) { atomicAdd(&bar[XB_TMO], 1u); break; } }
    }
    nloc = mine > 0u ? mine : 1u; nx = cnt > 0u ? cnt : 1u;
}
__device__ __forceinline__ void xcd_barrier(const XcdBarrier& b) {
    asm volatile("s_waitcnt vmcnt(0)" ::: "memory");
    __syncthreads();
    if (threadIdx.x == 0) {
        unsigned* bar = b.bar;
        __builtin_amdgcn_s_waitcnt(0);
        unsigned nloc = b.st[0], nx = b.st[1];
        if (nloc == 0u) { xcd_barrier_complete(bar, b.x, nloc, nx); b.st[0] = nloc; b.st[1] = nx; }
        const unsigned old = xb_add(&bar[XB_XSUB(b.x)], 1u);
        asm volatile("buffer_inv sc1" ::: "memory");
        const unsigned gen = old / nloc;
        if (old + 1u == (gen + 1u) * nloc) {
            __builtin_amdgcn_fence(__ATOMIC_RELEASE, "agent");
            asm volatile("s_waitcnt vmcnt(0)" ::: "memory");
            const unsigned og = xb_add(&bar[XB_TOP], 1u);
            const unsigned tg = og / nx;
            if (og + 1u == (tg + 1u) * nx) xb_add(&bar[XB_TOPGEN], 1u);
            else XB_SPIN(xb_ld(&bar[XB_TOPGEN]) == tg, bar);
            xb_add(&bar[XB_XGEN(b.x)], 1u);
            asm volatile("s_waitcnt vmcnt(0)" ::: "memory");
        } else {
            XB_SPIN(xb_ld(&bar[XB_XGEN(b.x)]) == gen, bar);
            asm volatile("s_waitcnt vmcnt(0)" ::: "memory");
        }
    }
    __syncthreads();
}

namespace pg8 {
typedef short bf16x8 __attribute__((ext_vector_type(8)));
typedef unsigned u32x4 __attribute__((ext_vector_type(4)));
constexpr int BM = 256, BK = 64, HALF = 128, HTB = HALF * BK * 2, STAGE_BYTES = 8 * HTB, NXCD = 8, WGM = 8;
__device__ __forceinline__ int lds_byte(int r, int c) { const int st = (r >> 4) * 2 + (c >> 5), rr = r & 15, cc = c & 31, ob = rr * 64 + cc * 2; return st * 1024 + (ob ^ (((ob >> 9) & 1) << 5)); }
__device__ __forceinline__ void stage_rc(int b, int& R, int& C) { const int st = b / 1024, sb = b % 1024, swz = sb ^ (((sb >> 9) & 1) << 5); R = (st >> 1) * 16 + swz / 64; C = (st & 1) * 32 + (swz % 64) / 2; }
__device__ __forceinline__ int perm32(int rho) { const int n = rho >> 4, i = rho & 15; return 8 * (i >> 2) + 4 * n + (i & 3); }
__device__ __forceinline__ unsigned cvt_pk_bf16(float lo, float hi) { unsigned r; asm volatile("v_cvt_pk_bf16_f32 %0, %1, %2" : "=v"(r) : "v"(lo), "v"(hi)); return r; }

struct Unit { const char* A; const char* B; char* out; int nt, ldc, flag, row0; };
__device__ __forceinline__ bool tile_order(int L, int nM, int nN, int& pm, int& pn) {
    const int nwg = nM * nN; if (L >= nwg || L < 0) return false;
    int wgid = L; { const int q = nwg / NXCD, r = nwg % NXCD, xcd = wgid % NXCD, off = wgid / NXCD; wgid = (xcd < r ? xcd * (q + 1) : r * (q + 1) + (xcd - r) * q) + off; }
    const int nig = WGM * nN, gid = wgid / nig, fm = gid * WGM, gsz = (nM - fm) < WGM ? (nM - fm) : WGM;
    pm = fm + ((wgid % nig) % gsz); pn = (wgid % nig) / gsz; return true;
}
struct SchedPlain {
    int G, c, nM, nN, ns, lda, ldb, ldc, nt, osz, gate_pn, lim; const char* A; const char* B; char* O; size_t osplit;
    __device__ __forceinline__ bool next(int i, Unit& u) const {
        int pm, pq; if (i * G + c >= lim || !tile_order(i * G + c, nM, nN * ns, pm, pq)) return false;
        const int pn = pq % nN, ks = pq / nN;
        u.A = A + ((size_t)pm * 256 * lda + (size_t)ks * nt * 64) * 2; u.B = B + ((size_t)pn * 256 * ldb + (size_t)ks * nt * 64) * 2;
        u.out = O + (size_t)ks * osplit + ((size_t)pm * 256 * ldc + (size_t)pn * 256) * osz; u.nt = nt; u.ldc = ldc; u.flag = (pn == gate_pn) ? 1 : 0; u.row0 = pm * 256; return true;
    }
};
struct EpiF32 {
    static constexpr bool PERM = false;
    __device__ __forceinline__ void operator()(const f32x4 (&acc)[2][2][4][2], const Unit& u, int wr, int wc, int fr, int fq) const {
        char* outp = u.out; asm volatile("" : "+v"(outp)); GAS float* C = (GAS float*)outp; int tl = threadIdx.x; asm volatile("" : "+v"(tl)); fr = tl & 15; fq = (tl >> 4) & 3; const int row0 = wr * 64 + fr; const int col0 = wc * 32 + 4 * fq;
#pragma unroll
        for (int ai = 0; ai < 2; ++ai)
#pragma unroll
            for (int m = 0; m < 4; ++m) { GAS float* rowp = C + (size_t)(row0 + ai * HALF + m * 16) * u.ldc + col0;
#pragma unroll
                for (int bj = 0; bj < 2; ++bj)
#pragma unroll
                    for (int n = 0; n < 2; ++n) *(GAS f32x4*)(rowp + bj * HALF + n * 16) = acc[ai][bj][m][n]; }
    }
};
template <int OFF> __device__ __forceinline__ void st16_wt(GAS u32x4* p, const u32x4& v) { asm volatile("global_store_dwordx4 %0, %1, off offset:%2 sc1\n\ts_nop 1" :: "v"(p), "v"(v), "n"(OFF) : "memory"); }
struct EpiBf16 {
    static constexpr bool PERM = true;
    float* gates;
    __device__ __forceinline__ void operator()(const f32x4 (&acc)[2][2][4][2], const Unit& u, int wr, int wc, int fr, int fq) const {
        int tl = threadIdx.x; asm volatile("" : "+v"(tl)); fr = tl & 15; fq = (tl >> 4) & 3; const int row0 = wr * 64 + fr; const int col0 = wc * 32 + 8 * fq;
        if (u.flag) {
            if (wc == 0) {
#pragma unroll
                for (int ai = 0; ai < 2; ++ai)
#pragma unroll
                    for (int m = 0; m < 4; ++m) { GAS float* gp = (GAS float*)gates + (size_t)(u.row0 + row0 + ai * HALF + m * 16) * 32 + 8 * fq;
                        *(GAS f32x4*)gp = acc[ai][0][m][0]; *(GAS f32x4*)(gp + 4) = acc[ai][0][m][1]; }
            }
            return;
        }
        char* outp = u.out; asm volatile("" : "+v"(outp)); GAS bf16_t* O = (GAS bf16_t*)outp;
#pragma unroll
        for (int ai = 0; ai < 2; ++ai)
#pragma unroll
            for (int m = 0; m < 4; ++m) { GAS bf16_t* rowp = O + (size_t)(row0 + ai * HALF + m * 16) * u.ldc + col0;
#pragma unroll
                for (int bj = 0; bj < 2; ++bj) { const f32x4 v0 = acc[ai][bj][m][0], v1 = acc[ai][bj][m][1];
                    u32x4 w; w.x = cvt_pk_bf16(v0[0], v0[1]); w.y = cvt_pk_bf16(v0[2], v0[3]); w.z = cvt_pk_bf16(v1[0], v1[1]); w.w = cvt_pk_bf16(v1[2], v1[3]);
                    if (bj == 0) st16_wt<0>((GAS u32x4*)rowp, w); else st16_wt<HALF * 2>((GAS u32x4*)rowp, w); } }
    }
};

template <bool PERM>
__device__ __forceinline__ void prestage_B(LAS unsigned char* lds, const char* B, int ldb) {
    const int tid = threadIdx.x, wid = __builtin_amdgcn_readfirstlane(tid >> 6), lane = tid & 63;
    if (wid == 0 || B == nullptr) return;
    const size_t hstepB = (size_t)HALF * ldb * 2;
#pragma unroll 1
    for (int pass = 0; pass < (wid == 1 ? 2 : 1); ++pass) { const int vw = pass ? 0 : wid; const unsigned ldsw = (unsigned)vw * 1024u;
#pragma unroll
        for (int i = 0; i < 2; ++i) { int R, C; stage_rc((vw * 64 + lane) * 16 + i * 8192, R, C); const int Rb = PERM ? ((R & ~31) + perm32(R & 31)) : R;
            const char* src = B + (unsigned)(Rb * ldb + C) * 2u;
            __builtin_amdgcn_global_load_lds((const unsigned*)src, (LAS unsigned*)(lds + (4 + 0) * HTB + ldsw + i * 8192), 16, 0, 0);
            __builtin_amdgcn_global_load_lds((const unsigned*)(src + hstepB), (LAS unsigned*)(lds + (4 + 1) * HTB + ldsw + i * 8192), 16, 0, 0);
            __builtin_amdgcn_global_load_lds((const unsigned*)(src + BK * 2), (LAS unsigned*)(lds + (4 + 2) * HTB + ldsw + i * 8192), 16, 0, 0);
            __builtin_amdgcn_global_load_lds((const unsigned*)(src + hstepB + BK * 2), (LAS unsigned*)(lds + (4 + 3) * HTB + ldsw + i * 8192), 16, 0, 0); } }
}
template <class Epi, class Sched, bool PRE = false>
__device__ __forceinline__ void gemm_phase(LAS unsigned char* lds, int lda, int ldb, const Sched& S, const Epi& E) {
    const int tid = threadIdx.x, wid = __builtin_amdgcn_readfirstlane(tid >> 6), lane = tid & 63, wr = wid >> 2, wc = wid & 3, fr = lane & 15, fq = lane >> 4;
    unsigned voffA[2], voffB[2];
#pragma unroll
    for (int i = 0; i < 2; ++i) { int R, C; stage_rc(tid * 16 + i * 8192, R, C); const int Rb = Epi::PERM ? ((R & ~31) + perm32(R & 31)) : R;
        voffA[i] = (unsigned)(R * lda + C) * 2u; voffB[i] = (unsigned)(Rb * ldb + C) * 2u; }
    const size_t kstep = (size_t)(BK * 2);
    const size_t hstepA = (size_t)HALF * lda * 2, hstepB = (size_t)HALF * ldb * 2;
    const unsigned ldsw = (unsigned)wid * 1024u;
    const int aoff = lds_byte(wr * 64 + fr, fq * 8), boff = lds_byte(wc * 32 + fr, fq * 8);
#define PG8_SA(b, h) (((b) * 2 + (h)) * HTB)
#define PG8_SB(b, h) ((4 + (b) * 2 + (h)) * HTB)
#define PG8_STAGE(bufoff, gbase, voff) do { _Pragma("unroll") for (int _i = 0; _i < 2; ++_i) \
        __builtin_amdgcn_global_load_lds((const unsigned*)((const char*)(gbase) + (voff)[_i]), (LAS unsigned*)(lds + (bufoff) + ldsw + _i * 8192), 16, 0, 0); } while (0)
#define PG8_LDA(dst, b, h) do { _Pragma("unroll") for (int m = 0; m < 4; ++m) _Pragma("unroll") for (int k = 0; k < 2; ++k) dst[m][k] = *(const LAS bf16x8*)(lds + PG8_SA(b, h) + aoff + m * 2048 + k * 1024); } while (0)
#define PG8_LDB(dst, b, h) do { _Pragma("unroll") for (int n = 0; n < 2; ++n) _Pragma("unroll") for (int k = 0; k < 2; ++k) dst[n][k] = *(const LAS bf16x8*)(lds + PG8_SB(b, h) + boff + n * 2048 + k * 1024); } while (0)
#define PG8_MMA(ai, bj, At, Bt) do { __builtin_amdgcn_s_setprio(1); _Pragma("unroll") for (int m = 0; m < 4; ++m) _Pragma("unroll") for (int n = 0; n < 2; ++n) _Pragma("unroll") for (int k = 0; k < 2; ++k) \
        acc[ai][bj][m][n] = __builtin_amdgcn_mfma_f32_16x16x32_bf16(Bt[n][k], At[m][k], acc[ai][bj][m][n], 0, 0, 0); __builtin_amdgcn_s_setprio(0); } while (0)
#define PG8_WAIT_V(n) asm volatile("s_waitcnt vmcnt(" #n ")" ::: "memory")
#define PG8_WAIT_L(n) asm volatile("s_waitcnt lgkmcnt(" #n ")" ::: "memory")
#define PG8_BAR __builtin_amdgcn_s_barrier()
#define PG8_SCHED __builtin_amdgcn_sched_barrier(0)
    Unit cur, nxt; int ui = 0;
    if (!S.next(0, cur)) return;
    f32x4 acc[2][2][4][2];
#pragma unroll
    for (int a = 0; a < 2; ++a)
#pragma unroll
        for (int b = 0; b < 2; ++b)
#pragma unroll
            for (int m = 0; m < 4; ++m)
#pragma unroll
                for (int n = 0; n < 2; ++n) acc[a][b][m][n] = (f32x4){0.f, 0.f, 0.f, 0.f};
    bf16x8 At[4][2], B0[2][2], B1[2][2];
    const char* cA = cur.A; const char* cB = cur.B; int nt = cur.nt;
    if constexpr (PRE) {
        PG8_STAGE(PG8_SA(0, 0), cA, voffA); PG8_STAGE(PG8_SA(0, 1), cA + hstepA, voffA);
        if (wr == 1) PG8_BAR;
        PG8_WAIT_V(2); PG8_BAR;
        PG8_STAGE(PG8_SA(1, 0), cA + kstep, voffA);
        PG8_WAIT_V(2); PG8_BAR;
    } else {
    PG8_STAGE(PG8_SB(0, 0), cB, voffB); PG8_STAGE(PG8_SB(0, 1), cB + hstepB, voffB); PG8_STAGE(PG8_SA(0, 0), cA, voffA); PG8_STAGE(PG8_SA(0, 1), cA + hstepA, voffA);
    if (wr == 1) PG8_BAR;
    PG8_WAIT_V(2); PG8_BAR;
    PG8_STAGE(PG8_SB(1, 0), cB + kstep, voffB); PG8_STAGE(PG8_SA(1, 0), cA + kstep, voffA); PG8_STAGE(PG8_SB(1, 1), cB + hstepB + kstep, voffB);
    PG8_WAIT_V(6); PG8_BAR;
    }
    for (;;) {
        const bool has_next = S.next(ui + 1, nxt);
        const char* nA = has_next ? nxt.A : cA; const char* nB = has_next ? nxt.B : cB;
        for (int t = 0; t < nt; t += 2) {
            const bool last = (t == nt - 2);
            const char* a1 = cA + (size_t)(t + 1) * kstep;
            const char* a2 = last ? nA : cA + (size_t)(t + 2) * kstep; const char* b2 = last ? nB : cB + (size_t)(t + 2) * kstep;
            const char* a3 = a2 + kstep; const char* b3 = b2 + kstep;
            PG8_LDB(B0, 0, 0); PG8_LDB(B1, 0, 1); PG8_SCHED; PG8_LDA(At, 0, 0); PG8_STAGE(PG8_SA(1, 1), a1 + hstepA, voffA);
            PG8_WAIT_V(8); PG8_WAIT_L(0); PG8_BAR; PG8_MMA(0, 0, At, B0); PG8_MMA(0, 1, At, B1); PG8_BAR; PG8_SCHED;
            PG8_LDA(At, 0, 1); PG8_STAGE(PG8_SB(0, 0), b2, voffB); PG8_STAGE(PG8_SB(0, 1), b2 + hstepB, voffB); PG8_STAGE(PG8_SA(0, 0), a2, voffA);
            PG8_WAIT_V(8); PG8_WAIT_L(0); PG8_BAR; PG8_MMA(1, 0, At, B0); PG8_MMA(1, 1, At, B1); PG8_BAR; PG8_SCHED;
            PG8_LDB(B0, 1, 0); PG8_LDB(B1, 1, 1); PG8_SCHED; PG8_LDA(At, 1, 0); PG8_STAGE(PG8_SA(0, 1), a2 + hstepA, voffA);
            PG8_WAIT_V(8); PG8_WAIT_L(0); PG8_BAR; PG8_MMA(0, 0, At, B0); PG8_MMA(0, 1, At, B1); PG8_BAR; PG8_SCHED;
            PG8_LDA(At, 1, 1); PG8_STAGE(PG8_SB(1, 0), b3, voffB); PG8_STAGE(PG8_SB(1, 1), b3 + hstepB, voffB); PG8_STAGE(PG8_SA(1, 0), a3, voffA);
            PG8_WAIT_V(8); PG8_WAIT_L(0); PG8_BAR; PG8_MMA(1, 0, At, B0); PG8_MMA(1, 1, At, B1); PG8_BAR; PG8_SCHED;
        }
        if (wr == 0) PG8_BAR;
        E(acc, cur, wr, wc, fr, fq);
        if (!has_next) break;
#pragma unroll
        for (int a = 0; a < 2; ++a)
#pragma unroll
            for (int b = 0; b < 2; ++b)
#pragma unroll
                for (int m = 0; m < 4; ++m)
#pragma unroll
                    for (int n = 0; n < 2; ++n) acc[a][b][m][n] = (f32x4){0.f, 0.f, 0.f, 0.f};
        cur = nxt; cA = nA; cB = nB; nt = cur.nt; ++ui;
        if (wr == 1) PG8_BAR;
    }
    PG8_WAIT_V(0);
    PG8_BAR;
#undef PG8_SA
#undef PG8_SB
#undef PG8_STAGE
#undef PG8_LDA
#undef PG8_LDB
#undef PG8_MMA
#undef PG8_WAIT_V
#undef PG8_WAIT_L
#undef PG8_BAR
#undef PG8_SCHED
}
}

__device__ __forceinline__ void xcd_barrier_pre(const XcdBarrier& b, LAS unsigned char* lds, const char* B, int ldb) {
    asm volatile("s_waitcnt vmcnt(0)" ::: "memory");
    __syncthreads();
    pg8::prestage_B<true>(lds, B, ldb);
    if (threadIdx.x == 0) {
        unsigned* bar = b.bar;
        __builtin_amdgcn_s_waitcnt(0);
        unsigned nloc = b.st[0], nx = b.st[1];
        if (nloc == 0u) { xcd_barrier_complete(bar, b.x, nloc, nx); b.st[0] = nloc; b.st[1] = nx; }
        const unsigned old = xb_add(&bar[XB_XSUB(b.x)], 1u);
        asm volatile("buffer_inv sc1" ::: "memory");
        const unsigned gen = old / nloc;
        if (old + 1u == (gen + 1u) * nloc) {
            __builtin_amdgcn_fence(__ATOMIC_RELEASE, "agent");
            asm volatile("s_waitcnt vmcnt(0)" ::: "memory");
            const unsigned og = xb_add(&bar[XB_TOP], 1u);
            const unsigned tg = og / nx;
            if (og + 1u == (tg + 1u) * nx) xb_add(&bar[XB_TOPGEN], 1u);
            else XB_SPIN(xb_ld(&bar[XB_TOPGEN]) == tg, bar);
            xb_add(&bar[XB_XGEN(b.x)], 1u);
            asm volatile("s_waitcnt vmcnt(0)" ::: "memory");
        } else {
            XB_SPIN(xb_ld(&bar[XB_XGEN(b.x)]) == gen, bar);
            asm volatile("s_waitcnt vmcnt(0)" ::: "memory");
        }
    }
    __syncthreads();
}
struct Args { const float* in[N_IN]; float* out; unsigned char* ws; int ph_lo, ph_hi; };
constexpr int PTR_OFF = MISC_OFF + 256;
struct Frame {
    float* out; unsigned char* ws; LAS unsigned char* lds;
    int tid, lane, wave, G, wg;
    __device__ __forceinline__ const float* inp(int i) const {
        const unsigned long long v = ((const LAS unsigned long long*)(lds + PTR_OFF))[i];
        const unsigned lo = __builtin_amdgcn_readfirstlane((unsigned)v), hi = __builtin_amdgcn_readfirstlane((unsigned)(v >> 32));
        return (const float*)(const __attribute__((address_space(1))) float*)(((unsigned long long)hi << 32) | lo); }
    __device__ __forceinline__ float* mod_() const { return (float*)(ws + WS_MOD); }
    __device__ __forceinline__ bf16_t* X_() const { return (bf16_t*)(ws + WS_X); }
    __device__ __forceinline__ bf16_t* H_() const { return (bf16_t*)(ws + WS_H); }
    __device__ __forceinline__ unsigned char* slab_() const { return ws + WS_SLAB; }
    __device__ __forceinline__ unsigned char* big_() const { return ws + WS_BIG; }
    __device__ __forceinline__ unsigned char* tab_() const { return ws + WS_TAB; }
    __device__ __forceinline__ unsigned char* wt_() const { return ws + WS_WT; }
};

typedef short bf16x8_t __attribute__((ext_vector_type(8)));
typedef short bf16x4_t __attribute__((ext_vector_type(4)));
__device__ __forceinline__ bf16x8_t frag_nat(const LAS bf16_t* base, int pitch, int row, int k0, int g) { return *(const LAS bf16x8_t*)(base + row * pitch + k0 + 8 * g); }
__device__ __forceinline__ bf16x8_t frag_perm(const LAS bf16_t* base, int pitch, int row, int kb, int g) {
    const bf16x4_t lo = *(const LAS bf16x4_t*)(base + row * pitch + kb + 4 * g), hi = *(const LAS bf16x4_t*)(base + row * pitch + kb + 16 + 4 * g);
    return __builtin_shufflevector(lo, hi, 0, 1, 2, 3, 4, 5, 6, 7);
}
__device__ __forceinline__ int rowp(int t, int r) { return 32 * (t >> 1) + 8 * (r >> 2) + 4 * (t & 1) + (r & 3); }
__device__ __forceinline__ bf16x8_t frag_sw(const LAS bf16_t* base, int pitch, int row, int kc, int g) { return *(const LAS bf16x8_t*)(base + row * pitch + (((kc + g) ^ (((row >> 4) & 1) << 2)) << 3)); }
__device__ __forceinline__ bf16x8_t pack_acc(const f32x4& a, const f32x4& b) {
    typedef unsigned u32x4_t __attribute__((ext_vector_type(4)));
    u32x4_t w; w.x = cvtpk(a[0], a[1]); w.y = cvtpk(a[2], a[3]); w.z = cvtpk(b[0], b[1]); w.w = cvtpk(b[2], b[3]);
    return __builtin_bit_cast(bf16x8_t, w);
}
#define MFMA16(a, b, c) __builtin_amdgcn_mfma_f32_16x16x32_bf16((a), (b), (c), 0, 0, 0)
__device__ __forceinline__ f32x4 up4(const u2v& u) { return (f32x4){__builtin_bit_cast(float, u.x << 16), __builtin_bit_cast(float, u.x & 0xffff0000u), __builtin_bit_cast(float, u.y << 16), __builtin_bit_cast(float, u.y & 0xffff0000u)}; }
__device__ __forceinline__ u2v pk4(const f32x4& v) { u2v o; o.x = cvtpk(v[0], v[1]); o.y = cvtpk(v[2], v[3]); return o; }

__device__ __forceinline__ const bf16_t* slab_ptr(Frame& F, int s) {
    return s < 2 ? (const bf16_t*)(F.slab_() + (size_t)s * SLAB_FULL) : (const bf16_t*)(F.slab_() + 2 * SLAB_FULL + (size_t)(s - 2) * SLAB_SMP) - (size_t)MCTX * D;
}
__device__ __forceinline__ void st4_wt(void* p, unsigned v) { asm volatile("global_store_dword %0, %1, off sc1" :: "v"((GAS void*)p), "v"(v) : "memory"); }
__device__ __forceinline__ void st16f_wt(void* p, const f32x4& v) { asm volatile("global_store_dwordx4 %0, %1, off sc1\n\ts_nop 1" :: "v"((GAS void*)p), "v"(v) : "memory"); }
__device__ __forceinline__ void st8_wt(void* p, const u2v& v) { asm volatile("global_store_dwordx2 %0, %1, off sc1" :: "v"((GAS void*)p), "v"(v) : "memory"); }
__device__ __forceinline__ void st16_wt(void* p, const u4v& v) { asm volatile("global_store_dwordx4 %0, %1, off sc1\n\ts_nop 1" :: "v"((GAS void*)p), "v"(v) : "memory"); }
__device__ __forceinline__ void p0_transpose_item(const float* W, int K, int N, bf16_t* WT, LAS float* scr, int item, int lane, bool up_il = false) {
    const int nblk = N / 32, kb = item / nblk, nb = item % nblk, k0 = 64 * kb, n0 = 32 * nb;
#pragma unroll
    for (int i = 0; i < 32; ++i) { const int kk = 2 * i + (lane >> 5); scr[kk * 33 + (lane & 31)] = W[(size_t)(k0 + kk) * N + n0 + (lane & 31)]; }
    asm volatile("s_waitcnt lgkmcnt(0)" ::: "memory");
    const int c = lane & 7;
#pragma unroll
    for (int j = 0; j < 4; ++j) { const int n = (lane >> 3) + 8 * j; const LAS float* s = scr + (8 * c) * 33 + n;
        u4v o; o.x = pk2(s[0 * 33], s[1 * 33]); o.y = pk2(s[2 * 33], s[3 * 33]); o.z = pk2(s[4 * 33], s[5 * 33]); o.w = pk2(s[6 * 33], s[7 * 33]);
        int orow = n0 + n; if (up_il) { const int gte = orow >= DFF ? 1 : 0, ch = orow - gte * DFF; orow = (ch >> 7) * 256 + gte * 128 + (ch & 127); }
        *(u4v*)(WT + (size_t)orow * K + k0 + 8 * c) = o; }
    asm volatile("s_waitcnt lgkmcnt(0)" ::: "memory");
}
__device__ __forceinline__ void ph_prologue(Frame& F) {
    const int lane = F.lane;
    const float* c_smp = F.inp(I_C); const float* c_ctx = F.inp(I_CCTX);
    for (int task = F.wg; task < 4 * 48; task += F.G) {
        const int l = task / 48, cc = task % 48, col = cc * 128 + lane * 2;
        const float* W = F.inp(I_WADA) + (size_t)l * D * 6144 + col;
        float acc[3][2] = {};
#pragma unroll 16
        for (int k = F.wave * 128; k < F.wave * 128 + 128; ++k) {
            const f32x2 w = *(const f32x2*)(W + (size_t)k * 6144);
            const float s0 = silu_f(c_ctx[k]), s1 = silu_f(c_smp[k]), s2 = silu_f(c_smp[D + k]);
            acc[0][0] += s0 * w[0]; acc[0][1] += s0 * w[1]; acc[1][0] += s1 * w[0]; acc[1][1] += s1 * w[1]; acc[2][0] += s2 * w[0]; acc[2][1] += s2 * w[1];
        }
        LAS float* red = (LAS float*)(F.lds + 8 * 8448);
        __syncthreads();
#pragma unroll
        for (int c = 0; c < 3; ++c) { red[(F.wave * 3 + c) * 128 + lane * 2] = acc[c][0]; red[(F.wave * 3 + c) * 128 + lane * 2 + 1] = acc[c][1]; }
        __syncthreads();
        if (F.tid < 384) { const int c = F.tid >> 7, j = F.tid & 127; float v = F.inp(I_BADA)[l * 6144 + cc * 128 + j];
#pragma unroll
            for (int w = 0; w < 8; ++w) v += red[(w * 3 + c) * 128 + j];
            F.mod_()[((size_t)l * 3 + c) * 6144 + cc * 128 + j] = v; }
    }
    {
        LAS float* scr = (LAS float*)(F.lds + F.wave * 8448);
        const int gw = F.wg * NWAVES + F.wave, NGW = F.G * NWAVES;
        constexpr int I_UP = 16 * 176, I_DNW = 44 * 32, I_FWT = 16 * 32, I_DIN = 16 * 129, I_MIN = 16 * 97;
        constexpr int NITEMS = 4 * I_UP + 4 * I_DNW + 2 * I_FWT + I_DIN + I_FWT + I_MIN + I_FWT;
        for (int it = gw; it < NITEMS; it += NGW) {
            int r = it;
            if (r < 4 * I_UP) { const int l = r / I_UP; p0_transpose_item(F.inp(I_WUP) + (size_t)l * D * NUP, D, NUP, (bf16_t*)(F.wt_() + WT_UP) + (size_t)l * NUP * D, scr, r % I_UP, lane, true); continue; } r -= 4 * I_UP;
            if (r < 4 * I_DNW) { const int l = r / I_DNW; p0_transpose_item(F.inp(I_WDN) + (size_t)l * DFF * D, DFF, D, (bf16_t*)(F.wt_() + WT_DN) + (size_t)l * D * DFF, scr, r % I_DNW, lane); continue; } r -= 4 * I_DNW;
            if (r < 2 * I_FWT) { const int j = r / I_FWT; p0_transpose_item(F.inp(I_FW) + (size_t)j * D * D, D, D, (bf16_t*)(F.wt_() + WT_F) + (size_t)j * D * D, scr, r % I_FWT, lane); continue; } r -= 2 * I_FWT;
            if (r < I_DIN) { p0_transpose_item(F.inp(I_DWIN), D, DN_PROJ, (bf16_t*)(F.wt_() + WT_DIN), scr, r, lane); continue; } r -= I_DIN;
            if (r < I_FWT) { p0_transpose_item(F.inp(I_DWOUT), D, D, (bf16_t*)(F.wt_() + WT_DOUT), scr, r, lane); continue; } r -= I_FWT;
            if (r < I_MIN) { p0_transpose_item(F.inp(I_MWIN), D, ML_PROJ, (bf16_t*)(F.wt_() + WT_MIN), scr, r, lane); continue; } r -= I_MIN;
            p0_transpose_item(F.inp(I_MWOUT), D, D, (bf16_t*)(F.wt_() + WT_MOUT), scr, r, lane);
        }
    }
    const int gt = F.wg * NTHR + F.tid, NGT = F.G * NTHR;
    bf16_t* cs256 = (bf16_t*)(F.tab_() + TAB_CS256); bf16_t* cst256 = (bf16_t*)(F.tab_() + TAB_CST256); bf16_t* cst1024 = (bf16_t*)(F.tab_() + TAB_CST1024);
    for (int i = gt; i < 256 * 256; i += NGT) { const int a = i >> 8, b = i & 255; const int m = (a * b) & 255; float s, c; sincospif(2.0f * (float)m / 256.0f, &s, &c);
        cs256[a * 256 + b] = (bf16_t)f2bf(c); cs256[(256 + a) * 256 + b] = (bf16_t)f2bf(s); cst256[a * 512 + b] = (bf16_t)f2bf(c); cst256[a * 512 + 256 + b] = (bf16_t)f2bf(-s); }
    for (int i = gt; i < 1024 * 1024; i += NGT) { const int a = i >> 10, b = i & 1023; const int m = (a * b) & 1023; float s, c; sincospif(2.0f * (float)m / 1024.0f, &s, &c);
        cst1024[a * 2048 + b] = (bf16_t)f2bf(c); cst1024[a * 2048 + 1024 + b] = (bf16_t)f2bf(-s); }
}
struct SchedWcs { int G, c, nun; const char* WT; const char* CS; char* O;
    __device__ __forceinline__ bool next(int i, pg8::Unit& u) const { const int L = i * G + c; if (L >= nun) return false;
        const int j = L >> 5, cs = (L >> 4) & 1, pm = (L >> 2) & 3, g = L & 3;
        u.A = WT + (size_t)j * D * D * 2 + ((size_t)pm * 256 * D + g * 256) * 2; u.B = CS + (size_t)cs * 256 * 256 * 2;
        u.out = O + (size_t)j * 2048 * D * 2 + ((size_t)(cs * 1024 + pm * 256) * D + g * 256) * 2; u.nt = 4; u.ldc = D; u.flag = 0; u.row0 = 0; return true; } };
__device__ __forceinline__ void ph_wcs(Frame& F) {
    int nun = 64; asm volatile("" : "+s"(nun));
    SchedWcs S{F.G, F.wg, nun, (const char*)(F.wt_() + WT_F), (const char*)(F.tab_() + TAB_CS256), (char*)(F.wt_() + WT_CS)};
    pg8::EpiBf16 E{nullptr};
    pg8::gemm_phase(F.lds, D, 256, S, E);
}

__device__ __forceinline__ void ph_norm(Frame& F, int pl, int pgj, const float* pbias, int nsc, int nss, float sc_ctx, float sc_smp, int nl, int nsh, const float* nw, bool first = false, int wg0 = 0) {
    const int gw = F.wg >= wg0 ? (F.wg - wg0) * NWAVES + F.wave : MTOT, NGW = (F.G - wg0) * NWAVES, lane = F.lane;
    const float* xin_p = F.inp(I_XP); const float* xin_s = F.inp(I_XS);
    const bf16_t* s0 = slab_ptr(F, 0); const bf16_t* s1 = slab_ptr(F, 1); const bf16_t* s2 = slab_ptr(F, 2); const bf16_t* s3 = slab_ptr(F, 3);
    auto ld4 = [](const bf16_t* p) { const u2v u = *(const u2v*)p; return (f32x4){__builtin_bit_cast(float, u.x << 16), __builtin_bit_cast(float, u.x & 0xffff0000u), __builtin_bit_cast(float, u.y << 16), __builtin_bit_cast(float, u.y & 0xffff0000u)}; };
    constexpr int RU = 3;
    for (int rb = gw; rb < MTOT; rb += RU * NGW) {
        f32x4 v[RU][4], sl[RU][4];
#pragma unroll
        for (int q = 0; q < RU; ++q) { const int row = rb + q * NGW; const bool ok = row < MTOT; const int ns = row < MCTX ? nsc : nss;
#pragma unroll
            for (int j = 0; j < 4; ++j) { const size_t o = (size_t)(ok ? row : 0) * D + 4 * lane + 256 * j;
                v[q][j] = first ? ((ok ? row : 0) < MCTX ? *(const f32x4*)(xin_p + o) : *(const f32x4*)(xin_s + o - (size_t)MCTX * D)) : ld4(F.X_() + o);
                if (pl >= 0) { f32x4 s = ld4(s0 + o);
                    if (ns > 1) s = s + ld4(s1 + o);
                    if (ns > 2) s = s + ld4(s2 + o) + ld4(s3 + o);
                    sl[q][j] = s; } } }
#pragma unroll
        for (int q = 0; q < RU; ++q) { const int row = rb + q * NGW; if (row >= MTOT) continue;
            const int cond = row_cond(row); const float scl = row < MCTX ? sc_ctx : sc_smp;
            float ss = 0.f;
#pragma unroll
            for (int j = 0; j < 4; ++j) { const int col = 4 * lane + 256 * j; const size_t o = (size_t)row * D + col;
                f32x4 x = v[q][j];
                if (pl >= 0) {
                    const f32x4 g = *(const f32x4*)(F.mod_() + ((size_t)pl * 3 + cond) * 6144 + pgj * D + col);
                    f32x4 s = sl[q][j] * scl;
                    if (pbias) s = s + *(const f32x4*)(pbias + col);
                    x = x + g * s;
                    st8_wt(F.X_() + o, pk4(x));
                }
                if (first) st8_wt(F.X_() + o, pk4(x));
                v[q][j] = x; ss += (x[0] * x[0] + x[1] * x[1]) + (x[2] * x[2] + x[3] * x[3]); }
            const float rstd = rsqrtf(wave_sum(ss) * (1.f / D) + EPS);
#pragma unroll
            for (int j = 0; j < 4; ++j) { const int col = 4 * lane + 256 * j;
                const f32x4 w = *(const f32x4*)(nw + col);
                f32x4 y = v[q][j] * rstd * w;
                if (nl >= 0) {
                    const float* m = F.mod_() + ((size_t)nl * 3 + cond) * 6144 + nsh * D + col;
                    const f32x4 sh = *(const f32x4*)m, sc = *(const f32x4*)(m + D);
                    y = y * (sc + 1.f) + sh;
                    u2v o; o.x = cvtpk(y[0], y[1]); o.y = cvtpk(y[2], y[3]);
                    st8_wt(F.H_() + (size_t)row * D + col, o);
                } else st16f_wt(F.out + O_Y + (size_t)row * D + col, y);
            }
        }
    }
}

__device__ __forceinline__ pg8::SchedPlain mk_plain(Frame& F, const void* A, int lda, const void* Bt, int ldb, int nN, int ns, int nt, void* O, int ldc, int osz, size_t osplit, int gate_pn) {
    pg8::SchedPlain S; S.G = F.G; S.c = F.wg; S.nM = 24; S.nN = nN; S.ns = ns; S.lda = lda; S.ldb = ldb; S.ldc = ldc; S.nt = nt; S.osz = osz; S.gate_pn = gate_pn;
    S.A = (const char*)A; S.B = (const char*)Bt; S.O = (char*)O; S.osplit = osplit; S.lim = 1 << 30; return S;
}
__device__ __forceinline__ void gemm64(Frame& F, const bf16_t* A, int lda, const bf16_t* Bt, int ldb, bf16_t* C, int ldc) {
    LAS bf16_t* LA = (LAS bf16_t*)F.lds; LAS bf16_t* LB = LA + 64 * 264;
    const int tid = F.tid, lane = F.lane, w = F.wave, r = lane & 15, g = lane >> 4, wr = w >> 1, wc = w & 1;
    u4v ra[4][4], rb[4][4];
#pragma unroll
    for (int kc = 0; kc < 4; ++kc)
#pragma unroll
        for (int i = 0; i < 4; ++i) { const int idx = tid + 512 * i, row = idx >> 5, pc = idx & 31;
            ra[kc][i] = *(const u4v*)(A + (size_t)row * lda + kc * 256 + pc * 8); rb[kc][i] = *(const u4v*)(Bt + (size_t)row * ldb + kc * 256 + pc * 8); }
    f32x4 acc0 = (f32x4){0.f, 0.f, 0.f, 0.f}, acc1 = (f32x4){0.f, 0.f, 0.f, 0.f};
#pragma unroll
    for (int kc = 0; kc < 4; ++kc) {
        __syncthreads();
#pragma unroll
        for (int i = 0; i < 4; ++i) { const int idx = tid + 512 * i, row = idx >> 5, pc = idx & 31; *(LAS u4v*)(LA + row * 264 + pc * 8) = ra[kc][i]; *(LAS u4v*)(LB + row * 264 + pc * 8) = rb[kc][i]; }
        __syncthreads();
#pragma unroll
        for (int kk = 0; kk < 8; ++kk) { const bf16x8_t a = frag_nat(LA, 264, 16 * wr + r, 32 * kk, g);
            acc0 = MFMA16(frag_nat(LB, 264, 32 * wc + r, 32 * kk, g), a, acc0); acc1 = MFMA16(frag_nat(LB, 264, 32 * wc + 16 + r, 32 * kk, g), a, acc1); }
    }
    bf16_t* cp = C + (size_t)(16 * wr + r) * ldc + 32 * wc + 4 * g;
    *(u2v*)cp = pk4(acc0); *(u2v*)(cp + 16) = pk4(acc1);
    __syncthreads();
}
constexpr int XR_OFF = MISC_OFF + 1024;
struct SchedUp { int G, c, lim; const char* A; const char* B; char* UGp; char* ACTp;
    __device__ __forceinline__ bool next(int i, pg8::Unit& u) const { const int L = i * G + c; if (L >= lim) return false; int pm, pn;
        if (L < 352) pg8::tile_order(L, 16, 22, pm, pn); else { pg8::tile_order(L - 352, 8, 22, pm, pn); pm += 16; }
        u.A = A + (size_t)pm * 256 * D * 2; u.B = B + (size_t)pn * 256 * D * 2; u.nt = 16; u.row0 = pm * 256;
        if (pm < 16) { u.flag = 2 + pn * 4; u.out = ACTp + ((size_t)pm * 256 * DFF + pn * 128) * 2; u.ldc = DFF; }
        else { u.flag = 0; u.out = UGp + ((size_t)pm * 256 * NUP + pn * 128) * 2; u.ldc = NUP; }
        return true; } };
__device__ __forceinline__ float dpp_ror1(float v) { return __builtin_bit_cast(float, __builtin_amdgcn_update_dpp(0, __builtin_bit_cast(int, v), 0x121, 0xF, 0xF, false)); }
__device__ __forceinline__ float dpp_ror15(float v) { return __builtin_bit_cast(float, __builtin_amdgcn_update_dpp(0, __builtin_bit_cast(int, v), 0x12F, 0xF, 0xF, false)); }
struct EpiUp {
    static constexpr bool PERM = true;
    const float* cw; const float* cb; LAS unsigned char* lds;
    __device__ __forceinline__ void operator()(f32x4 (&acc)[2][2][4][2], const pg8::Unit& u, int wr, int wc, int fr, int fq) const {
        char* outp = u.out; asm volatile("" : "+v"(outp)); int tl = threadIdx.x; asm volatile("" : "+v"(tl)); fr = tl & 15; fq = (tl >> 4) & 3;
        const int row0 = wr * 64 + fr, col0 = wc * 32 + 8 * fq;
        GAS bf16_t* O = (GAS bf16_t*)outp;
        if ((u.flag & 3) == 0) {
#pragma unroll
            for (int ai = 0; ai < 2; ++ai)
#pragma unroll
                for (int m = 0; m < 4; ++m) { GAS bf16_t* rowp = O + (size_t)(row0 + ai * 128 + m * 16) * u.ldc + col0;
#pragma unroll
                    for (int bj = 0; bj < 2; ++bj) { const f32x4 v0 = acc[ai][bj][m][0], v1 = acc[ai][bj][m][1];
                        pg8::u32x4 w; w.x = cvtpk(v0[0], v0[1]); w.y = cvtpk(v0[2], v0[3]); w.z = cvtpk(v1[0], v1[1]); w.w = cvtpk(v1[2], v1[3]);
                        pg8::st16_wt<0>((GAS pg8::u32x4*)(rowp + bj * DFF), w); } }
            return;
        }
        const int pn = u.flag >> 2, ch0 = pn * 128 + col0;
        LAS float* XR = (LAS float*)(lds + XR_OFF);
#pragma unroll
        for (int ai = 0; ai < 2; ++ai) {
            if (fr == 0) { LAS float* p = XR + (((wr * 4 + wc) * 2 + ai) * 2 + 0) * 32 + 8 * fq; *(LAS f32x4*)p = acc[ai][1][0][0]; *(LAS f32x4*)(p + 4) = acc[ai][1][0][1]; }
            if (fr == 15) { LAS float* p = XR + (((wr * 4 + wc) * 2 + ai) * 2 + 1) * 32 + 8 * fq; *(LAS f32x4*)p = acc[ai][1][3][0]; *(LAS f32x4*)(p + 4) = acc[ai][1][3][1]; } }
        asm volatile("s_waitcnt lgkmcnt(0)" ::: "memory"); __builtin_amdgcn_s_barrier(); asm volatile("" ::: "memory");
#pragma unroll
        for (int ai = 0; ai < 2; ++ai) {
            const int wrp = 1 - wr, aip = wr ? ai : ai - 1, ain = wr ? ai + 1 : ai;
            f32x4 bp[2], bn[2];
#pragma unroll
            for (int n = 0; n < 2; ++n) {
                bp[n] = aip >= 0 ? *(const LAS f32x4*)(XR + (((wrp * 4 + wc) * 2 + aip) * 2 + 1) * 32 + 8 * fq + 4 * n) : (f32x4){0.f, 0.f, 0.f, 0.f};
                bn[n] = ain <= 1 ? *(const LAS f32x4*)(XR + (((wrp * 4 + wc) * 2 + ain) * 2 + 0) * 32 + 8 * fq + 4 * n) : (f32x4){0.f, 0.f, 0.f, 0.f}; }
#pragma unroll
            for (int n = 0; n < 2; ++n) {
                const f32x4 w0 = *(const f32x4*)(cw + 3 * DFF + ch0 + 4 * n), w1 = *(const f32x4*)(cw + 4 * DFF + ch0 + 4 * n), w2 = *(const f32x4*)(cw + 5 * DFF + ch0 + 4 * n), bb = *(const f32x4*)(cb + ch0 + 4 * n);
#pragma unroll
                for (int j = 0; j < 4; ++j) {
                    float R[4], L[4];
#pragma unroll
                    for (int m = 0; m < 4; ++m) { R[m] = dpp_ror1(acc[ai][1][m][n][j]); L[m] = dpp_ror15(acc[ai][1][m][n][j]); }
#pragma unroll
                    for (int m = 0; m < 4; ++m) {
                        const float prev = fr == 0 ? (m == 0 ? bp[n][j] : R[m - 1]) : R[m];
                        const float next = fr == 15 ? (m == 3 ? bn[n][j] : L[m + 1]) : L[m];
                        const float cv = w0[j] * prev + w1[j] * acc[ai][1][m][n][j] + w2[j] * next + bb[j];
                        acc[ai][0][m][n][j] = silu_f(cv) * acc[ai][0][m][n][j]; }
                } }
#pragma unroll
            for (int m = 0; m < 4; ++m) { const f32x4 v0 = acc[ai][0][m][0], v1 = acc[ai][0][m][1];
                pg8::u32x4 w; w.x = cvtpk(v0[0], v0[1]); w.y = cvtpk(v0[2], v0[3]); w.z = cvtpk(v1[0], v1[1]); w.w = cvtpk(v1[2], v1[3]);
                pg8::st16_wt<0>((GAS pg8::u32x4*)(O + (size_t)(row0 + ai * 128 + m * 16) * u.ldc + col0), w); }
        }
    }
};
__device__ __forceinline__ void ph_ffn_up(Frame& F, int l) {
    SchedUp S{F.G, F.wg, 2 * F.G, (const char*)F.H_(), (const char*)(F.wt_() + WT_UP + (size_t)l * NUP * D * 2), (char*)(F.big_() + BIG_UG), (char*)(F.big_() + BIG_ACT)};
    EpiUp E{F.inp(I_CW) + (size_t)l * 9 * DFF, F.inp(I_CB) + (size_t)l * DFF, F.lds};
    for (int sk = 0; sk < (int)((blockIdx.x >> 3) & 7); ++sk) __builtin_amdgcn_s_sleep(36);
    pg8::gemm_phase<EpiUp, SchedUp, true>(F.lds, D, D, S, E);
    const int ntail = 24 * 22 - 2 * F.G;
    for (int st = F.wg; st < ntail * 16; st += F.G) { int pm, pn; pg8::tile_order(2 * F.G + (st >> 4) - 352, 8, 22, pm, pn); pm += 16;
        const int r0 = pm * 256 + ((st >> 2) & 3) * 64, sn = st & 3, c0 = (sn >> 1) * DFF + pn * 128 + (sn & 1) * 64;
        gemm64(F, F.H_() + (size_t)r0 * D, D, (const bf16_t*)(F.wt_() + WT_UP + (size_t)l * NUP * D * 2) + (size_t)(pn * 256 + sn * 64) * D, D, (bf16_t*)(F.big_() + BIG_UG) + (size_t)r0 * NUP + c0, NUP); }
}
__device__ __forceinline__ const char* firstB_up(Frame& F, int l) { SchedUp S{F.G, F.wg, 2 * F.G, (const char*)F.H_(), (const char*)(F.wt_() + WT_UP + (size_t)l * NUP * D * 2), (char*)(F.big_() + BIG_UG), (char*)(F.big_() + BIG_ACT)}; pg8::Unit u; return S.next(0, u) ? u.B : nullptr; }
__device__ __forceinline__ void unpack8(const u4v& u, float (&f)[8]) {
#pragma unroll
    for (int i = 0; i < 4; ++i) { f[2 * i] = __builtin_bit_cast(float, u[i] << 16); f[2 * i + 1] = __builtin_bit_cast(float, u[i] & 0xffff0000u); }
}
struct ConvItem { u2v raw[3][6]; u2v ua[4]; f32x4 w[9]; f32x4 bias; };
__device__ __forceinline__ void conv_load(ConvItem& I, const bf16_t* UG, const float* cw, const float* cb, int c4, int row0, int gr, int gc0) {
    const bf16_t* gb = UG + DFF + 4 * c4;
#pragma unroll
    for (int di = -1; di <= 1; ++di) { const bool rok = gr + di >= 0 && gr + di < 16;
#pragma unroll
        for (int j = 0; j < 6; ++j) { const int col = gc0 + j - 1; const bool ok = rok && col >= 0 && col < 64;
            u2v u = *(const u2v*)(gb + (size_t)(ok ? row0 + di * 64 + j - 1 : row0) * NUP); if (!ok) u = (u2v){0u, 0u};
            I.raw[di + 1][j] = u; } }
#pragma unroll
    for (int it = 0; it < 4; ++it) I.ua[it] = *(const u2v*)(UG + (size_t)(row0 + it) * NUP + 4 * c4);
#pragma unroll
    for (int t = 0; t < 9; ++t) I.w[t] = *(const f32x4*)(cw + t * DFF + 4 * c4);
    I.bias = *(const f32x4*)(cb + 4 * c4);
}
__device__ __forceinline__ f32x4 unpack4(const u2v& u) { return (f32x4){__builtin_bit_cast(float, u.x << 16), __builtin_bit_cast(float, u.x & 0xffff0000u), __builtin_bit_cast(float, u.y << 16), __builtin_bit_cast(float, u.y & 0xffff0000u)}; }
__device__ __forceinline__ void conv_compute(const ConvItem& I, bf16_t* ACT, int c4, int row0) {
    f32x4 acc[4];
#pragma unroll
    for (int it = 0; it < 4; ++it) acc[it] = I.bias;
#pragma unroll
    for (int di = 0; di < 3; ++di)
#pragma unroll
        for (int j = 0; j < 6; ++j) { const f32x4 f = unpack4(I.raw[di][j]);
#pragma unroll
            for (int dj = -1; dj <= 1; ++dj) { const int it = j - 1 - dj; if (it >= 0 && it < 4) acc[it] = acc[it] + f * I.w[di * 3 + dj + 1]; } }
#pragma unroll
    for (int it = 0; it < 4; ++it) { const f32x4 a = unpack4(I.ua[it]); u2v o;
        o.x = cvtpk(silu_f(acc[it][0]) * a[0], silu_f(acc[it][1]) * a[1]); o.y = cvtpk(silu_f(acc[it][2]) * a[2], silu_f(acc[it][3]) * a[3]);
        st8_wt(ACT + (size_t)(row0 + it) * DFF + 4 * c4, o); }
}
__device__ __forceinline__ void ph_ffn_conv(Frame& F, int l) {
    const bf16_t* UG = (const bf16_t*)(F.big_() + BIG_UG); bf16_t* ACT = (bf16_t*)(F.big_() + BIG_ACT);
    const float* cw = F.inp(I_CW) + (size_t)l * 9 * DFF; const float* cb = F.inp(I_CB) + (size_t)l * DFF;
    const int tw = (F.wg * 8) & 1023, gr = tw >> 6, gcw = tw & 63, rowW = MCTX + F.wg * 8;
    const int i1 = F.tid + 512, i2 = F.tid + 1024;
    const int c0 = F.tid, h1 = i1 >= 704 ? 1 : 0, c1 = i1 - h1 * 704, c2 = i2 - 704;
    const bool v2 = F.wave < 6;
    ConvItem A, B;
    conv_load(A, UG, cw, cb, c0, rowW, gr, gcw);
    conv_load(B, UG, cw, cb, c1, rowW + 4 * h1, gr, gcw + 4 * h1);
    conv_compute(A, ACT, c0, rowW);
    if (v2) conv_load(A, UG, cw, cb, c2, rowW + 4, gr, gcw + 4);
    conv_compute(B, ACT, c1, rowW + 4 * h1);
    if (v2) conv_compute(A, ACT, c2, rowW + 4);
}
__device__ __forceinline__ void ph_gemm_slab(Frame& F, const bf16_t* A, int K, const void* WT) {
    pg8::SchedPlain S = mk_plain(F, A, K, WT, K, 4, 2, K / 128, F.slab_(), D, 2, SLAB_FULL, -1);
    pg8::EpiBf16 E{nullptr};
    pg8::gemm_phase<pg8::EpiBf16, pg8::SchedPlain, true>(F.lds, K, K, S, E);
}
__device__ __forceinline__ const char* firstB_slab(Frame& F, const bf16_t* A, int K, const void* WT) { pg8::SchedPlain S = mk_plain(F, A, K, WT, K, 4, 2, K / 128, F.slab_(), D, 2, SLAB_FULL, -1); pg8::Unit u; return S.next(0, u) ? u.B : nullptr; }

struct SchedF1 { int G, c; const char* A; const char* B; char* ZC; char* ZS;
    __device__ __forceinline__ bool next(int i, pg8::Unit& u) const { int pm, pn; if (!pg8::tile_order(i * G + c, 8, 24, pm, pn)) return false;
        u.A = A + (size_t)pm * 256 * D * 2; u.B = B + (size_t)pn * 256 * D * 2; u.nt = 16; u.flag = 0; u.row0 = 0;
        if (pn < 16) { u.out = ZC + (size_t)pn * 1024 * 512 * 2 + ((size_t)(pm & 3) * 256 * 512 + (pm >> 2) * 256) * 2; u.ldc = 512; }
        else { const int sq = (pn - 16) >> 2, tq = (pn - 16) & 3; u.out = ZS + (size_t)sq * 1024 * 2048 * 2 + ((size_t)(pm & 3) * 256 * 2048 + (pm >> 2) * 1024 + tq * 256) * 2; u.ldc = 2048; }
        return true; } };
__device__ __forceinline__ void ph_f1(Frame& F, int j) {
    SchedF1 S{F.G, F.wg, (const char*)(F.wt_() + WT_CS + (size_t)j * 2048 * D * 2), (const char*)F.H_(), (char*)(F.big_() + BIG_ZTC), (char*)(F.big_() + BIG_ZTS)};
    pg8::EpiBf16 E{nullptr};
    pg8::gemm_phase(F.lds, D, D, S, E);
}
struct SchedF2C { int G, c; const char* A; const char* B; char* O;
    __device__ __forceinline__ bool next(int i, pg8::Unit& u) const { const int L = i * G + c; if (L >= 64) return false; const int seq = L >> 2, pn = L & 3;
        u.A = A; u.B = B + (size_t)seq * 1024 * 512 * 2 + (size_t)pn * 256 * 512 * 2; u.out = O + ((size_t)seq * 256 * D + pn * 256) * 2; u.nt = 8; u.ldc = D; u.flag = 0; u.row0 = 0; return true; } };
struct SchedF2S { int G, c; const char* A; const char* B; char* O0; char* O2;
    __device__ __forceinline__ bool next(int i, pg8::Unit& u) const { const int L = i * G + c - 64; if (L < 0 || L >= 128) return false;
        const int ks = L & 3, r = L >> 2, seq = r >> 4, pm = (r >> 2) & 3, pn = r & 3;
        u.A = A + ((size_t)pm * 256 * 2048 + ks * 512) * 2; u.B = B + (size_t)seq * 1024 * 2048 * 2 + ((size_t)pn * 256 * 2048 + ks * 512) * 2;
        char* ob = ks < 2 ? O0 + (size_t)ks * SLAB_FULL + (size_t)MCTX * D * 2 : O2 + (size_t)(ks - 2) * SLAB_SMP;
        u.out = ob + ((size_t)(seq * 1024 + pm * 256) * D + pn * 256) * 2; u.nt = 8; u.ldc = D; u.flag = 0; u.row0 = 0; return true; } };
__device__ __forceinline__ void ph_f2(Frame& F) {
    pg8::EpiBf16 E{nullptr};
    { SchedF2C S{F.G, F.wg, (const char*)(F.tab_() + TAB_CST256), (const char*)(F.big_() + BIG_ZTC), (char*)F.slab_()}; pg8::gemm_phase(F.lds, 512, 512, S, E); }
    { SchedF2S S{F.G, F.wg, (const char*)(F.tab_() + TAB_CST1024), (const char*)(F.big_() + BIG_ZTS), (char*)F.slab_(), (char*)(F.slab_() + 2 * SLAB_FULL)}; pg8::gemm_phase(F.lds, 2048, 2048, S, E); }
}

struct SchedCols { int G, c, np, first, gate_p; const char* A; const char* B; char* O; int ldc;
    __device__ __forceinline__ bool next(int i, pg8::Unit& u) const { int pm, pp; if (c < 0 || !pg8::tile_order(i * G + c, 24, np, pm, pp)) return false;
        const int pn = (pp == gate_p) ? 12 : first + pp;
        u.A = A + (size_t)pm * 256 * D * 2; u.B = B + (size_t)pn * 256 * D * 2; u.out = O + ((size_t)pm * 256 * ldc + (size_t)pn * 256) * 2; u.nt = 16; u.ldc = ldc; u.flag = (pp == gate_p) ? 1 : 0; u.row0 = pm * 256; return true; } };
__device__ __forceinline__ void ph_proj(Frame& F, const void* WT, int nfull) {
    pg8::EpiBf16 E{(float*)(F.big_() + BIG_GATES)};
    if (nfull == 16) {
        pg8::SchedPlain S = mk_plain(F, F.H_(), D, WT, D, nfull + 1, 1, 16, F.big_() + BIG_PROJ, nfull * 256, 2, 0, nfull);
        pg8::gemm_phase<pg8::EpiBf16, pg8::SchedPlain, true>(F.lds, D, D, S, E);
    } else {
        SchedCols S{F.G, F.wg, 9, 0, 8, (const char*)F.H_(), (const char*)WT, (char*)(F.big_() + BIG_PROJ), nfull * 256};
        pg8::gemm_phase<pg8::EpiBf16, SchedCols, true>(F.lds, D, D, S, E);
    }
}
__device__ __forceinline__ const char* firstB_proj(Frame& F, const void* WT, int nfull) { pg8::Unit u;
    if (nfull == 16) { pg8::SchedPlain S = mk_plain(F, F.H_(), D, WT, D, nfull + 1, 1, 16, F.big_() + BIG_PROJ, nfull * 256, 2, 0, nfull); return S.next(0, u) ? u.B : nullptr; }
    SchedCols S{F.G, F.wg, 9, 0, 8, (const char*)F.H_(), (const char*)WT, (char*)(F.big_() + BIG_PROJ), nfull * 256}; return S.next(0, u) ? u.B : nullptr; }
__device__ __forceinline__ void ph_ml_ogate(Frame& F) {
    __syncthreads();
    SchedCols S{96, F.wg >= 160 ? F.wg - 160 : -1, 4, 8, -1, (const char*)F.H_(), (const char*)(F.wt_() + WT_MIN), (char*)(F.big_() + BIG_PROJ), 3072};
    pg8::EpiBf16 E{nullptr};
    pg8::gemm_phase<pg8::EpiBf16, SchedCols, true>(F.lds, D, D, S, E);
}
__device__ __forceinline__ const char* firstB_og(Frame& F) { pg8::Unit u;
    SchedCols S{96, F.wg >= 160 ? F.wg - 160 : -1, 4, 8, -1, (const char*)F.H_(), (const char*)(F.wt_() + WT_MIN), (char*)(F.big_() + BIG_PROJ), 3072}; return S.next(0, u) ? u.B : nullptr; }
__device__ __forceinline__ void chunk_pos(int ck, int& seq, int& t0, int& T) { if (ck < 64) { seq = ck >> 2; t0 = (ck & 3) * 64; T = 256; } else { const int u = ck - 64; seq = 16 + (u >> 4); t0 = (u & 15) * 64; T = 1024; } }

constexpr int DP_LQ = 0, DP_LK = 17408, DP_LQK = 34816, DP_LKK = 52224, DP_LKT = 69632, DP_LVT = 88064, DP_SC = 106496, DP_T = DP_LQK;
constexpr int DS_VEC_F = 192;
__device__ __forceinline__ void ph_dn_prep2(Frame& F) {
    const bf16_t* P = (const bf16_t*)(F.big_() + BIG_PROJ); const float* GT = (const float*)(F.big_() + BIG_GATES);
    LAS bf16_t* LQ = (LAS bf16_t*)(F.lds + DP_LQ); LAS bf16_t* LK = (LAS bf16_t*)(F.lds + DP_LK); LAS float* LQK = (LAS float*)(F.lds + DP_LQK); LAS float* LKK = (LAS float*)(F.lds + DP_LKK);
    LAS bf16_t* LKT = (LAS bf16_t*)(F.lds + DP_LKT); LAS bf16_t* LVT = (LAS bf16_t*)(F.lds + DP_LVT); LAS float* SC = (LAS float*)(F.lds + DP_SC);
    const int tid = F.tid, lane = F.lane, w = F.wave, r = lane & 15, g = lane >> 4;
    const float* cw = F.inp(I_DCW);
    unsigned xr[12][3];
    auto load_xr = [&](int task_) { const int ck_ = task_ >> 3, h_ = task_ & 7; int seq_, t0_, T_; chunk_pos(ck_, seq_, t0_, T_);
        unsigned rowv = (unsigned)(seq_row0(seq_) + t0_ + 8 * w - 2); asm volatile("" : "+v"(rowv));
#pragma unroll
        for (int rr = 0; rr < 12; ++rr) { const int tp = t0_ + 8 * w - 2 + rr; const bool ok = tp >= 0 && tp < T_;
#pragma unroll
            for (int wh = 0; wh < 3; ++wh) { xr[rr][wh] = 0u; if (ok) xr[rr][wh] = *(const unsigned*)(P + ((rowv + rr) * 4096u + (unsigned)(wh * 1024 + h_ * 128 + 2 * lane))); } } };
    if (F.wg < 96 * 8) load_xr(F.wg);
    for (int task = F.wg; task < 96 * 8; task += F.G) {
        const int ck = task >> 3, h = task & 7; int seq, t0, T; chunk_pos(ck, seq, t0, T); const int row0 = seq_row0(seq) + t0;
        __syncthreads();
        {
            float cwr[3][5][2];
#pragma unroll
            for (int wh = 0; wh < 3; ++wh)
#pragma unroll
                for (int j = 0; j < 5; ++j) { const f32x2 c = *(const f32x2*)(cw + j * 3072 + wh * 1024 + h * 128 + 2 * lane); cwr[wh][j][0] = c[0]; cwr[wh][j][1] = c[1]; }
            bf16_t* QSg = (bf16_t*)(F.big_() + BIG_QS) + (size_t)task * 64 * 128;
#pragma unroll
            for (int tt = 0; tt < 8; ++tt) { const int tk = 8 * w + tt;
                float val[3][2];
#pragma unroll
                for (int wh = 0; wh < 3; ++wh) { float a0 = 0.f, a1 = 0.f;
#pragma unroll
                    for (int j = 0; j < 5; ++j) { const unsigned x = xr[tt + j][wh]; a0 += bf2f(x & 0xffffu) * cwr[wh][j][0]; a1 += bf2f(x >> 16) * cwr[wh][j][1]; }
                    val[wh][0] = silu_f(a0); val[wh][1] = silu_f(a1); }
                const float qs = rsqrtf(wave_sum(val[0][0] * val[0][0] + val[0][1] * val[0][1]) + EPS) * 0.08838834764831845f;
                const float ks = rsqrtf(wave_sum(val[1][0] * val[1][0] + val[1][1] * val[1][1]) + EPS);
                const unsigned qp = cvtpk(val[0][0] * qs, val[0][1] * qs), kp = cvtpk(val[1][0] * ks, val[1][1] * ks), vp = cvtpk(val[2][0], val[2][1]);
                *(LAS unsigned*)(LQ + tk * 136 + 2 * lane) = qp; *(LAS unsigned*)(LK + tk * 136 + 2 * lane) = kp;
                *(unsigned*)(QSg + tk * 128 + 2 * lane) = qp;
                LKT[(2 * lane) * 72 + tk] = (bf16_t)(kp & 0xffffu); LKT[(2 * lane + 1) * 72 + tk] = (bf16_t)(kp >> 16);
                LVT[(2 * lane) * 72 + tk] = (bf16_t)(vp & 0xffffu); LVT[(2 * lane + 1) * 72 + tk] = (bf16_t)(vp >> 16);
            }
        }
        if (task + F.G < 96 * 8) load_xr(task + F.G);
        float gl_dir = 0.f;
        if (w < 2) { const int dir = w, c = dir ? 63 - lane : lane;
            const float graw = GT[(size_t)(row0 + c) * 32 + dir * 16 + h], braw = GT[(size_t)(row0 + c) * 32 + dir * 16 + 8 + h];
            float gsum = -expf(F.inp(I_DALOG)[dir * 8 + h]) * softplus_f(graw + F.inp(I_DDT)[dir * 8 + h]);
#pragma unroll
            for (int o = 1; o < 64; o <<= 1) { const float t = __shfl_up(gsum, o); if (lane >= o) gsum += t; }
            SC[dir * 64 + c] = gsum; SC[128 + dir * 64 + c] = sigmoid_f(braw);
            gl_dir = __shfl(gsum, 63);
        }
        __syncthreads();
        {
            const LAS bf16_t* Asrc = w < 4 ? LK : LQ; LAS float* Dst = w < 4 ? LKK : LQK; const int mi = w & 3;
            f32x4 acc[4];
#pragma unroll
            for (int ni = 0; ni < 4; ++ni) acc[ni] = (f32x4){0.f, 0.f, 0.f, 0.f};
#pragma unroll
            for (int kk = 0; kk < 4; ++kk) { const bf16x8_t a = frag_nat(Asrc, 136, 16 * mi + r, 32 * kk, g);
#pragma unroll
                for (int ni = 0; ni < 4; ++ni) acc[ni] = MFMA16(a, frag_nat(LK, 136, 16 * ni + r, 32 * kk, g), acc[ni]); }
#pragma unroll
            for (int ni = 0; ni < 4; ++ni)
#pragma unroll
                for (int i = 0; i < 4; ++i) Dst[(16 * mi + 4 * g + i) * 68 + 16 * ni + r] = acc[ni][i];
        }
        __syncthreads();
        {
            const size_t cd0 = (size_t)task * 2;
            bf16_t* QKMg = (bf16_t*)(F.big_() + BIG_QKM) + cd0 * 64 * 64;
#pragma unroll
            for (int it = 0; it < 4; ++it) { const int idx = tid + 512 * it, c = idx >> 5, s = (idx & 31) * 2;
                const float gFc = SC[c], gBc = SC[64 + c], bFc = SC[128 + c], bBc = SC[192 + c];
                float qf[2], qb[2];
#pragma unroll
                for (int e = 0; e < 2; ++e) { const int ss = s + e; const float qk = LQK[c * 68 + ss], kk = LKK[c * 68 + ss];
                    const float dF = __expf(gFc - SC[ss]), dB = __expf(gBc - SC[64 + ss]);
                    qf[e] = ss <= c ? qk * dF : 0.f; qb[e] = ss >= c ? qk * dB : 0.f;
                    LKK[c * 68 + ss] = ss < c ? bFc * kk * dF : (ss > c ? bBc * kk * dB : 0.f); }
                *(unsigned*)(QKMg + c * 64 + s) = pk2(qf[0], qf[1]); *(unsigned*)(QKMg + 4096 + c * 64 + s) = pk2(qb[0], qb[1]); }
            bf16_t* KTg = (bf16_t*)(F.big_() + BIG_KTG) + (size_t)task * 128 * 64;
#pragma unroll
            for (int it = 0; it < 2; ++it) { const int idx = tid + 512 * it, d = idx >> 3, c8 = (idx & 7) * 8; *(u4v*)(KTg + d * 64 + c8) = *(const LAS u4v*)(LKT + d * 72 + c8); }
            if (tid < 128) { const int dir = tid >> 6, c = tid & 63; float* VEC = (float*)(F.big_() + BIG_VEC) + (cd0 + dir) * DS_VEC_F;
                const float gc = SC[dir * 64 + c], gl = SC[dir * 64 + (dir ? 0 : 63)];
                VEC[c] = __expf(gc); VEC[64 + c] = __expf(gl - gc); if (c == 0) VEC[128] = __expf(gl); }
        }
        __syncthreads();
#pragma unroll
        for (int it = 0; it < 8; ++it) { const int idx = tid + 512 * it, p = idx >> 6, pj = idx & 63; LQK[p * 68 + pj] = LKK[(63 - p) * 68 + 63 - pj]; }
        __syncthreads();
        {
            LAS float* TF0 = (LAS float*)(F.lds + DP_LQ); LAS float* XS = (LAS float*)(F.lds + DP_SC + 1024) + w * 272;
            unsigned lofs = 0u; asm volatile("" : "+v"(lofs));
            const LAS float* Lf = (const LAS float*)(F.lds + DP_LKK + lofs); const LAS float* Lb = (const LAS float*)(F.lds + DP_LQK + lofs);
            const int lr = lane & 15, lg = lane >> 4;
            { const int dir = w >> 2, bi = w & 3; const LAS float* Ls = (dir ? Lb : Lf) + (16 * bi) * 68 + 16 * bi; LAS float* Td = TF0 + dir * 64 * 68 + (16 * bi) * 68 + 16 * bi + lofs;
                float Tr[16];
#pragma unroll
                for (int p = 0; p < 16; ++p) { float a0 = (p == lr) ? 1.f : 0.f;
#pragma unroll
                    for (int pj = 0; pj < p; ++pj) a0 -= Ls[p * 68 + pj] * Tr[pj];
                    Tr[p] = a0; }
                if (lane < 16) {
#pragma unroll
                    for (int p = 0; p < 16; ++p) Td[p * 68 + lr] = Tr[p]; } }
            __syncthreads();
#define MM16(acc, Ap, pa, Bp, pb) do { _Pragma("unroll") for (int s_ = 0; s_ < 4; ++s_) acc = __builtin_amdgcn_mfma_f32_16x16x4f32((Ap)[lr * (pa) + 4 * s_ + lg], (Bp)[(4 * s_ + lg) * (pb) + lr], acc, 0, 0, 0); } while (0)
#pragma unroll
            for (int lev = 1; lev < 4; ++lev) {
                const int ntask = 2 * (4 - lev);
                if (w < ntask) { const int dir = w / (4 - lev), bi = lev + w % (4 - lev), bj = bi - lev;
                    const LAS float* Ls = dir ? Lb : Lf; LAS float* Tf = TF0 + dir * 64 * 68 + lofs;
                    f32x4 x = (f32x4){0.f, 0.f, 0.f, 0.f};
#pragma unroll
                    for (int d = 0; d < 3; ++d) if (d < lev) { const int bk = bj + d;
                        MM16(x, Ls + (16 * bi) * 68 + 16 * bk, 68, Tf + (16 * bk) * 68 + 16 * bj, 68); }
#pragma unroll
                    for (int rr = 0; rr < 4; ++rr) XS[(4 * lg + rr) * 17 + lr] = x[rr];
                    f32x4 t = (f32x4){0.f, 0.f, 0.f, 0.f};
                    MM16(t, Tf + (16 * bi) * 68 + 16 * bi, 68, XS, 17);
#pragma unroll
                    for (int rr = 0; rr < 4; ++rr) Tf[(16 * bi + 4 * lg + rr) * 68 + 16 * bj + lr] = -t[rr]; }
                __syncthreads();
            }
#undef MM16
            LAS bf16_t* Tb = (LAS bf16_t*)(F.lds + DP_T);
#pragma unroll
            for (int it = 0; it < 8; ++it) { const int idx = tid + 512 * it, dir = idx >> 11, p = (idx >> 5) & 63, pj = (idx & 31) * 2;
                const f32x2 tv = *(const LAS f32x2*)(TF0 + dir * 64 * 68 + p * 68 + pj);
                const int c = dir ? 63 - p : p, s0 = dir ? 63 - pj : pj, s1 = dir ? 62 - pj : pj + 1;
                const float t0 = (pj >> 4) <= (p >> 4) ? tv[0] : 0.f, t1 = ((pj + 1) >> 4) <= (p >> 4) ? tv[1] : 0.f;
                const float b0 = SC[128 + dir * 64 + s0], b1 = SC[128 + dir * 64 + s1], e0 = b0 * __expf(SC[dir * 64 + s0]), e1 = b1 * __expf(SC[dir * 64 + s1]);
                LAS bf16_t* T1 = Tb + dir * 2 * 4096; LAS bf16_t* T2 = T1 + 4096;
                T1[c * 64 + s0] = (bf16_t)f2bf(t0 * b0); T1[c * 64 + s1] = (bf16_t)f2bf(t1 * b1); T2[c * 64 + s0] = (bf16_t)f2bf(t0 * e0); T2[c * 64 + s1] = (bf16_t)f2bf(t1 * e1); }
        }
        __syncthreads();
#pragma unroll
        for (int dir = 0; dir < 2; ++dir) { const size_t cd = (size_t)task * 2 + dir;
            const LAS bf16_t* T1 = (const LAS bf16_t*)(F.lds + DP_T) + dir * 2 * 4096; const LAS bf16_t* T2 = T1 + 4096;
            bf16_t* Ug = (bf16_t*)(F.big_() + BIG_U) + cd * 8192 + (size_t)w * 1024; bf16_t* WNg = (bf16_t*)(F.big_() + BIG_WN) + cd * 8192;
#pragma unroll
            for (int m = 0; m < 4; ++m) { f32x4 au = (f32x4){0.f, 0.f, 0.f, 0.f}, aw = (f32x4){0.f, 0.f, 0.f, 0.f};
#pragma unroll
                for (int kk = 0; kk < 2; ++kk) {
                    au = MFMA16(frag_nat(T1, 64, rowp(m, r), 32 * kk, g), frag_nat(LVT, 72, 16 * w + r, 32 * kk, g), au);
                    aw = MFMA16(frag_nat(LKT, 72, 16 * w + r, 32 * kk, g), frag_nat(T2, 64, 16 * m + r, 32 * kk, g), aw); }
                *(u2v*)(Ug + m * 256 + lane * 4) = pk4(au);
                u2v o; o.x = pk2(-aw[0], -aw[1]); o.y = pk2(-aw[2], -aw[3]);
                *(u2v*)(WNg + (16 * m + r) * 128 + 16 * w + 4 * g) = o; }
        }
    }
}

constexpr int DS_LWN = 0, DS_LQS = 17408, DS_LQKM = 34816, DS_LKT = 44032, DS_LVEC = 62464;
__device__ __forceinline__ void dn_scan_seq(Frame& F, int seq, int h, int dir, int esl0, int nact) {
    LAS bf16_t* LWN = (LAS bf16_t*)(F.lds + DS_LWN); LAS bf16_t* LQS = (LAS bf16_t*)(F.lds + DS_LQS); LAS bf16_t* LQKM = (LAS bf16_t*)(F.lds + DS_LQKM); LAS bf16_t* LKT = (LAS bf16_t*)(F.lds + DS_LKT);
    LAS float* LVEC = (LAS float*)(F.lds + DS_LVEC);
    const int tid = F.tid, lane = F.lane, w = F.wave, r = lane & 15, g = lane >> 4, ws = esl0 + (w < nact ? w : 0); const bool act = w < nact;
    const int NC = seq < 16 ? 4 : 16, ck0 = seq < 16 ? seq * 4 : 64 + (seq - 16) * 16, rowS = seq_row0(seq);
    bf16_t* O = (bf16_t*)(F.slab_() + (dir ? SLAB_FULL : 0));
    f32x4 Sacc[8];
    if (seq >= 16) { const float* s0 = F.inp(I_SD) + ((size_t)((seq - 16) * 2 + dir) * 8 + h) * 16384 + 16 * ws + r;
#pragma unroll
        for (int j = 0; j < 8; ++j)
#pragma unroll
            for (int i = 0; i < 4; ++i) Sacc[j][i] = s0[(32 * (j >> 1) + 8 * g + 4 * (j & 1) + i) * 128]; }
    else {
#pragma unroll
        for (int j = 0; j < 8; ++j) Sacc[j] = (f32x4){0.f, 0.f, 0.f, 0.f}; }
    struct DStage { u4v wn[2], qs[2], qkm, kt[2]; f32x4 vec; u2v U[4]; };
    constexpr int PD = 1;
    DStage st[PD];
#define DS_LOAD(S, n) do { const int ckn = ck0 + (dir ? NC - 1 - (n) : (n)); const size_t tk = (size_t)ckn * 8 + h, cd = tk * 2 + dir; \
        const u4v* gWN = (const u4v*)((const bf16_t*)(F.big_() + BIG_WN) + cd * 8192); const u4v* gQS = (const u4v*)((const bf16_t*)(F.big_() + BIG_QS) + tk * 8192); \
        const u4v* gQKM = (const u4v*)((const bf16_t*)(F.big_() + BIG_QKM) + cd * 4096); const u4v* gKT = (const u4v*)((const bf16_t*)(F.big_() + BIG_KTG) + tk * 8192); \
        S.wn[0] = gWN[tid]; S.wn[1] = gWN[tid + 512]; S.qs[0] = gQS[tid]; S.qs[1] = gQS[tid + 512]; S.qkm = gQKM[tid]; S.kt[0] = gKT[tid]; S.kt[1] = gKT[tid + 512]; \
        S.vec = (f32x4){0.f, 0.f, 0.f, 0.f}; if (tid < 48) S.vec = *(const f32x4*)((const float*)(F.big_() + BIG_VEC) + cd * DS_VEC_F + tid * 4); \
        const bf16_t* gU = (const bf16_t*)(F.big_() + BIG_U) + cd * 8192 + (size_t)ws * 1024 + lane * 4; \
        _Pragma("unroll") for (int m = 0; m < 4; ++m) S.U[m] = *(const u2v*)(gU + m * 256); } while (0)
#pragma unroll
    for (int k = 0; k < PD; ++k) DS_LOAD(st[k], k);
    for (int n0 = 0; n0 < NC; n0 += PD) {
#pragma unroll
      for (int k = 0; k < PD; ++k) { const int n = n0 + k;
        __syncthreads();
#pragma unroll
        for (int i = 0; i < 2; ++i) { const int idx = tid + 512 * i;
            const int r16 = idx >> 4, c16 = (idx & 15) ^ (((r16 >> 4) & 1) << 2), r8 = idx >> 3, c8 = (idx & 7) ^ (((r8 >> 4) & 1) << 2);
            *(LAS u4v*)(LWN + r16 * 136 + c16 * 8) = st[k].wn[i]; *(LAS u4v*)(LQS + r16 * 136 + c16 * 8) = st[k].qs[i];
            *(LAS u4v*)(LKT + r8 * 72 + c8 * 8) = st[k].kt[i]; }
        { const int r8 = tid >> 3, c8 = (tid & 7) ^ (((r8 >> 4) & 1) << 2); *(LAS u4v*)(LQKM + r8 * 72 + c8 * 8) = st[k].qkm; }
        if (tid < 48) *(LAS f32x4*)(LVEC + tid * 4) = st[k].vec;
        f32x4 vn[4];
#pragma unroll
        for (int m = 0; m < 4; ++m) vn[m] = up4(st[k].U[m]);
        const int ckc = ck0 + (dir ? NC - 1 - n : n);
        __syncthreads();
        if (n + PD < NC) DS_LOAD(st[k], n + PD);
        if (act) {
        bf16x8_t Sb[4];
#pragma unroll
        for (int kk = 0; kk < 4; ++kk) Sb[kk] = pack_acc(Sacc[2 * kk], Sacc[2 * kk + 1]);
        f32x4 o[4];
#pragma unroll
        for (int m = 0; m < 4; ++m) { o[m] = (f32x4){0.f, 0.f, 0.f, 0.f};
#pragma unroll
            for (int kk = 0; kk < 4; ++kk) { vn[m] = MFMA16(frag_sw(LWN, 136, rowp(m, r), 4 * kk, g), Sb[kk], vn[m]); o[m] = MFMA16(frag_sw(LQS, 136, rowp(m, r), 4 * kk, g), Sb[kk], o[m]); }
            o[m] = o[m] * *(const LAS f32x4*)(LVEC + 32 * (m >> 1) + 8 * g + 4 * (m & 1)); }
        bf16x8_t vb[2], vs[2];
#pragma unroll
        for (int k2 = 0; k2 < 2; ++k2) { vb[k2] = pack_acc(vn[2 * k2], vn[2 * k2 + 1]);
            const f32x4 e0 = *(const LAS f32x4*)(LVEC + 64 + 32 * k2 + 8 * g), e1 = *(const LAS f32x4*)(LVEC + 64 + 32 * k2 + 8 * g + 4);
            vs[k2] = pack_acc(vn[2 * k2] * e0, vn[2 * k2 + 1] * e1); }
#pragma unroll
        for (int m = 0; m < 4; ++m) {
#pragma unroll
            for (int k2 = 0; k2 < 2; ++k2) o[m] = MFMA16(frag_sw(LQKM, 72, rowp(m, r), 4 * k2, g), vb[k2], o[m]);
            bf16_t* op = O + (size_t)(rowS + (ckc - ck0) * 64 + 32 * (m >> 1) + 8 * g + 4 * (m & 1)) * D + h * 128 + 16 * ws + r;
            const unsigned p01 = cvtpk(o[m][0], o[m][1]), p23 = cvtpk(o[m][2], o[m][3]);
            op[0] = (bf16_t)p01; op[(size_t)D] = (bf16_t)(p01 >> 16); op[(size_t)2 * D] = (bf16_t)p23; op[(size_t)3 * D] = (bf16_t)(p23 >> 16); }
        const float egl = LVEC[128];
#pragma unroll
        for (int j = 0; j < 8; ++j) { Sacc[j] = Sacc[j] * egl;
#pragma unroll
            for (int k2 = 0; k2 < 2; ++k2) Sacc[j] = MFMA16(frag_sw(LKT, 72, rowp(j, r), 4 * k2, g), vs[k2], Sacc[j]); }
        }
      }
    }
#undef DS_LOAD
    if (seq < 16 && act) { float* nd = F.out + O_ND + ((size_t)(seq * 2 + dir) * 8 + h) * 16384 + 16 * ws + r;
#pragma unroll
        for (int j = 0; j < 8; ++j)
#pragma unroll
            for (int i = 0; i < 4; ++i) nd[(32 * (j >> 1) + 8 * g + 4 * (j & 1) + i) * 128] = Sacc[j][i]; }
}
__device__ __forceinline__ bool scan_slot(int wg, int rnd, int& seq, int& h, int& dir, int& esl0, int& nact) {
    int id;
    if (wg < 64) { if (rnd) return false; id = wg >> 1; esl0 = (wg & 1) * 4; nact = 4; seq = 16 + id / 16; }
    else { id = (wg - 64) + rnd * 192; if (id >= 256) return false; esl0 = 0; nact = 8; seq = id / 16; }
    h = (id >> 1) & 7; dir = id & 1; return true;
}
__device__ __forceinline__ void ph_dn_scan2(Frame& F) {
    for (int rnd = 0; rnd < 2; ++rnd) { int seq, h, dir, esl0, nact; if (!scan_slot(F.wg, rnd, seq, h, dir, esl0, nact)) break; dn_scan_seq(F, seq, h, dir, esl0, nact); }
}
constexpr size_t BIG_MINTRA = BIG_WN;
constexpr size_t BIG_MU = BIG_MINTRA + (size_t)1536 * 8192 * 4;
constexpr size_t BIG_MVEC = BIG_MU + (size_t)1536 * 8192 * 4;
constexpr size_t BIG_MQS = BIG_MVEC + (size_t)1536 * 272 * 4;
static_assert(BIG_MQS + (size_t)768 * 4096 * 2 <= BIG_END, "mLSTM buffers exceed the big region");
constexpr int MP_LQ = 0, MP_LK = 9216, MP_LKT = 18432, MP_LVT = 27648, MP_LQK = 46080, MP_LPM = 63488, MP_LKW = 81920, MP_SC = 100352;
__device__ __forceinline__ void ph_ml_prep(Frame& F) {
    const bf16_t* P = (const bf16_t*)(F.big_() + BIG_PROJ); const float* GT = (const float*)(F.big_() + BIG_GATES);
    LAS bf16_t* LQ = (LAS bf16_t*)(F.lds + MP_LQ); LAS bf16_t* LK = (LAS bf16_t*)(F.lds + MP_LK); LAS bf16_t* LKT = (LAS bf16_t*)(F.lds + MP_LKT); LAS bf16_t* LVT = (LAS bf16_t*)(F.lds + MP_LVT);
    LAS float* LQK = (LAS float*)(F.lds + MP_LQK); LAS bf16_t* LPM = (LAS bf16_t*)(F.lds + MP_LPM); LAS bf16_t* LKW = (LAS bf16_t*)(F.lds + MP_LKW);
    LAS float* SC = (LAS float*)(F.lds + MP_SC);
    const int tid = F.tid, lane = F.lane, w = F.wave, r = lane & 15, g = lane >> 4;
    unsigned xqk[8], xvv[8];
    auto load_x = [&](int task_) { const int ck_ = task_ >> 3, h_ = task_ & 7; int seq_, t0_, T_; chunk_pos(ck_, seq_, t0_, T_);
        unsigned rowv = (unsigned)(seq_row0(seq_) + t0_ + 8 * w); asm volatile("" : "+v"(rowv));
#pragma unroll
        for (int tt = 0; tt < 8; ++tt) {
            xqk[tt] = *(const unsigned*)(P + ((rowv + tt) * 3072u + (unsigned)((lane < 32 ? 0 : 512) + h_ * 64 + (lane & 31) * 2)));
            xvv[tt] = *(const unsigned*)(P + ((rowv + tt) * 3072u + (unsigned)(1024 + h_ * 128 + 2 * lane))); } };
    if (F.wg < 96 * 8) load_x(F.wg);
    for (int task = F.wg; task < 96 * 8; task += F.G) {
        const int ck = task >> 3, h = task & 7; int seq, t0, T; chunk_pos(ck, seq, t0, T); const int row0 = seq_row0(seq) + t0;
        __syncthreads();
        {
            bf16_t* QSg = (bf16_t*)(F.big_() + BIG_MQS) + (size_t)task * 4096;
#pragma unroll
            for (int tt = 0; tt < 8; ++tt) { const int tk = 8 * w + tt;
                const int l2 = (lane & 31) * 2;
                const unsigned qk = xqk[tt], vv = xvv[tt];
                if (lane < 32) { const unsigned qs = pk2(bf2f(qk & 0xffffu) * 0.125f, bf2f(qk >> 16) * 0.125f); *(LAS unsigned*)(LQ + tk * 72 + l2) = qs; *(unsigned*)(QSg + tk * 64 + l2) = qs; }
                else { *(LAS unsigned*)(LK + tk * 72 + l2) = qk; LKT[l2 * 72 + tk] = (bf16_t)(qk & 0xffffu); LKT[(l2 + 1) * 72 + tk] = (bf16_t)(qk >> 16); }
                LVT[(2 * lane) * 72 + tk] = (bf16_t)(vv & 0xffffu); LVT[(2 * lane + 1) * 72 + tk] = (bf16_t)(vv >> 16);
            }
        }
        if (task + F.G < 96 * 8) load_x(task + F.G);
        if (w < 2) { const int dir = w, c = dir ? 63 - lane : lane;
            const float li = GT[(size_t)(row0 + c) * 32 + dir * 16 + h] + F.inp(I_MBI)[dir * 8 + h];
            float bc = logsigmoid_f(GT[(size_t)(row0 + c) * 32 + dir * 16 + 8 + h] + F.inp(I_MBF)[dir * 8 + h]);
#pragma unroll
            for (int o = 1; o < 64; o <<= 1) { const float t = __shfl_up(bc, o); if (lane >= o) bc += t; }
            const float a = li - bc; float am = a;
#pragma unroll
            for (int o = 1; o < 64; o <<= 1) { const float t = __shfl_up(am, o); if (lane >= o) am = fmaxf(am, t); }
            SC[dir * 256 + c] = bc; SC[dir * 256 + 64 + c] = a; SC[dir * 256 + 128 + c] = am;
            if (lane == 63) { SC[512 + dir * 2] = bc; SC[512 + dir * 2 + 1] = am; }
        }
        __syncthreads();
        {
            const int mi = w >> 1;
            f32x4 acc[2] = {(f32x4){0.f, 0.f, 0.f, 0.f}, (f32x4){0.f, 0.f, 0.f, 0.f}};
#pragma unroll
            for (int kk = 0; kk < 2; ++kk) { const bf16x8_t a = frag_nat(LQ, 72, 16 * mi + r, 32 * kk, g);
#pragma unroll
                for (int nn = 0; nn < 2; ++nn) acc[nn] = MFMA16(a, frag_nat(LK, 72, 16 * (2 * (w & 1) + nn) + r, 32 * kk, g), acc[nn]); }
#pragma unroll
            for (int nn = 0; nn < 2; ++nn)
#pragma unroll
                for (int i = 0; i < 4; ++i) LQK[(16 * mi + 4 * g + i) * 68 + 16 * (2 * (w & 1) + nn) + r] = acc[nn][i];
        }
        __syncthreads();
        {
            const size_t cd0 = (size_t)task * 2;
#pragma unroll
            for (int it = 0; it < 4; ++it) { const int idx = tid + 512 * it, c = idx >> 5, s = (idx & 31) * 2;
#pragma unroll
                for (int dir = 0; dir < 2; ++dir) { const LAS float* sc = SC + dir * 256;
                    const float amc = sc[128 + c], amL = SC[512 + dir * 2 + 1];
                    float pm[2], kw[2];
#pragma unroll
                    for (int e = 0; e < 2; ++e) { const int ss = s + e; const bool ok = dir ? ss >= c : ss <= c;
                        pm[e] = ok ? LQK[c * 68 + ss] * __expf(sc[64 + ss] - amc) : 0.f;
                        kw[e] = bf2f(LKT[c * 72 + ss]) * __expf(sc[64 + ss] - amL); }
                    *(LAS unsigned*)(LPM + dir * 64 * 72 + c * 72 + s) = pk2(pm[0], pm[1]); *(LAS unsigned*)(LKW + dir * 64 * 72 + c * 72 + s) = pk2(kw[0], kw[1]);
                    float ps = pm[0] + pm[1], ks = kw[0] + kw[1];
#pragma unroll
                    for (int o = 1; o < 32; o <<= 1) { ps += __shfl_xor(ps, o); ks += __shfl_xor(ks, o); }
                    if ((lane & 31) == 0) { float* VEC = (float*)(F.big_() + BIG_MVEC) + (cd0 + dir) * 272; VEC[128 + (c & 15) * 4 + (c >> 4)] = ps; VEC[192 + c] = ks; }
                } }
            if (tid < 128) { const int dir = tid >> 6, c = tid & 63; float* VEC = (float*)(F.big_() + BIG_MVEC) + (cd0 + dir) * 272; const LAS float* sc = SC + dir * 256;
                VEC[(c & 15) * 4 + (c >> 4)] = sc[c]; VEC[64 + (c & 15) * 4 + (c >> 4)] = sc[c] + sc[128 + c];
                if (c == 0) { const float bl = SC[512 + dir * 2]; VEC[256] = bl; VEC[257] = bl + SC[512 + dir * 2 + 1]; } }
        }
        __syncthreads();
#pragma unroll
        for (int dir = 0; dir < 2; ++dir) { const size_t cd = (size_t)task * 2 + dir;
            bf16_t* Ig = (bf16_t*)(F.big_() + BIG_MINTRA) + cd * 8192 + (size_t)w * 1024 + lane * 4; bf16_t* Ug = (bf16_t*)(F.big_() + BIG_MU) + cd * 8192 + (size_t)w * 1024 + lane * 4;
            const bf16x8_t v0 = frag_nat(LVT, 72, 16 * w + r, 0, g), v1 = frag_nat(LVT, 72, 16 * w + r, 32, g);
#pragma unroll
            for (int m = 0; m < 4; ++m) { f32x4 ai = (f32x4){0.f, 0.f, 0.f, 0.f}, au = (f32x4){0.f, 0.f, 0.f, 0.f};
                ai = MFMA16(frag_nat(LPM + dir * 64 * 72, 72, 16 * m + r, 0, g), v0, ai); ai = MFMA16(frag_nat(LPM + dir * 64 * 72, 72, 16 * m + r, 32, g), v1, ai);
                au = MFMA16(frag_nat(LKW + dir * 64 * 72, 72, rowp(m, r), 0, g), v0, au); au = MFMA16(frag_nat(LKW + dir * 64 * 72, 72, rowp(m, r), 32, g), v1, au);
                *(u2v*)(Ig + m * 256) = pk4(ai); *(u2v*)(Ug + m * 256) = pk4(au); }
        }
    }
}
constexpr int MS_LQS = 0, MS_LVEC = 9216, MS_WSCR = 10304;
__device__ __forceinline__ void ml_scan_seq(Frame& F, int seq, int h, int dir, int esl0, int nact) {
    const int lane = F.lane, w = F.wave, r = lane & 15, g = lane >> 4, ws = esl0 + w;
    if (w >= nact) return;
    LAS float* WS = (LAS float*)(F.lds + MS_WSCR) + w * 192;
    const int NC = seq < 16 ? 4 : 16, ck0 = seq < 16 ? seq * 4 : 64 + (seq - 16) * 16, rowS = seq_row0(seq);
    bf16_t* O = (bf16_t*)(F.slab_() + (dir ? SLAB_FULL : 0));
    f32x4 Cacc[4]; float nst = 0.f, mst = 0.f;
    if (seq >= 16) { const size_t sidx = (size_t)((seq - 16) * 2 + dir) * 8 + h; const float* c0 = F.inp(I_SC) + sidx * 8192 + 16 * ws + r;
#pragma unroll
        for (int j = 0; j < 4; ++j)
#pragma unroll
            for (int i = 0; i < 4; ++i) Cacc[j][i] = c0[(32 * (j >> 1) + 8 * g + 4 * (j & 1) + i) * 128];
        nst = F.inp(I_SN)[sidx * 64 + lane]; mst = F.inp(I_SM)[sidx]; }
    else {
#pragma unroll
        for (int j = 0; j < 4; ++j) Cacc[j] = (f32x4){0.f, 0.f, 0.f, 0.f}; }
    struct MStage { bf16x8_t qf[4][2]; f32x4 vt[3]; float ks, bl, wm; u2v I[4], U[4]; };
    constexpr int PD = 2;
    MStage st[PD];
#define MS_LOAD(S, n) do { const int ckn = ck0 + (dir ? NC - 1 - (n) : (n)); const size_t tk = (size_t)ckn * 8 + h, cd = tk * 2 + dir; \
        const bf16_t* gQ = (const bf16_t*)(F.big_() + BIG_MQS) + tk * 4096 + r * 64 + 8 * g; const float* gV = (const float*)(F.big_() + BIG_MVEC) + cd * 272; \
        _Pragma("unroll") for (int m = 0; m < 4; ++m) { S.qf[m][0] = *(const bf16x8_t*)(gQ + m * 1024); S.qf[m][1] = *(const bf16x8_t*)(gQ + m * 1024 + 32); } \
        _Pragma("unroll") for (int q = 0; q < 3; ++q) S.vt[q] = *(const f32x4*)(gV + q * 64 + r * 4); \
        S.ks = gV[192 + lane]; S.bl = gV[256]; S.wm = gV[257]; \
        const bf16_t* gI = (const bf16_t*)(F.big_() + BIG_MINTRA) + cd * 8192 + (size_t)ws * 1024 + lane * 4; const bf16_t* gU = (const bf16_t*)(F.big_() + BIG_MU) + cd * 8192 + (size_t)ws * 1024 + lane * 4; \
        _Pragma("unroll") for (int m = 0; m < 4; ++m) { S.I[m] = *(const u2v*)(gI + m * 256); S.U[m] = *(const u2v*)(gU + m * 256); } } while (0)
#pragma unroll
    for (int k = 0; k < PD; ++k) MS_LOAD(st[k], k);
    for (int n0 = 0; n0 < NC; n0 += PD) {
#pragma unroll
      for (int k = 0; k < PD; ++k) { const int n = n0 + k; const int ckc = ck0 + (dir ? NC - 1 - n : n);
        WS[lane] = nst;
        const f32x4 na0 = *(const LAS f32x4*)(WS + 8 * g), na1 = *(const LAS f32x4*)(WS + 8 * g + 4), nb0 = *(const LAS f32x4*)(WS + 32 + 8 * g), nb1 = *(const LAS f32x4*)(WS + 32 + 8 * g + 4);
        float qn[4];
#pragma unroll
        for (int m = 0; m < 4; ++m) { const bf16x8_t qa = st[k].qf[m][0], qb = st[k].qf[m][1]; float p = 0.f;
#pragma unroll
            for (int e = 0; e < 4; ++e) { p += bf2f((unsigned short)qa[e]) * na0[e]; p += bf2f((unsigned short)qa[4 + e]) * na1[e]; p += bf2f((unsigned short)qb[e]) * nb0[e]; p += bf2f((unsigned short)qb[4 + e]) * nb1[e]; }
            p += __shfl_xor(p, 16); p += __shfl_xor(p, 32); qn[m] = p; }
#pragma unroll
        for (int m = 0; m < 4; ++m) { const float bc = st[k].vt[0][m], dm = st[k].vt[1][m], rs = st[k].vt[2][m];
            const float mt = fmaxf(bc + mst, dm), inter = __expf(bc + mst - mt), rr = __expf(dm - mt);
            const float inv = __builtin_amdgcn_rcpf(fmaxf(fabsf(inter * qn[m] + rr * rs), __expf(-mt)));
            if (g == 0) { WS[64 + 16 * m + r] = inter * inv; WS[128 + 16 * m + r] = rr * inv; } }
        const bf16x8_t Cb0 = pack_acc(Cacc[0], Cacc[1]), Cb1 = pack_acc(Cacc[2], Cacc[3]);
#pragma unroll
        for (int m = 0; m < 4; ++m) { f32x4 qc = (f32x4){0.f, 0.f, 0.f, 0.f};
            qc = MFMA16(st[k].qf[m][0], Cb0, qc); qc = MFMA16(st[k].qf[m][1], Cb1, qc);
            const f32x4 ac = *(const LAS f32x4*)(WS + 64 + 16 * m + 4 * g), bcf = *(const LAS f32x4*)(WS + 128 + 16 * m + 4 * g);
            const f32x4 hv = ac * qc + bcf * up4(st[k].I[m]);
            bf16_t* op = O + (size_t)(rowS + (ckc - ck0) * 64 + 16 * m + 4 * g) * D + h * 128 + 16 * ws + r;
            const unsigned p01 = cvtpk(hv[0], hv[1]), p23 = cvtpk(hv[2], hv[3]);
            op[0] = (bf16_t)p01; op[(size_t)D] = (bf16_t)(p01 >> 16); op[(size_t)2 * D] = (bf16_t)p23; op[(size_t)3 * D] = (bf16_t)(p23 >> 16); }
        const float bl = st[k].bl, wm = st[k].wm, mn = fmaxf(bl + mst, wm), dec = __expf(bl + mst - mn), fw = __expf(wm - mn);
#pragma unroll
        for (int j = 0; j < 4; ++j) Cacc[j] = Cacc[j] * dec + up4(st[k].U[j]) * fw;
        nst = dec * nst + fw * st[k].ks; mst = mn;
        if (n + PD < NC) MS_LOAD(st[k], n + PD);
      }
    }
#undef MS_LOAD
    if (seq < 16) { const size_t sidx = (size_t)(seq * 2 + dir) * 8 + h; float* nc = F.out + O_NC + sidx * 8192 + 16 * ws + r;
#pragma unroll
        for (int j = 0; j < 4; ++j)
#pragma unroll
            for (int i = 0; i < 4; ++i) nc[(32 * (j >> 1) + 8 * g + 4 * (j & 1) + i) * 128] = Cacc[j][i];
        if (w == 0) { F.out[O_NN + sidx * 64 + lane] = nst; if (lane == 0) F.out[O_NM + sidx] = mst; } }
}
__device__ __forceinline__ bool ml_scan_slot(int wg, int rnd, int& seq, int& h, int& dir, int& esl0, int& nact) {
    int id;
    if (wg < 64) { if (rnd) return false; id = wg >> 1; esl0 = (wg & 1) * 4; nact = 4; seq = 16 + id / 16; }
    else { if (wg >= 160) return false; id = (wg - 64) + rnd * 96; if (id >= 256) return false; esl0 = 0; nact = 8; seq = id / 16; }
    h = (id >> 1) & 7; dir = id & 1; return true;
}
__device__ __forceinline__ void ph_ml_scan2(Frame& F) {
    for (int rnd = 0; rnd < 3; ++rnd) { int seq, h, dir, esl0, nact; if (!ml_scan_slot(F.wg, rnd, seq, h, dir, esl0, nact)) break; ml_scan_seq(F, seq, h, dir, esl0, nact); }
}
__device__ __forceinline__ void ph_post(Frame& F, int NP, int gate_col0, int gate_kind, const float* nw) {
    const bf16_t* P = (const bf16_t*)(F.big_() + BIG_PROJ); const bf16_t* OF = (const bf16_t*)F.slab_(); const bf16_t* OB = (const bf16_t*)(F.slab_() + SLAB_FULL); bf16_t* OG = (bf16_t*)(F.big_() + BIG_OG);
    const int gw = F.wg * NWAVES + F.wave, NGW = F.G * NWAVES, lane = F.lane;
    const f32x2 w = *(const f32x2*)(nw + 2 * lane);
    constexpr int IU = 6;
    for (int ib = gw; ib < MTOT * 8; ib += IU * NGW) {
        f32x2 v[IU]; unsigned zz[IU];
#pragma unroll
        for (int q = 0; q < IU; ++q) { const int it = ib + q * NGW; const bool ok = it < MTOT * 8; const int row = ok ? it >> 3 : 0, h = it & 7; const size_t o = (size_t)row * D + h * 128 + 2 * lane;
            { const unsigned uf = *(const unsigned*)(OF + o), ub = *(const unsigned*)(OB + o); v[q] = (f32x2){bf2f(uf & 0xffffu) + bf2f(ub & 0xffffu), bf2f(uf >> 16) + bf2f(ub >> 16)}; } zz[q] = *(const unsigned*)(P + (size_t)row * NP + gate_col0 + h * 128 + 2 * lane); }
#pragma unroll
        for (int q = 0; q < IU; ++q) { const int it = ib + q * NGW; if (it >= MTOT * 8) continue; const int row = it >> 3, h = it & 7; const size_t o = (size_t)row * D + h * 128 + 2 * lane;
            const float rstd = rsqrtf(wave_sum(v[q][0] * v[q][0] + v[q][1] * v[q][1]) * (1.f / 128.f) + EPS);
            const float z0 = bf2f(zz[q] & 0xffffu), z1 = bf2f(zz[q] >> 16);
            const float g0 = gate_kind == 0 ? silu_f(z0) : sigmoid_f(z0), g1 = gate_kind == 0 ? silu_f(z1) : sigmoid_f(z1);
            st4_wt(OG + o, cvtpk(v[q][0] * rstd * w[0] * g0, v[q][1] * rstd * w[1] * g1)); }
    }
}

#define R(cls, call) do { call; if (PROBE_MASK & (1 << (cls))) { call; } } while (0)
constexpr int NPHASES = 36;
__global__ void __launch_bounds__(NTHR, 2) mega(Args args) {
    extern __shared__ __attribute__((aligned(16))) unsigned char lds_raw[];
    Frame F;
    F.out = args.out; F.ws = args.ws; F.lds = (LAS unsigned char*)lds_raw;
    F.tid = threadIdx.x; F.lane = F.tid & 63; F.wave = __builtin_amdgcn_readfirstlane(F.tid >> 6); F.G = gridDim.x; F.wg = blockIdx.x;
    volatile LAS unsigned* MISC = (volatile LAS unsigned*)(F.lds + MISC_OFF);
    if (F.tid < 64) MISC[F.tid] = 0u;
    if (F.tid >= 64 && F.tid < 64 + N_IN) ((LAS unsigned long long*)(F.lds + PTR_OFF))[F.tid - 64] = (unsigned long long)args.in[F.tid - 64];
    __syncthreads();
    const int lo = args.ph_lo, hi = args.ph_hi;
    XcdBarrier bar; bar.bar = (unsigned*)(args.ws + WS_CTL); bar.x = 0; bar.st = MISC + 8;
    if (hi - lo > 1) bar = xcd_barrier_post((unsigned*)(args.ws + WS_CTL), MISC + 8);
    int ph = 0;
#define PH_BEGIN if (ph >= lo && ph < hi) {
#define PH_END   if (ph + 1 < hi) xcd_barrier(bar); } ++ph;
#define PH_END_PRE(Bexpr, ldb) if (ph + 1 < hi) xcd_barrier_pre(bar, F.lds, Bexpr, ldb); } ++ph;
    #define in_nmix F.inp(I_NMIX)
#define in_nffn F.inp(I_NFFN)

    PH_BEGIN R(4, ph_prologue(F)); PH_END
    PH_BEGIN R(3, ph_wcs(F)); ph_norm(F, -1, 0, nullptr, 0, 0, 1.f, 1.f, 0, 0, in_nmix, true, 64); PH_END
#define MIX_FOURIER(j) \
    PH_BEGIN R(3, ph_f1(F, j)); PH_END \
    PH_BEGIN R(3, ph_f2(F)); PH_END
#define FFN_BLOCK(l, mbias, nsc, nss, sc_c, sc_s) \
    PH_BEGIN ph_norm(F, l, 2, mbias, nsc, nss, sc_c, sc_s, l, 3, in_nffn + (l) * D); PH_END_PRE(firstB_up(F, l), D) \
    PH_BEGIN ph_ffn_up(F, l); PH_END \
    PH_BEGIN R(2, ph_ffn_conv(F, l)); PH_END_PRE(firstB_slab(F, (const bf16_t*)(F.big_() + BIG_ACT), DFF, F.wt_() + WT_DN + (size_t)(l) * D * DFF * 2), DFF) \
    PH_BEGIN ph_gemm_slab(F, (const bf16_t*)(F.big_() + BIG_ACT), DFF, F.wt_() + WT_DN + (size_t)(l) * D * DFF * 2); PH_END
    MIX_FOURIER(0)
    FFN_BLOCK(0, F.inp(I_FB), 1, 4, 1.f / 256.f, 1.f / 512.f)
    PH_BEGIN ph_norm(F, 0, 5, nullptr, 2, 2, 1.f, 1.f, 1, 0, in_nmix + 1 * D); PH_END_PRE(firstB_proj(F, F.wt_() + WT_DIN, 16), D)
    PH_BEGIN ph_proj(F, F.wt_() + WT_DIN, 16); PH_END
    PH_BEGIN R(5, ph_dn_prep2(F)); PH_END
    PH_BEGIN R(0, ph_dn_scan2(F)); PH_END
    PH_BEGIN R(7, ph_post(F, 4096, 3072, 0, F.inp(I_DNORM))); PH_END_PRE(firstB_slab(F, (const bf16_t*)(F.big_() + BIG_OG), D, F.wt_() + WT_DOUT), D)
    PH_BEGIN ph_gemm_slab(F, (const bf16_t*)(F.big_() + BIG_OG), D, F.wt_() + WT_DOUT); PH_END
    FFN_BLOCK(1, nullptr, 2, 2, 1.f, 1.f)
    PH_BEGIN ph_norm(F, 1, 5, nullptr, 2, 2, 1.f, 1.f, 2, 0, in_nmix + 2 * D); PH_END_PRE(firstB_proj(F, F.wt_() + WT_MIN, 12), D)
    PH_BEGIN ph_proj(F, F.wt_() + WT_MIN, 12); PH_END
    PH_BEGIN R(6, ph_ml_prep(F)); PH_END_PRE(firstB_og(F), D)
    PH_BEGIN R(0, ph_ml_scan2(F)); ph_ml_ogate(F); PH_END
    PH_BEGIN R(7, ph_post(F, 3072, 2048, 1, F.inp(I_MNORM))); PH_END_PRE(firstB_slab(F, (const bf16_t*)(F.big_() + BIG_OG), D, F.wt_() + WT_MOUT), D)
    PH_BEGIN ph_gemm_slab(F, (const bf16_t*)(F.big_() + BIG_OG), D, F.wt_() + WT_MOUT); PH_END
    FFN_BLOCK(2, nullptr, 2, 2, 1.f, 1.f)
    PH_BEGIN ph_norm(F, 2, 5, nullptr, 2, 2, 1.f, 1.f, 3, 0, in_nmix + 3 * D); PH_END
    MIX_FOURIER(1)
    FFN_BLOCK(3, F.inp(I_FB) + D, 1, 4, 1.f / 256.f, 1.f / 512.f)
    PH_BEGIN ph_norm(F, 3, 5, nullptr, 2, 2, 1.f, 1.f, -1, 0, F.inp(I_NFIN)); PH_END
}

extern "C" void kernel_launch(void* const* d_in, const int* in_sizes, int n_in, void* d_out, int out_size, void* d_ws, size_t ws_size, hipStream_t stream) {
    static int grid = 0;
    if (grid == 0) {
        if (n_in != N_IN || ws_size < WS_END) { fprintf(stderr, "kernel_launch: unexpected n_in %d / ws %zu (need %zu)\n", n_in, ws_size, (size_t)WS_END); grid = -1; return; }
        int dev = 0, cus = 0, per_cu = 0;
        (void)hipGetDevice(&dev); (void)hipDeviceGetAttribute(&cus, hipDeviceAttributeMultiprocessorCount, dev);
        (void)hipFuncSetAttribute((const void*)mega, hipFuncAttributeMaxDynamicSharedMemorySize, LDS_BYTES);
        if (hipOccupancyMaxActiveBlocksPerMultiprocessor(&per_cu, (const void*)mega, NTHR, LDS_BYTES) != hipSuccess || per_cu < 1) per_cu = 1;
        (void)hipGetLastError();
        (void)cus; grid = 256;
    }
    if (grid < 0) return;
    (void)hipMemsetAsync((char*)d_ws + WS_CTL, 0, ZERO_BYTES, stream);
    Args a{};
    for (int i = 0; i < N_IN; ++i) a.in[i] = (const float*)d_in[i];
    a.out = (float*)d_out; a.ws = (unsigned char*)d_ws;
#if N_LAUNCH_MODE == 1
    a.ph_lo = 0; a.ph_hi = NPHASES;
    void* kargs[] = {&a};
    hipError_t e = hipLaunchCooperativeKernel((const void*)mega, dim3(grid), dim3(NTHR), kargs, LDS_BYTES, stream);
    if (e != hipSuccess) fprintf(stderr, "cooperative launch failed: %s (grid %d)\n", hipGetErrorString(e), grid);
#else
    for (int p = 0; p < NPHASES; ++p) { a.ph_lo = p; a.ph_hi = p + 1; hipLaunchKernelGGL(mega, dim3(grid), dim3(NTHR), LDS_BYTES, stream, a); }
#endif
}
```

```cpp
#include <hip/hip_runtime.h>
#include <cstdint>
#include <cstdio>

#ifndef PROBE_MASK
#define PROBE_MASK 0
#endif
#ifndef N_LAUNCH_MODE
#define N_LAUNCH_MODE 1
#endif

#define LAS __attribute__((address_space(3)))
#define GAS __attribute__((address_space(1)))
typedef unsigned short bf16_t;
typedef float f32x4 __attribute__((ext_vector_type(4)));
typedef float f32x2 __attribute__((ext_vector_type(2)));
typedef unsigned u4v __attribute__((ext_vector_type(4)));
typedef unsigned u2v __attribute__((ext_vector_type(2)));
typedef __bf16 bf16x2_t __attribute__((ext_vector_type(2)));
__device__ __forceinline__ unsigned cvtpk(float lo, float hi) { const f32x2 v = {lo, hi}; return __builtin_bit_cast(unsigned, __builtin_convertvector(v, bf16x2_t)); }

constexpr int D = 1024, MCTX = 4096, MTOT = 6144;
constexpr int DFF = 2816, NUP = 5632;
constexpr int DN_PROJ = 4128, ML_PROJ = 3104;
constexpr int NWAVES = 8, NTHR = 512;
constexpr float EPS = 1e-6f;
enum { I_XP = 0, I_XS, I_SD, I_SC, I_SN, I_SM, I_C, I_CCTX, I_WADA, I_BADA, I_NMIX, I_NFFN, I_NFIN, I_WUP, I_CW, I_CB, I_WDN,
       I_FW, I_FB, I_DWIN, I_DCW, I_DALOG, I_DDT, I_DNORM, I_DWOUT, I_MWIN, I_MBI, I_MBF, I_MNORM, I_MWOUT, N_IN };
constexpr size_t O_Y = 0, O_ND = 6291456, O_NC = 10485760, O_NN = 12582912, O_NM = 12599296;

constexpr size_t WS_CTL = 0;
constexpr size_t CTL_BYTES = 65536;
constexpr size_t ZERO_BYTES = CTL_BYTES;
constexpr size_t WS_MOD = WS_CTL + CTL_BYTES;
constexpr size_t MOD_BYTES = 4 * 3 * 6144 * 4;
constexpr size_t WS_X = WS_MOD + MOD_BYTES;
constexpr size_t WS_H = WS_X + (size_t)MTOT * D * 4;
constexpr size_t WS_TAB = WS_H + (size_t)MTOT * D * 2;
constexpr size_t TAB_CS256 = 0, TAB_CST256 = 512 * 256 * 2, TAB_CST1024 = TAB_CST256 + 256 * 512 * 2, TAB_BYTES = TAB_CST1024 + 1024 * 2048 * 2;
constexpr size_t WS_WT = WS_TAB + TAB_BYTES;
constexpr size_t WT_UP = 0;
constexpr size_t WT_DN = WT_UP + (size_t)4 * NUP * D * 2;
constexpr size_t WT_F = WT_DN + (size_t)4 * D * DFF * 2;
constexpr size_t WT_CS = WT_F + (size_t)2 * D * D * 2;
constexpr size_t WT_DIN = WT_CS + (size_t)2 * 2048 * D * 2;
constexpr size_t WT_DOUT = WT_DIN + (size_t)4352 * D * 2;
constexpr size_t WT_MIN = WT_DOUT + (size_t)D * D * 2;
constexpr size_t WT_MOUT = WT_MIN + (size_t)3328 * D * 2;
constexpr size_t WT_BYTES = WT_MOUT + (size_t)D * D * 2;
constexpr size_t WS_SLAB = WS_WT + WT_BYTES;
constexpr size_t SLAB_FULL = (size_t)MTOT * D * 4, SLAB_SMP = (size_t)2048 * D * 4;
constexpr size_t WS_BIG = WS_SLAB + 2 * SLAB_FULL + 2 * SLAB_SMP;
constexpr size_t BIG_UG = 0;
constexpr size_t BIG_ACT = BIG_UG + (size_t)MTOT * NUP * 2;
constexpr size_t BIG_ZTC = 0;
constexpr size_t BIG_ZTS = BIG_ZTC + (size_t)16 * 1024 * 512 * 2;
constexpr size_t BIG_PROJ = 0;
constexpr size_t BIG_GATES = BIG_PROJ + (size_t)MTOT * 4096 * 2;
constexpr size_t BIG_OG = BIG_GATES + (size_t)MTOT * 32 * 4;
constexpr size_t BIG_WN = BIG_OG + (size_t)MTOT * D * 2;
constexpr size_t BIG_QKM = BIG_WN + (size_t)1536 * 8192 * 2;
constexpr size_t BIG_U = BIG_QKM + (size_t)1536 * 4096 * 2;
constexpr size_t BIG_VEC = BIG_U + (size_t)1536 * 8192 * 4;
constexpr size_t BIG_QS = BIG_VEC + (size_t)1536 * 192 * 4;
constexpr size_t BIG_KTG = BIG_QS + (size_t)768 * 8192 * 2;
constexpr size_t BIG_END_DN = BIG_KTG + (size_t)768 * 8192 * 2;
constexpr size_t BIG_END = BIG_END_DN > (size_t)MTOT * NUP * 2 + (size_t)MTOT * DFF * 2 ? BIG_END_DN : (size_t)MTOT * NUP * 2 + (size_t)MTOT * DFF * 2;
constexpr size_t BIG_Q = 0, BIG_K = 0, BIG_V = 0, BIG_GA = 0, BIG_BE = 0;
constexpr size_t WS_END = WS_BIG + BIG_END;

constexpr int LDS_BYTES = 131072 + 1024 + 4096;
constexpr int MISC_OFF = 131072;

__device__ __forceinline__ unsigned f2bf(float f) { unsigned u = __builtin_bit_cast(unsigned, f); return (u + 0x7fffu + ((u >> 16) & 1u)) >> 16; }
__device__ __forceinline__ float bf2f(unsigned h) { return __builtin_bit_cast(float, h << 16); }
__device__ __forceinline__ unsigned pk2(float lo, float hi) { return cvtpk(lo, hi); }
__device__ __forceinline__ float dpp_add(float v, const int ctrl_sel) {
    int s;
    switch (ctrl_sel) {
        case 0: s = __builtin_amdgcn_update_dpp(0, __builtin_bit_cast(int, v), 0xB1, 0xF, 0xF, true); break;
        case 1: s = __builtin_amdgcn_update_dpp(0, __builtin_bit_cast(int, v), 0x4E, 0xF, 0xF, true); break;
        case 2: s = __builtin_amdgcn_update_dpp(0, __builtin_bit_cast(int, v), 0x141, 0xF, 0xF, true); break;
        default: s = __builtin_amdgcn_update_dpp(0, __builtin_bit_cast(int, v), 0x140, 0xF, 0xF, true); break;
    }
    return v + __builtin_bit_cast(float, s);
}
__device__ __forceinline__ float wave_sum(float v) {
    v = dpp_add(v, 0); v = dpp_add(v, 1); v = dpp_add(v, 2); v = dpp_add(v, 3);
    const int iv = __builtin_bit_cast(int, v);
    const float r0 = __builtin_bit_cast(float, __builtin_amdgcn_readlane(iv, 0)), r1 = __builtin_bit_cast(float, __builtin_amdgcn_readlane(iv, 16));
    const float r2 = __builtin_bit_cast(float, __builtin_amdgcn_readlane(iv, 32)), r3 = __builtin_bit_cast(float, __builtin_amdgcn_readlane(iv, 48));
    return (r0 + r1) + (r2 + r3);
}
__device__ __forceinline__ float silu_f(float x) { return x * __builtin_amdgcn_rcpf(1.f + __expf(-x)); }
__device__ __forceinline__ float sigmoid_f(float x) { return __builtin_amdgcn_rcpf(1.f + __expf(-x)); }
__device__ __forceinline__ float softplus_f(float x) { return x > 20.f ? x : log1pf(expf(x)); }
__device__ __forceinline__ float logsigmoid_f(float x) { return fminf(x, 0.f) - log1pf(expf(-fabsf(x))); }
__device__ __forceinline__ int row_cond(int r) { return r < MCTX ? 0 : 1 + ((r - MCTX) >> 10); }
__device__ __forceinline__ void row_seq(int r, int& seq, int& t, int& T) {
    if (r < MCTX) { seq = r >> 8; t = r & 255; T = 256; } else { seq = 16 + ((r - MCTX) >> 10); t = (r - MCTX) & 1023; T = 1024; }
}
__device__ __forceinline__ int seq_row0(int seq) { return seq < 16 ? seq * 256 : MCTX + (seq - 16) * 1024; }
__device__ __forceinline__ int seq_len(int seq) { return seq < 16 ? 256 : 1024; }

#define XB_TMO      128
#define XB_XCNT(j)  (256  + 64 * (j))
#define XB_XSUB(j)  (1280 + 64 * (j))
#define XB_XGEN(j)  (2304 + 64 * (j))
#define XB_TOP      3328
#define XB_TOPGEN   3392
#define XCD_BAR_WORDS 3456
#define XB_SPIN_CAP (1u << 20)
__device__ __forceinline__ unsigned xb_ld(unsigned* p)              { return __hip_atomic_load(p, __ATOMIC_RELAXED, __HIP_MEMORY_SCOPE_AGENT); }
__device__ __forceinline__ unsigned xb_add(unsigned* p, unsigned v) { return __hip_atomic_fetch_add(p, v, __ATOMIC_RELAXED, __HIP_MEMORY_SCOPE_AGENT); }
__device__ __forceinline__ unsigned xb_xcc_id() { return (unsigned)__builtin_amdgcn_s_getreg((3 << 11) | 20) & 0xFu; }
#define XB_SPIN(cond, bar) do { unsigned _sp = 0; while (cond) { __builtin_amdgcn_s_sleep(1); \
    if ((++_sp & 255u) == 0u) { if (xb_ld(&(bar)[XB_TMO])) break; if (_sp > XB_SPIN_CAP) { atomicAdd(&(bar)[XB_TMO], 1u); break; } } } } while (0)
struct XcdBarrier { unsigned* bar; unsigned x; volatile LAS unsigned* st; };
__device__ __forceinline__ XcdBarrier xcd_barrier_post(unsigned* bar, volatile LAS unsigned* st) {
    XcdBarrier b; b.bar = bar; b.x = xb_xcc_id(); b.st = st;
    if (threadIdx.x == 0) (void)xb_add(&bar[XB_XCNT(b.x)], 1u);
    return b;
}
__device__ __forceinline__ void xcd_barrier_complete(unsigned* bar, unsigned x, unsigned& nloc, unsigned& nx) {
    const unsigned G = gridDim.x * gridDim.y * gridDim.z;
    unsigned sum, cnt, mine, sp = 0u;
    for (;;) {
        sum = 0u; cnt = 0u; mine = 0u;
#pragma unroll
        for (unsigned j = 0; j < 16; ++j) { const unsigned c = xb_ld(&bar[XB_XCNT(j)]); sum += c; cnt += (c > 0u) ? 1u : 0u; mine = (j == x) ? c : mine; }
        if (sum == G) break;
        __builtin_amdgcn_s_sleep(1);
        if ((++sp & 255u) == 0u) { if (xb_ld(&bar[XB_TMO])) break; if (sp > XB_SPIN_CAP) { atomicAdd(&bar[XB_TMO], 1u); break; } }
    }
    nloc = mine > 0u ? mine : 1u; nx = cnt > 0u ? cnt : 1u;
}
__device__ __forceinline__ void xcd_barrier(const XcdBarrier& b, bool clean = false) {
    asm volatile("s_waitcnt vmcnt(0)" ::: "memory");
    __syncthreads();
    if (threadIdx.x == 0) {
        unsigned* bar = b.bar;
        __builtin_amdgcn_s_waitcnt(0);
        unsigned nloc = b.st[0], nx = b.st[1];
        if (nloc == 0u) { xcd_barrier_complete(bar, b.x, nloc, nx); b.st[0] = nloc; b.st[1] = nx; }
        const unsigned old = xb_add(&bar[XB_XSUB(b.x)], 1u);
        asm volatile("buffer_inv sc1" ::: "memory");
        const unsigned gen = old / nloc;
        if (old + 1u == (gen + 1u) * nloc) {
            if (!clean) __builtin_amdgcn_fence(__ATOMIC_RELEASE, "agent");
            asm volatile("s_waitcnt vmcnt(0)" ::: "memory");
            const unsigned og = xb_add(&bar[XB_TOP], 1u);
            const unsigned tg = og / nx;
            if (og + 1u == (tg + 1u) * nx) xb_add(&bar[XB_TOPGEN], 1u);
            else XB_SPIN(xb_ld(&bar[XB_TOPGEN]) == tg, bar);
            xb_add(&bar[XB_XGEN(b.x)], 1u);
            asm volatile("s_waitcnt vmcnt(0)" ::: "memory");
        } else {
            XB_SPIN(xb_ld(&bar[XB_XGEN(b.x)]) == gen, bar);
            asm volatile("s_waitcnt vmcnt(0)" ::: "memory");
        }
    }
    __syncthreads();
}

namespace pg8 {
typedef short bf16x8 __attribute__((ext_vector_type(8)));
typedef unsigned u32x4 __attribute__((ext_vector_type(4)));
constexpr int BM = 256, BK = 64, HALF = 128, HTB = HALF * BK * 2, STAGE_BYTES = 8 * HTB, NXCD = 8, WGM = 8;
__device__ __forceinline__ int lds_byte(int r, int c) { const int st = (r >> 4) * 2 + (c >> 5), rr = r & 15, cc = c & 31, ob = rr * 64 + cc * 2; return st * 1024 + (ob ^ (((ob >> 9) & 1) << 5)); }
__device__ __forceinline__ void stage_rc(int b, int& R, int& C) { const int st = b / 1024, sb = b % 1024, swz = sb ^ (((sb >> 9) & 1) << 5); R = (st >> 1) * 16 + swz / 64; C = (st & 1) * 32 + (swz % 64) / 2; }
__device__ __forceinline__ int perm32(int rho) { const int n = rho >> 4, i = rho & 15; return 8 * (i >> 2) + 4 * n + (i & 3); }
__device__ __forceinline__ unsigned cvt_pk_bf16(float lo, float hi) { unsigned r; asm volatile("v_cvt_pk_bf16_f32 %0, %1, %2" : "=v"(r) : "v"(lo), "v"(hi)); return r; }

struct Unit { const char* A; const char* B; char* out; int nt, ldc, flag, row0; };
__device__ __forceinline__ bool tile_order(int L, int nM, int nN, int& pm, int& pn) {
    const int nwg = nM * nN; if (L >= nwg || L < 0) return false;
    int wgid = L; { const int q = nwg / NXCD, r = nwg % NXCD, xcd = wgid % NXCD, off = wgid / NXCD; wgid = (xcd < r ? xcd * (q + 1) : r * (q + 1) + (xcd - r) * q) + off; }
    const int nig = WGM * nN, gid = wgid / nig, fm = gid * WGM, gsz = (nM - fm) < WGM ? (nM - fm) : WGM;
    pm = fm + ((wgid % nig) % gsz); pn = (wgid % nig) / gsz; return true;
}
struct SchedPlain {
    int G, c, nM, nN, ns, lda, ldb, ldc, nt, osz, gate_pn, lim; const char* A; const char* B; char* O; size_t osplit;
    __device__ __forceinline__ bool next(int i, Unit& u) const {
        int pm, pq; if (i * G + c >= lim || !tile_order(i * G + c, nM, nN * ns, pm, pq)) return false;
        const int pn = pq % nN, ks = pq / nN;
        u.A = A + ((size_t)pm * 256 * lda + (size_t)ks * nt * 64) * 2; u.B = B + ((size_t)pn * 256 * ldb + (size_t)ks * nt * 64) * 2;
        u.out = O + (size_t)ks * osplit + ((size_t)pm * 256 * ldc + (size_t)pn * 256) * osz; u.nt = nt; u.ldc = ldc; u.flag = (pn == gate_pn) ? 1 : 0; u.row0 = pm * 256; return true;
    }
};
struct EpiF32 {
    static constexpr bool PERM = false;
    __device__ __forceinline__ void operator()(const f32x4 (&acc)[2][2][4][2], const Unit& u, int wr, int wc, int fr, int fq) const {
        char* outp = u.out; asm volatile("" : "+v"(outp)); GAS float* C = (GAS float*)outp; int tl = threadIdx.x; asm volatile("" : "+v"(tl)); fr = tl & 15; fq = (tl >> 4) & 3; const int row0 = wr * 64 + fr; const int col0 = wc * 32 + 4 * fq;
#pragma unroll
        for (int ai = 0; ai < 2; ++ai)
#pragma unroll
            for (int m = 0; m < 4; ++m) { GAS float* rowp = C + (size_t)(row0 + ai * HALF + m * 16) * u.ldc + col0;
#pragma unroll
                for (int bj = 0; bj < 2; ++bj)
#pragma unroll
                    for (int n = 0; n < 2; ++n) *(GAS f32x4*)(rowp + bj * HALF + n * 16) = acc[ai][bj][m][n]; }
    }
};
template <int OFF> __device__ __forceinline__ void st16f_wt(GAS f32x4* p, const f32x4& v) { asm volatile("global_store_dwordx4 %0, %1, off offset:%2 sc1\n\ts_nop 1" :: "v"(p), "v"(v), "n"(OFF) : "memory"); }
template <int OFF> __device__ __forceinline__ void st16_wt(GAS u32x4* p, const u32x4& v) { asm volatile("global_store_dwordx4 %0, %1, off offset:%2 sc1\n\ts_nop 1" :: "v"(p), "v"(v), "n"(OFF) : "memory"); }
struct EpiBf16 {
    static constexpr bool PERM = true;
    float* gates;
    __device__ __forceinline__ void operator()(const f32x4 (&acc)[2][2][4][2], const Unit& u, int wr, int wc, int fr, int fq) const {
        int tl = threadIdx.x; asm volatile("" : "+v"(tl)); fr = tl & 15; fq = (tl >> 4) & 3; const int row0 = wr * 64 + fr; const int col0 = wc * 32 + 8 * fq;
        if (u.flag) {
            if (wc == 0) {
#pragma unroll
                for (int ai = 0; ai < 2; ++ai)
#pragma unroll
                    for (int m = 0; m < 4; ++m) { GAS float* gp = (GAS float*)gates + (size_t)(u.row0 + row0 + ai * HALF + m * 16) * 32 + 8 * fq;
                        st16f_wt<0>((GAS f32x4*)gp, acc[ai][0][m][0]); st16f_wt<16>((GAS f32x4*)gp, acc[ai][0][m][1]); }
            }
            return;
        }
        char* outp = u.out; asm volatile("" : "+v"(outp)); GAS bf16_t* O = (GAS bf16_t*)outp;
#pragma unroll
        for (int ai = 0; ai < 2; ++ai)
#pragma unroll
            for (int m = 0; m < 4; ++m) { GAS bf16_t* rowp = O + (size_t)(row0 + ai * HALF + m * 16) * u.ldc + col0;
#pragma unroll
                for (int bj = 0; bj < 2; ++bj) { const f32x4 v0 = acc[ai][bj][m][0], v1 = acc[ai][bj][m][1];
                    u32x4 w; w.x = cvt_pk_bf16(v0[0], v0[1]); w.y = cvt_pk_bf16(v0[2], v0[3]); w.z = cvt_pk_bf16(v1[0], v1[1]); w.w = cvt_pk_bf16(v1[2], v1[3]);
                    if (bj == 0) st16_wt<0>((GAS u32x4*)rowp, w); else st16_wt<HALF * 2>((GAS u32x4*)rowp, w); } }
    }
};

template <bool PERM>
__device__ __forceinline__ void prestage_B(LAS unsigned char* lds, const char* B, int ldb) {
    const int tid = threadIdx.x, wid = __builtin_amdgcn_readfirstlane(tid >> 6), lane = tid & 63;
    if (wid == 0 || B == nullptr) return;
    const size_t hstepB = (size_t)HALF * ldb * 2;
#pragma unroll 1
    for (int pass = 0; pass < (wid == 1 ? 2 : 1); ++pass) { const int vw = pass ? 0 : wid; const unsigned ldsw = (unsigned)vw * 1024u;
#pragma unroll
        for (int i = 0; i < 2; ++i) { int R, C; stage_rc((vw * 64 + lane) * 16 + i * 8192, R, C); const int Rb = PERM ? ((R & ~31) + perm32(R & 31)) : R;
            const char* src = B + (unsigned)(Rb * ldb + C) * 2u;
            __builtin_amdgcn_global_load_lds((const unsigned*)src, (LAS unsigned*)(lds + (4 + 0) * HTB + ldsw + i * 8192), 16, 0, 0);
            __builtin_amdgcn_global_load_lds((const unsigned*)(src + hstepB), (LAS unsigned*)(lds + (4 + 1) * HTB + ldsw + i * 8192), 16, 0, 0);
            __builtin_amdgcn_global_load_lds((const unsigned*)(src + BK * 2), (LAS unsigned*)(lds + (4 + 2) * HTB + ldsw + i * 8192), 16, 0, 0);
            __builtin_amdgcn_global_load_lds((const unsigned*)(src + hstepB + BK * 2), (LAS unsigned*)(lds + (4 + 3) * HTB + ldsw + i * 8192), 16, 0, 0); } }
}
template <class Epi, class Sched, bool PRE = false>
__device__ __forceinline__ void gemm_phase(LAS unsigned char* lds, int lda, int ldb, const Sched& S, const Epi& E) {
    const int tid = threadIdx.x, wid = __builtin_amdgcn_readfirstlane(tid >> 6), lane = tid & 63, wr = wid >> 2, wc = wid & 3, fr = lane & 15, fq = lane >> 4;
    unsigned voffA[2], voffB[2];
#pragma unroll
    for (int i = 0; i < 2; ++i) { int R, C; stage_rc(tid * 16 + i * 8192, R, C); const int Rb = Epi::PERM ? ((R & ~31) + perm32(R & 31)) : R;
        voffA[i] = (unsigned)(R * lda + C) * 2u; voffB[i] = (unsigned)(Rb * ldb + C) * 2u; }
    const size_t kstep = (size_t)(BK * 2);
    const size_t hstepA = (size_t)HALF * lda * 2, hstepB = (size_t)HALF * ldb * 2;
    const unsigned ldsw = (unsigned)wid * 1024u;
    const int aoff = lds_byte(wr * 64 + fr, fq * 8), boff = lds_byte(wc * 32 + fr, fq * 8);
#define PG8_SA(b, h) (((b) * 2 + (h)) * HTB)
#define PG8_SB(b, h) ((4 + (b) * 2 + (h)) * HTB)
#define PG8_STAGE(bufoff, gbase, voff) do { _Pragma("unroll") for (int _i = 0; _i < 2; ++_i) \
        __builtin_amdgcn_global_load_lds((const unsigned*)((const char*)(gbase) + (voff)[_i]), (LAS unsigned*)(lds + (bufoff) + ldsw + _i * 8192), 16, 0, 0); } while (0)
#define PG8_LDA(dst, b, h) do { _Pragma("unroll") for (int m = 0; m < 4; ++m) _Pragma("unroll") for (int k = 0; k < 2; ++k) dst[m][k] = *(const LAS bf16x8*)(lds + PG8_SA(b, h) + aoff + m * 2048 + k * 1024); } while (0)
#define PG8_LDB(dst, b, h) do { _Pragma("unroll") for (int n = 0; n < 2; ++n) _Pragma("unroll") for (int k = 0; k < 2; ++k) dst[n][k] = *(const LAS bf16x8*)(lds + PG8_SB(b, h) + boff + n * 2048 + k * 1024); } while (0)
#define PG8_MMA(ai, bj, At, Bt) do { __builtin_amdgcn_s_setprio(1); _Pragma("unroll") for (int m = 0; m < 4; ++m) _Pragma("unroll") for (int n = 0; n < 2; ++n) _Pragma("unroll") for (int k = 0; k < 2; ++k) \
        acc[ai][bj][m][n] = __builtin_amdgcn_mfma_f32_16x16x32_bf16(Bt[n][k], At[m][k], acc[ai][bj][m][n], 0, 0, 0); __builtin_amdgcn_s_setprio(0); } while (0)
#define PG8_WAIT_V(n) asm volatile("s_waitcnt vmcnt(" #n ")" ::: "memory")
#define PG8_WAIT_L(n) asm volatile("s_waitcnt lgkmcnt(" #n ")" ::: "memory")
#define PG8_BAR __builtin_amdgcn_s_barrier()
#define PG8_SCHED __builtin_amdgcn_sched_barrier(0)
    Unit cur, nxt; int ui = 0;
    if (!S.next(0, cur)) return;
    f32x4 acc[2][2][4][2];
#pragma unroll
    for (int a = 0; a < 2; ++a)
#pragma unroll
        for (int b = 0; b < 2; ++b)
#pragma unroll
            for (int m = 0; m < 4; ++m)
#pragma unroll
                for (int n = 0; n < 2; ++n) acc[a][b][m][n] = (f32x4){0.f, 0.f, 0.f, 0.f};
    bf16x8 At[4][2], B0[2][2], B1[2][2];
    const char* cA = cur.A; const char* cB = cur.B; int nt = cur.nt;
    if constexpr (PRE) {
        PG8_STAGE(PG8_SA(0, 0), cA, voffA); PG8_STAGE(PG8_SA(0, 1), cA + hstepA, voffA);
        if (wr == 1) PG8_BAR;
        PG8_WAIT_V(2); PG8_BAR;
        PG8_STAGE(PG8_SA(1, 0), cA + kstep, voffA);
        PG8_WAIT_V(2); PG8_BAR;
    } else {
    PG8_STAGE(PG8_SB(0, 0), cB, voffB); PG8_STAGE(PG8_SB(0, 1), cB + hstepB, voffB); PG8_STAGE(PG8_SA(0, 0), cA, voffA); PG8_STAGE(PG8_SA(0, 1), cA + hstepA, voffA);
    if (wr == 1) PG8_BAR;
    PG8_WAIT_V(2); PG8_BAR;
    PG8_STAGE(PG8_SB(1, 0), cB + kstep, voffB); PG8_STAGE(PG8_SA(1, 0), cA + kstep, voffA); PG8_STAGE(PG8_SB(1, 1), cB + hstepB + kstep, voffB);
    PG8_WAIT_V(6); PG8_BAR;
    }
    for (;;) {
        const bool has_next = S.next(ui + 1, nxt);
        const char* nA = has_next ? nxt.A : cA; const char* nB = has_next ? nxt.B : cB;
        for (int t = 0; t < nt; t += 2) {
            const bool last = (t == nt - 2);
            const char* a1 = cA + (size_t)(t + 1) * kstep;
            const char* a2 = last ? nA : cA + (size_t)(t + 2) * kstep; const char* b2 = last ? nB : cB + (size_t)(t + 2) * kstep;
            const char* a3 = a2 + kstep; const char* b3 = b2 + kstep;
            PG8_LDB(B0, 0, 0); PG8_LDB(B1, 0, 1); PG8_SCHED; PG8_LDA(At, 0, 0); PG8_STAGE(PG8_SA(1, 1), a1 + hstepA, voffA);
            PG8_WAIT_V(8); PG8_WAIT_L(0); PG8_BAR; PG8_MMA(0, 0, At, B0); PG8_MMA(0, 1, At, B1); PG8_BAR; PG8_SCHED;
            PG8_LDA(At, 0, 1); PG8_STAGE(PG8_SB(0, 0), b2, voffB); PG8_STAGE(PG8_SB(0, 1), b2 + hstepB, voffB); PG8_STAGE(PG8_SA(0, 0), a2, voffA);
            PG8_WAIT_V(8); PG8_WAIT_L(0); PG8_BAR; PG8_MMA(1, 0, At, B0); PG8_MMA(1, 1, At, B1); PG8_BAR; PG8_SCHED;
            PG8_LDB(B0, 1, 0); PG8_LDB(B1, 1, 1); PG8_SCHED; PG8_LDA(At, 1, 0); PG8_STAGE(PG8_SA(0, 1), a2 + hstepA, voffA);
            PG8_WAIT_V(8); PG8_WAIT_L(0); PG8_BAR; PG8_MMA(0, 0, At, B0); PG8_MMA(0, 1, At, B1); PG8_BAR; PG8_SCHED;
            PG8_LDA(At, 1, 1); PG8_STAGE(PG8_SB(1, 0), b3, voffB); PG8_STAGE(PG8_SB(1, 1), b3 + hstepB, voffB); PG8_STAGE(PG8_SA(1, 0), a3, voffA);
            PG8_WAIT_V(8); PG8_WAIT_L(0); PG8_BAR; PG8_MMA(1, 0, At, B0); PG8_MMA(1, 1, At, B1); PG8_BAR; PG8_SCHED;
        }
        if (wr == 0) PG8_BAR;
        E(acc, cur, wr, wc, fr, fq);
        if (!has_next) break;
#pragma unroll
        for (int a = 0; a < 2; ++a)
#pragma unroll
            for (int b = 0; b < 2; ++b)
#pragma unroll
                for (int m = 0; m < 4; ++m)
#pragma unroll
                    for (int n = 0; n < 2; ++n) acc[a][b][m][n] = (f32x4){0.f, 0.f, 0.f, 0.f};
        cur = nxt; cA = nA; cB = nB; nt = cur.nt; ++ui;
        if (wr == 1) PG8_BAR;
    }
    PG8_WAIT_V(0);
    PG8_BAR;
#undef PG8_SA
#undef PG8_SB
#undef PG8_STAGE
#undef PG8_LDA
#undef PG8_LDB
#undef PG8_MMA
#undef PG8_WAIT_V
#undef PG8_WAIT_L
#undef PG8_BAR
#undef PG8_SCHED
}
}

__device__ __forceinline__ void xcd_barrier_pre(const XcdBarrier& b, LAS unsigned char* lds, const char* B, int ldb, bool clean = false) {
    asm volatile("s_waitcnt vmcnt(0)" ::: "memory");
    __syncthreads();
    pg8::prestage_B<true>(lds, B, ldb);
    if (threadIdx.x == 0) {
        unsigned* bar = b.bar;
        __builtin_amdgcn_s_waitcnt(0);
        unsigned nloc = b.st[0], nx = b.st[1];
        if (nloc == 0u) { xcd_barrier_complete(bar, b.x, nloc, nx); b.st[0] = nloc; b.st[1] = nx; }
        const unsigned old = xb_add(&bar[XB_XSUB(b.x)], 1u);
        asm volatile("buffer_inv sc1" ::: "memory");
        const unsigned gen = old / nloc;
        if (old + 1u == (gen + 1u) * nloc) {
            if (!clean) __builtin_amdgcn_fence(__ATOMIC_RELEASE, "agent");
            asm volatile("s_waitcnt vmcnt(0)" ::: "memory");
            const unsigned og = xb_add(&bar[XB_TOP], 1u);
            const unsigned tg = og / nx;
            if (og + 1u == (tg + 1u) * nx) xb_add(&bar[XB_TOPGEN], 1u);
            else XB_SPIN(xb_ld(&bar[XB_TOPGEN]) == tg, bar);
            xb_add(&bar[XB_XGEN(b.x)], 1u);
            asm volatile("s_waitcnt vmcnt(0)" ::: "memory");
        } else {
            XB_SPIN(xb_ld(&bar[XB_XGEN(b.x)]) == gen, bar);
            asm volatile("s_waitcnt vmcnt(0)" ::: "memory");
        }
    }
    __syncthreads();
}
struct Args { const float* in[N_IN]; float* out; unsigned char* ws; int ph_lo, ph_hi; };
constexpr int PTR_OFF = MISC_OFF + 256;
struct Frame {
    float* out; unsigned char* ws; LAS unsigned char* lds;
    int tid, lane, wave, G, wg;
    __device__ __forceinline__ const float* inp(int i) const {
        const unsigned long long v = ((const LAS unsigned long long*)(lds + PTR_OFF))[i];
        const unsigned lo = __builtin_amdgcn_readfirstlane((unsigned)v), hi = __builtin_amdgcn_readfirstlane((unsigned)(v >> 32));
        return (const float*)(const __attribute__((address_space(1))) float*)(((unsigned long long)hi << 32) | lo); }
    __device__ __forceinline__ float* mod_() const { return (float*)(ws + WS_MOD); }
    __device__ __forceinline__ bf16_t* X_() const { return (bf16_t*)(ws + WS_X); }
    __device__ __forceinline__ bf16_t* H_() const { return (bf16_t*)(ws + WS_H); }
    __device__ __forceinline__ unsigned char* slab_() const { return ws + WS_SLAB; }
    __device__ __forceinline__ unsigned char* big_() const { return ws + WS_BIG; }
    __device__ __forceinline__ unsigned char* tab_() const { return ws + WS_TAB; }
    __device__ __forceinline__ unsigned char* wt_() const { return ws + WS_WT; }
};

typedef short bf16x8_t __attribute__((ext_vector_type(8)));
typedef short bf16x4_t __attribute__((ext_vector_type(4)));
__device__ __forceinline__ bf16x8_t frag_nat(const LAS bf16_t* base, int pitch, int row, int k0, int g) { return *(const LAS bf16x8_t*)(base + row * pitch + k0 + 8 * g); }
__device__ __forceinline__ bf16x8_t frag_perm(const LAS bf16_t* base, int pitch, int row, int kb, int g) {
    const bf16x4_t lo = *(const LAS bf16x4_t*)(base + row * pitch + kb + 4 * g), hi = *(const LAS bf16x4_t*)(base + row * pitch + kb + 16 + 4 * g);
    return __builtin_shufflevector(lo, hi, 0, 1, 2, 3, 4, 5, 6, 7);
}
__device__ __forceinline__ int rowp(int t, int r) { return 32 * (t >> 1) + 8 * (r >> 2) + 4 * (t & 1) + (r & 3); }
__device__ __forceinline__ bf16x8_t frag_sw(const LAS bf16_t* base, int pitch, int row, int kc, int g) { return *(const LAS bf16x8_t*)(base + row * pitch + (((kc + g) ^ (((row >> 4) & 1) << 2)) << 3)); }
__device__ __forceinline__ bf16x8_t pack_acc(const f32x4& a, const f32x4& b) {
    typedef unsigned u32x4_t __attribute__((ext_vector_type(4)));
    u32x4_t w; w.x = cvtpk(a[0], a[1]); w.y = cvtpk(a[2], a[3]); w.z = cvtpk(b[0], b[1]); w.w = cvtpk(b[2], b[3]);
    return __builtin_bit_cast(bf16x8_t, w);
}
#define MFMA16(a, b, c) __builtin_amdgcn_mfma_f32_16x16x32_bf16((a), (b), (c), 0, 0, 0)
__device__ __forceinline__ f32x4 up4(const u2v& u) { return (f32x4){__builtin_bit_cast(float, u.x << 16), __builtin_bit_cast(float, u.x & 0xffff0000u), __builtin_bit_cast(float, u.y << 16), __builtin_bit_cast(float, u.y & 0xffff0000u)}; }
__device__ __forceinline__ u2v pk4(const f32x4& v) { u2v o; o.x = cvtpk(v[0], v[1]); o.y = cvtpk(v[2], v[3]); return o; }

__device__ __forceinline__ const bf16_t* slab_ptr(Frame& F, int s) {
    return s < 2 ? (const bf16_t*)(F.slab_() + (size_t)s * SLAB_FULL) : (const bf16_t*)(F.slab_() + 2 * SLAB_FULL + (size_t)(s - 2) * SLAB_SMP) - (size_t)MCTX * D;
}
__device__ __forceinline__ void st4_wt(void* p, unsigned v) { asm volatile("global_store_dword %0, %1, off sc1" :: "v"((GAS void*)p), "v"(v) : "memory"); }
__device__ __forceinline__ void st16f_wt(void* p, const f32x4& v) { asm volatile("global_store_dwordx4 %0, %1, off sc1\n\ts_nop 1" :: "v"((GAS void*)p), "v"(v) : "memory"); }
__device__ __forceinline__ void st8_wt(void* p, const u2v& v) { asm volatile("global_store_dwordx2 %0, %1, off sc1" :: "v"((GAS void*)p), "v"(v) : "memory"); }
__device__ __forceinline__ void st16_wt(void* p, const u4v& v) { asm volatile("global_store_dwordx4 %0, %1, off sc1\n\ts_nop 1" :: "v"((GAS void*)p), "v"(v) : "memory"); }
__device__ __forceinline__ void p0_transpose_item(const float* W, int K, int N, bf16_t* WT, LAS float* scr, int item, int lane, bool up_il = false) {
    const int nblk = N / 32, kb = item / nblk, nb = item % nblk, k0 = 64 * kb, n0 = 32 * nb;
#pragma unroll
    for (int i = 0; i < 32; ++i) { const int kk = 2 * i + (lane >> 5); scr[kk * 33 + (lane & 31)] = W[(size_t)(k0 + kk) * N + n0 + (lane & 31)]; }
    asm volatile("s_waitcnt lgkmcnt(0)" ::: "memory");
    const int c = lane & 7;
#pragma unroll
    for (int j = 0; j < 4; ++j) { const int n = (lane >> 3) + 8 * j; const LAS float* s = scr + (8 * c) * 33 + n;
        u4v o; o.x = pk2(s[0 * 33], s[1 * 33]); o.y = pk2(s[2 * 33], s[3 * 33]); o.z = pk2(s[4 * 33], s[5 * 33]); o.w = pk2(s[6 * 33], s[7 * 33]);
        int orow = n0 + n; if (up_il) { const int gte = orow >= DFF ? 1 : 0, ch = orow - gte * DFF; orow = (ch >> 7) * 256 + gte * 128 + (ch & 127); }
        *(u4v*)(WT + (size_t)orow * K + k0 + 8 * c) = o; }
    asm volatile("s_waitcnt lgkmcnt(0)" ::: "memory");
}
__device__ __forceinline__ void ph_prologue(Frame& F) {
    const int lane = F.lane;
    const float* c_smp = F.inp(I_C); const float* c_ctx = F.inp(I_CCTX);
    for (int task = F.wg; task < 4 * 48; task += F.G) {
        const int l = task / 48, cc = task % 48, col = cc * 128 + lane * 2;
        const float* W = F.inp(I_WADA) + (size_t)l * D * 6144 + col;
        float acc[3][2] = {};
#pragma unroll 16
        for (int k = F.wave * 128; k < F.wave * 128 + 128; ++k) {
            const f32x2 w = *(const f32x2*)(W + (size_t)k * 6144);
            const float s0 = silu_f(c_ctx[k]), s1 = silu_f(c_smp[k]), s2 = silu_f(c_smp[D + k]);
            acc[0][0] += s0 * w[0]; acc[0][1] += s0 * w[1]; acc[1][0] += s1 * w[0]; acc[1][1] += s1 * w[1]; acc[2][0] += s2 * w[0]; acc[2][1] += s2 * w[1];
        }
        LAS float* red = (LAS float*)(F.lds + 8 * 8448);
        __syncthreads();
#pragma unroll
        for (int c = 0; c < 3; ++c) { red[(F.wave * 3 + c) * 128 + lane * 2] = acc[c][0]; red[(F.wave * 3 + c) * 128 + lane * 2 + 1] = acc[c][1]; }
        __syncthreads();
        if (F.tid < 384) { const int c = F.tid >> 7, j = F.tid & 127; float v = F.inp(I_BADA)[l * 6144 + cc * 128 + j];
#pragma unroll
            for (int w = 0; w < 8; ++w) v += red[(w * 3 + c) * 128 + j];
            F.mod_()[((size_t)l * 3 + c) * 6144 + cc * 128 + j] = v; }
    }
    {
        LAS float* scr = (LAS float*)(F.lds + F.wave * 8448);
        const int gw = F.wg * NWAVES + F.wave, NGW = F.G * NWAVES;
        constexpr int I_UP = 16 * 176, I_DNW = 44 * 32, I_FWT = 16 * 32, I_DIN = 16 * 129, I_MIN = 16 * 97;
        constexpr int NITEMS = 4 * I_UP + 4 * I_DNW + 2 * I_FWT + I_DIN + I_FWT + I_MIN + I_FWT;
        for (int it = gw; it < NITEMS; it += NGW) {
            int r = it;
            if (r < 4 * I_UP) { const int l = r / I_UP; p0_transpose_item(F.inp(I_WUP) + (size_t)l * D * NUP, D, NUP, (bf16_t*)(F.wt_() + WT_UP) + (size_t)l * NUP * D, scr, r % I_UP, lane, true); continue; } r -= 4 * I_UP;
            if (r < 4 * I_DNW) { const int l = r / I_DNW; p0_transpose_item(F.inp(I_WDN) + (size_t)l * DFF * D, DFF, D, (bf16_t*)(F.wt_() + WT_DN) + (size_t)l * D * DFF, scr, r % I_DNW, lane); continue; } r -= 4 * I_DNW;
            if (r < 2 * I_FWT) { const int j = r / I_FWT; p0_transpose_item(F.inp(I_FW) + (size_t)j * D * D, D, D, (bf16_t*)(F.wt_() + WT_F) + (size_t)j * D * D, scr, r % I_FWT, lane); continue; } r -= 2 * I_FWT;
            if (r < I_DIN) { p0_transpose_item(F.inp(I_DWIN), D, DN_PROJ, (bf16_t*)(F.wt_() + WT_DIN), scr, r, lane); continue; } r -= I_DIN;
            if (r < I_FWT) { p0_transpose_item(F.inp(I_DWOUT), D, D, (bf16_t*)(F.wt_() + WT_DOUT), scr, r, lane); continue; } r -= I_FWT;
            if (r < I_MIN) { p0_transpose_item(F.inp(I_MWIN), D, ML_PROJ, (bf16_t*)(F.wt_() + WT_MIN), scr, r, lane); continue; } r -= I_MIN;
            p0_transpose_item(F.inp(I_MWOUT), D, D, (bf16_t*)(F.wt_() + WT_MOUT), scr, r, lane);
        }
    }
    const int gt = F.wg * NTHR + F.tid, NGT = F.G * NTHR;
    bf16_t* cs256 = (bf16_t*)(F.tab_() + TAB_CS256); bf16_t* cst256 = (bf16_t*)(F.tab_() + TAB_CST256); bf16_t* cst1024 = (bf16_t*)(F.tab_() + TAB_CST1024);
    for (int i = gt; i < 256 * 256; i += NGT) { const int a = i >> 8, b = i & 255; const int m = (a * b) & 255; float s, c; sincospif(2.0f * (float)m / 256.0f, &s, &c);
        cs256[a * 256 + b] = (bf16_t)f2bf(c); cs256[(256 + a) * 256 + b] = (bf16_t)f2bf(s); cst256[a * 512 + b] = (bf16_t)f2bf(c); cst256[a * 512 + 256 + b] = (bf16_t)f2bf(-s); }
    for (int i = gt; i < 1024 * 1024; i += NGT) { const int a = i >> 10, b = i & 1023; const int m = (a * b) & 1023; float s, c; sincospif(2.0f * (float)m / 1024.0f, &s, &c);
        cst1024[a * 2048 + b] = (bf16_t)f2bf(c); cst1024[a * 2048 + 1024 + b] = (bf16_t)f2bf(-s); }
}
struct SchedWcs { int G, c, nun; const char* WT; const char* CS; char* O;
    __device__ __forceinline__ bool next(int i, pg8::Unit& u) const { const int L = i * G + c; if (L >= nun) return false;
        const int j = L >> 5, cs = (L >> 4) & 1, pm = (L >> 2) & 3, g = L & 3;
        u.A = WT + (size_t)j * D * D * 2 + ((size_t)pm * 256 * D + g * 256) * 2; u.B = CS + (size_t)cs * 256 * 256 * 2;
        u.out = O + (size_t)j * 2048 * D * 2 + ((size_t)(cs * 1024 + pm * 256) * D + g * 256) * 2; u.nt = 4; u.ldc = D; u.flag = 0; u.row0 = 0; return true; } };
__device__ __forceinline__ void ph_wcs(Frame& F) {
    int nun = 64; asm volatile("" : "+s"(nun));
    SchedWcs S{F.G, F.wg, nun, (const char*)(F.wt_() + WT_F), (const char*)(F.tab_() + TAB_CS256), (char*)(F.wt_() + WT_CS)};
    pg8::EpiBf16 E{nullptr};
    pg8::gemm_phase(F.lds, D, 256, S, E);
}

__device__ __forceinline__ void ph_norm(Frame& F, int pl, int pgj, const float* pbias, int nsc, int nss, float sc_ctx, float sc_smp, int nl, int nsh, const float* nw, bool first = false, int wg0 = 0) {
    const int gw = F.wg >= wg0 ? (F.wg - wg0) * NWAVES + F.wave : MTOT, NGW = (F.G - wg0) * NWAVES, lane = F.lane;
    const float* xin_p = F.inp(I_XP); const float* xin_s = F.inp(I_XS);
    const bf16_t* s0 = slab_ptr(F, 0); const bf16_t* s1 = slab_ptr(F, 1); const bf16_t* s2 = slab_ptr(F, 2); const bf16_t* s3 = slab_ptr(F, 3);
    auto ld4 = [](const bf16_t* p) { const u2v u = *(const u2v*)p; return (f32x4){__builtin_bit_cast(float, u.x << 16), __builtin_bit_cast(float, u.x & 0xffff0000u), __builtin_bit_cast(float, u.y << 16), __builtin_bit_cast(float, u.y & 0xffff0000u)}; };
    constexpr int RU = 3;
    for (int rb = gw; rb < MTOT; rb += RU * NGW) {
        f32x4 v[RU][4], sl[RU][4];
#pragma unroll
        for (int q = 0; q < RU; ++q) { const int row = rb + q * NGW; const bool ok = row < MTOT; const int ns = row < MCTX ? nsc : nss;
#pragma unroll
            for (int j = 0; j < 4; ++j) { const size_t o = (size_t)(ok ? row : 0) * D + 4 * lane + 256 * j;
                v[q][j] = first ? ((ok ? row : 0) < MCTX ? *(const f32x4*)(xin_p + o) : *(const f32x4*)(xin_s + o - (size_t)MCTX * D)) : ld4(F.X_() + o);
                if (pl >= 0) { f32x4 s = ld4(s0 + o);
                    if (ns > 1) s = s + ld4(s1 + o);
                    if (ns > 2) s = s + ld4(s2 + o) + ld4(s3 + o);
                    sl[q][j] = s; } } }
#pragma unroll
        for (int q = 0; q < RU; ++q) { const int row = rb + q * NGW; if (row >= MTOT) continue;
            const int cond = row_cond(row); const float scl = row < MCTX ? sc_ctx : sc_smp;
            float ss = 0.f;
#pragma unroll
            for (int j = 0; j < 4; ++j) { const int col = 4 * lane + 256 * j; const size_t o = (size_t)row * D + col;
                f32x4 x = v[q][j];
                if (pl >= 0) {
                    const f32x4 g = *(const f32x4*)(F.mod_() + ((size_t)pl * 3 + cond) * 6144 + pgj * D + col);
                    f32x4 s = sl[q][j] * scl;
                    if (pbias) s = s + *(const f32x4*)(pbias + col);
                    x = x + g * s;
                    st8_wt(F.X_() + o, pk4(x));
                }
                if (first) st8_wt(F.X_() + o, pk4(x));
                v[q][j] = x; ss += (x[0] * x[0] + x[1] * x[1]) + (x[2] * x[2] + x[3] * x[3]); }
            const float rstd = rsqrtf(wave_sum(ss) * (1.f / D) + EPS);
#pragma unroll
            for (int j = 0; j < 4; ++j) { const int col = 4 * lane + 256 * j;
                const f32x4 w = *(const f32x4*)(nw + col);
                f32x4 y = v[q][j] * rstd * w;
                if (nl >= 0) {
                    const float* m = F.mod_() + ((size_t)nl * 3 + cond) * 6144 + nsh * D + col;
                    const f32x4 sh = *(const f32x4*)m, sc = *(const f32x4*)(m + D);
                    y = y * (sc + 1.f) + sh;
                    u2v o; o.x = cvtpk(y[0], y[1]); o.y = cvtpk(y[2], y[3]);
                    st8_wt(F.H_() + (size_t)row * D + col, o);
                } else st16f_wt(F.out + O_Y + (size_t)row * D + col, y);
            }
        }
    }
}

__device__ __forceinline__ pg8::SchedPlain mk_plain(Frame& F, const void* A, int lda, const void* Bt, int ldb, int nN, int ns, int nt, void* O, int ldc, int osz, size_t osplit, int gate_pn) {
    pg8::SchedPlain S; S.G = F.G; S.c = F.wg; S.nM = 24; S.nN = nN; S.ns = ns; S.lda = lda; S.ldb = ldb; S.ldc = ldc; S.nt = nt; S.osz = osz; S.gate_pn = gate_pn;
    S.A = (const char*)A; S.B = (const char*)Bt; S.O = (char*)O; S.osplit = osplit; S.lim = 1 << 30; return S;
}
__device__ __forceinline__ void gemm64(Frame& F, const bf16_t* A, int lda, const bf16_t* Bt, int ldb, bf16_t* C, int ldc) {
    LAS bf16_t* LA = (LAS bf16_t*)F.lds; LAS bf16_t* LB = LA + 64 * 264;
    const int tid = F.tid, lane = F.lane, w = F.wave, r = lane & 15, g = lane >> 4, wr = w >> 1, wc = w & 1;
    u4v ra[4][4], rb[4][4];
#pragma unroll
    for (int kc = 0; kc < 4; ++kc)
#pragma unroll
        for (int i = 0; i < 4; ++i) { const int idx = tid + 512 * i, row = idx >> 5, pc = idx & 31;
            ra[kc][i] = *(const u4v*)(A + (size_t)row * lda + kc * 256 + pc * 8); rb[kc][i] = *(const u4v*)(Bt + (size_t)row * ldb + kc * 256 + pc * 8); }
    f32x4 acc0 = (f32x4){0.f, 0.f, 0.f, 0.f}, acc1 = (f32x4){0.f, 0.f, 0.f, 0.f};
#pragma unroll
    for (int kc = 0; kc < 4; ++kc) {
        __syncthreads();
#pragma unroll
        for (int i = 0; i < 4; ++i) { const int idx = tid + 512 * i, row = idx >> 5, pc = idx & 31; *(LAS u4v*)(LA + row * 264 + pc * 8) = ra[kc][i]; *(LAS u4v*)(LB + row * 264 + pc * 8) = rb[kc][i]; }
        __syncthreads();
#pragma unroll
        for (int kk = 0; kk < 8; ++kk) { const bf16x8_t a = frag_nat(LA, 264, 16 * wr + r, 32 * kk, g);
            acc0 = MFMA16(frag_nat(LB, 264, 32 * wc + r, 32 * kk, g), a, acc0); acc1 = MFMA16(frag_nat(LB, 264, 32 * wc + 16 + r, 32 * kk, g), a, acc1); }
    }
    bf16_t* cp = C + (size_t)(16 * wr + r) * ldc + 32 * wc + 4 * g;
    st8_wt(cp, pk4(acc0)); st8_wt(cp + 16, pk4(acc1));
    __syncthreads();
}
constexpr int XR_OFF = MISC_OFF + 1024;
struct SchedUp { int G, c, lim; const char* A; const char* B; char* UGp; char* ACTp;
    __device__ __forceinline__ bool next(int i, pg8::Unit& u) const { const int L = i * G + c; if (L >= lim) return false; int pm, pn;
        if (L < 352) pg8::tile_order(L, 16, 22, pm, pn); else { pg8::tile_order(L - 352, 8, 22, pm, pn); pm += 16; }
        u.A = A + (size_t)pm * 256 * D * 2; u.B = B + (size_t)pn * 256 * D * 2; u.nt = 16; u.row0 = pm * 256;
        if (pm < 16) { u.flag = 2 + pn * 4; u.out = ACTp + ((size_t)pm * 256 * DFF + pn * 128) * 2; u.ldc = DFF; }
        else { u.flag = 0; u.out = UGp + ((size_t)pm * 256 * NUP + pn * 128) * 2; u.ldc = NUP; }
        return true; } };
__device__ __forceinline__ float dpp_ror1(float v) { return __builtin_bit_cast(float, __builtin_amdgcn_update_dpp(0, __builtin_bit_cast(int, v), 0x121, 0xF, 0xF, false)); }
__device__ __forceinline__ float dpp_ror15(float v) { return __builtin_bit_cast(float, __builtin_amdgcn_update_dpp(0, __builtin_bit_cast(int, v), 0x12F, 0xF, 0xF, false)); }
struct EpiUp {
    static constexpr bool PERM = true;
    const float* cw; const float* cb; LAS unsigned char* lds;
    __device__ __forceinline__ void operator()(f32x4 (&acc)[2][2][4][2], const pg8::Unit& u, int wr, int wc, int fr, int fq) const {
        char* outp = u.out; asm volatile("" : "+v"(outp)); int tl = threadIdx.x; asm volatile("" : "+v"(tl)); fr = tl & 15; fq = (tl >> 4) & 3;
        const int row0 = wr * 64 + fr, col0 = wc * 32 + 8 * fq;
        GAS bf16_t* O = (GAS bf16_t*)outp;
        if ((u.flag & 3) == 0) {
#pragma unroll
            for (int ai = 0; ai < 2; ++ai)
#pragma unroll
                for (int m = 0; m < 4; ++m) { GAS bf16_t* rowp = O + (size_t)(row0 + ai * 128 + m * 16) * u.ldc + col0;
#pragma unroll
                    for (int bj = 0; bj < 2; ++bj) { const f32x4 v0 = acc[ai][bj][m][0], v1 = acc[ai][bj][m][1];
                        pg8::u32x4 w; w.x = cvtpk(v0[0], v0[1]); w.y = cvtpk(v0[2], v0[3]); w.z = cvtpk(v1[0], v1[1]); w.w = cvtpk(v1[2], v1[3]);
                        pg8::st16_wt<0>((GAS pg8::u32x4*)(rowp + bj * DFF), w); } }
            return;
        }
        const int pn = u.flag >> 2, ch0 = pn * 128 + col0;
        LAS float* XR = (LAS float*)(lds + XR_OFF);
#pragma unroll
        for (int ai = 0; ai < 2; ++ai) {
            if (fr == 0) { LAS float* p = XR + (((wr * 4 + wc) * 2 + ai) * 2 + 0) * 32 + 8 * fq; *(LAS f32x4*)p = acc[ai][1][0][0]; *(LAS f32x4*)(p + 4) = acc[ai][1][0][1]; }
            if (fr == 15) { LAS float* p = XR + (((wr * 4 + wc) * 2 + ai) * 2 + 1) * 32 + 8 * fq; *(LAS f32x4*)p = acc[ai][1][3][0]; *(LAS f32x4*)(p + 4) = acc[ai][1][3][1]; } }
        asm volatile("s_waitcnt lgkmcnt(0)" ::: "memory"); __builtin_amdgcn_s_barrier(); asm volatile("" ::: "memory");
#pragma unroll
        for (int ai = 0; ai < 2; ++ai) {
            const int wrp = 1 - wr, aip = wr ? ai : ai - 1, ain = wr ? ai + 1 : ai;
            f32x4 bp[2], bn[2];
#pragma unroll
            for (int n = 0; n < 2; ++n) {
                bp[n] = aip >= 0 ? *(const LAS f32x4*)(XR + (((wrp * 4 + wc) * 2 + aip) * 2 + 1) * 32 + 8 * fq + 4 * n) : (f32x4){0.f, 0.f, 0.f, 0.f};
                bn[n] = ain <= 1 ? *(const LAS f32x4*)(XR + (((wrp * 4 + wc) * 2 + ain) * 2 + 0) * 32 + 8 * fq + 4 * n) : (f32x4){0.f, 0.f, 0.f, 0.f}; }
#pragma unroll
            for (int n = 0; n < 2; ++n) {
                const f32x4 w0 = *(const f32x4*)(cw + 3 * DFF + ch0 + 4 * n), w1 = *(const f32x4*)(cw + 4 * DFF + ch0 + 4 * n), w2 = *(const f32x4*)(cw + 5 * DFF + ch0 + 4 * n), bb = *(const f32x4*)(cb + ch0 + 4 * n);
#pragma unroll
                for (int j = 0; j < 4; ++j) {
                    float R[4], L[4];
#pragma unroll
                    for (int m = 0; m < 4; ++m) { R[m] = dpp_ror1(acc[ai][1][m][n][j]); L[m] = dpp_ror15(acc[ai][1][m][n][j]); }
#pragma unroll
                    for (int m = 0; m < 4; ++m) {
                        const float prev = fr == 0 ? (m == 0 ? bp[n][j] : R[m - 1]) : R[m];
                        const float next = fr == 15 ? (m == 3 ? bn[n][j] : L[m + 1]) : L[m];
                        const float cv = w0[j] * prev + w1[j] * acc[ai][1][m][n][j] + w2[j] * next + bb[j];
                        acc[ai][0][m][n][j] = silu_f(cv) * acc[ai][0][m][n][j]; }
                } }
#pragma unroll
            for (int m = 0; m < 4; ++m) { const f32x4 v0 = acc[ai][0][m][0], v1 = acc[ai][0][m][1];
                pg8::u32x4 w; w.x = cvtpk(v0[0], v0[1]); w.y = cvtpk(v0[2], v0[3]); w.z = cvtpk(v1[0], v1[1]); w.w = cvtpk(v1[2], v1[3]);
                pg8::st16_wt<0>((GAS pg8::u32x4*)(O + (size_t)(row0 + ai * 128 + m * 16) * u.ldc + col0), w); }
        }
    }
};
__device__ __forceinline__ void ph_ffn_up(Frame& F, int l) {
    SchedUp S{F.G, F.wg, 2 * F.G, (const char*)F.H_(), (const char*)(F.wt_() + WT_UP + (size_t)l * NUP * D * 2), (char*)(F.big_() + BIG_UG), (char*)(F.big_() + BIG_ACT)};
    EpiUp E{F.inp(I_CW) + (size_t)l * 9 * DFF, F.inp(I_CB) + (size_t)l * DFF, F.lds};
    for (int sk = 0; sk < (int)((blockIdx.x >> 3) & 7); ++sk) __builtin_amdgcn_s_sleep(36);
    pg8::gemm_phase<EpiUp, SchedUp, true>(F.lds, D, D, S, E);
    const int ntail = 24 * 22 - 2 * F.G;
    for (int st = F.wg; st < ntail * 16; st += F.G) { int pm, pn; pg8::tile_order(2 * F.G + (st >> 4) - 352, 8, 22, pm, pn); pm += 16;
        const int r0 = pm * 256 + ((st >> 2) & 3) * 64, sn = st & 3, c0 = (sn >> 1) * DFF + pn * 128 + (sn & 1) * 64;
        gemm64(F, F.H_() + (size_t)r0 * D, D, (const bf16_t*)(F.wt_() + WT_UP + (size_t)l * NUP * D * 2) + (size_t)(pn * 256 + sn * 64) * D, D, (bf16_t*)(F.big_() + BIG_UG) + (size_t)r0 * NUP + c0, NUP); }
}
__device__ __forceinline__ const char* firstB_up(Frame& F, int l) { SchedUp S{F.G, F.wg, 2 * F.G, (const char*)F.H_(), (const char*)(F.wt_() + WT_UP + (size_t)l * NUP * D * 2), (char*)(F.big_() + BIG_UG), (char*)(F.big_() + BIG_ACT)}; pg8::Unit u; return S.next(0, u) ? u.B : nullptr; }
__device__ __forceinline__ void unpack8(const u4v& u, float (&f)[8]) {
#pragma unroll
    for (int i = 0; i < 4; ++i) { f[2 * i] = __builtin_bit_cast(float, u[i] << 16); f[2 * i + 1] = __builtin_bit_cast(float, u[i] & 0xffff0000u); }
}
struct ConvItem { u2v raw[3][6]; u2v ua[4]; f32x4 w[9]; f32x4 bias; };
__device__ __forceinline__ void conv_load(ConvItem& I, const bf16_t* UG, const float* cw, const float* cb, int c4, int row0, int gr, int gc0) {
    const bf16_t* gb = UG + DFF + 4 * c4;
#pragma unroll
    for (int di = -1; di <= 1; ++di) { const bool rok = gr + di >= 0 && gr + di < 16;
#pragma unroll
        for (int j = 0; j < 6; ++j) { const int col = gc0 + j - 1; const bool ok = rok && col >= 0 && col < 64;
            u2v u = *(const u2v*)(gb + (size_t)(ok ? row0 + di * 64 + j - 1 : row0) * NUP); if (!ok) u = (u2v){0u, 0u};
            I.raw[di + 1][j] = u; } }
#pragma unroll
    for (int it = 0; it < 4; ++it) I.ua[it] = *(const u2v*)(UG + (size_t)(row0 + it) * NUP + 4 * c4);
#pragma unroll
    for (int t = 0; t < 9; ++t) I.w[t] = *(const f32x4*)(cw + t * DFF + 4 * c4);
    I.bias = *(const f32x4*)(cb + 4 * c4);
}
__device__ __forceinline__ f32x4 unpack4(const u2v& u) { return (f32x4){__builtin_bit_cast(float, u.x << 16), __builtin_bit_cast(float, u.x & 0xffff0000u), __builtin_bit_cast(float, u.y << 16), __builtin_bit_cast(float, u.y & 0xffff0000u)}; }
__device__ __forceinline__ void conv_compute(const ConvItem& I, bf16_t* ACT, int c4, int row0) {
    f32x4 acc[4];
#pragma unroll
    for (int it = 0; it < 4; ++it) acc[it] = I.bias;
#pragma unroll
    for (int di = 0; di < 3; ++di)
#pragma unroll
        for (int j = 0; j < 6; ++j) { const f32x4 f = unpack4(I.raw[di][j]);
#pragma unroll
            for (int dj = -1; dj <= 1; ++dj) { const int it = j - 1 - dj; if (it >= 0 && it < 4) acc[it] = acc[it] + f * I.w[di * 3 + dj + 1]; } }
#pragma unroll
    for (int it = 0; it < 4; ++it) { const f32x4 a = unpack4(I.ua[it]); u2v o;
        o.x = cvtpk(silu_f(acc[it][0]) * a[0], silu_f(acc[it][1]) * a[1]); o.y = cvtpk(silu_f(acc[it][2]) * a[2], silu_f(acc[it][3]) * a[3]);
        st8_wt(ACT + (size_t)(row0 + it) * DFF + 4 * c4, o); }
}
__device__ __forceinline__ void ph_ffn_conv(Frame& F, int l) {
    const bf16_t* UG = (const bf16_t*)(F.big_() + BIG_UG); bf16_t* ACT = (bf16_t*)(F.big_() + BIG_ACT);
    const float* cw = F.inp(I_CW) + (size_t)l * 9 * DFF; const float* cb = F.inp(I_CB) + (size_t)l * DFF;
    const int tw = (F.wg * 8) & 1023, gr = tw >> 6, gcw = tw & 63, rowW = MCTX + F.wg * 8;
    const int i1 = F.tid + 512, i2 = F.tid + 1024;
    const int c0 = F.tid, h1 = i1 >= 704 ? 1 : 0, c1 = i1 - h1 * 704, c2 = i2 - 704;
    const bool v2 = F.wave < 6;
    ConvItem A, B;
    conv_load(A, UG, cw, cb, c0, rowW, gr, gcw);
    conv_load(B, UG, cw, cb, c1, rowW + 4 * h1, gr, gcw + 4 * h1);
    conv_compute(A, ACT, c0, rowW);
    if (v2) conv_load(A, UG, cw, cb, c2, rowW + 4, gr, gcw + 4);
    conv_compute(B, ACT, c1, rowW + 4 * h1);
    if (v2) conv_compute(A, ACT, c2, rowW + 4);
}
__device__ __forceinline__ void ph_gemm_slab(Frame& F, const bf16_t* A, int K, const void* WT) {
    pg8::SchedPlain S = mk_plain(F, A, K, WT, K, 4, 2, K / 128, F.slab_(), D, 2, SLAB_FULL, -1);
    pg8::EpiBf16 E{nullptr};
    pg8::gemm_phase<pg8::EpiBf16, pg8::SchedPlain, true>(F.lds, K, K, S, E);
}
__device__ __forceinline__ const char* firstB_slab(Frame& F, const bf16_t* A, int K, const void* WT) { pg8::SchedPlain S = mk_plain(F, A, K, WT, K, 4, 2, K / 128, F.slab_(), D, 2, SLAB_FULL, -1); pg8::Unit u; return S.next(0, u) ? u.B : nullptr; }

struct SchedF1 { int G, c; const char* A; const char* B; char* ZC; char* ZS;
    __device__ __forceinline__ bool next(int i, pg8::Unit& u) const { int pm, pn; if (!pg8::tile_order(i * G + c, 8, 24, pm, pn)) return false;
        u.A = A + (size_t)pm * 256 * D * 2; u.B = B + (size_t)pn * 256 * D * 2; u.nt = 16; u.flag = 0; u.row0 = 0;
        if (pn < 16) { u.out = ZC + (size_t)pn * 1024 * 512 * 2 + ((size_t)(pm & 3) * 256 * 512 + (pm >> 2) * 256) * 2; u.ldc = 512; }
        else { const int sq = (pn - 16) >> 2, tq = (pn - 16) & 3; u.out = ZS + (size_t)sq * 1024 * 2048 * 2 + ((size_t)(pm & 3) * 256 * 2048 + (pm >> 2) * 1024 + tq * 256) * 2; u.ldc = 2048; }
        return true; } };
__device__ __forceinline__ void ph_f1(Frame& F, int j) {
    SchedF1 S{F.G, F.wg, (const char*)(F.wt_() + WT_CS + (size_t)j * 2048 * D * 2), (const char*)F.H_(), (char*)(F.big_() + BIG_ZTC), (char*)(F.big_() + BIG_ZTS)};
    pg8::EpiBf16 E{nullptr};
    pg8::gemm_phase(F.lds, D, D, S, E);
}
struct SchedF2C { int G, c; const char* A; const char* B; char* O;
    __device__ __forceinline__ bool next(int i, pg8::Unit& u) const { const int L = i * G + c; if (L >= 64) return false; const int seq = L >> 2, pn = L & 3;
        u.A = A; u.B = B + (size_t)seq * 1024 * 512 * 2 + (size_t)pn * 256 * 512 * 2; u.out = O + ((size_t)seq * 256 * D + pn * 256) * 2; u.nt = 8; u.ldc = D; u.flag = 0; u.row0 = 0; return true; } };
struct SchedF2S { int G, c; const char* A; const char* B; char* O0; char* O2;
    __device__ __forceinline__ bool next(int i, pg8::Unit& u) const { const int L = i * G + c - 64; if (L < 0 || L >= 128) return false;
        const int ks = L & 3, r = L >> 2, seq = r >> 4, pm = (r >> 2) & 3, pn = r & 3;
        u.A = A + ((size_t)pm * 256 * 2048 + ks * 512) * 2; u.B = B + (size_t)seq * 1024 * 2048 * 2 + ((size_t)pn * 256 * 2048 + ks * 512) * 2;
        char* ob = ks < 2 ? O0 + (size_t)ks * SLAB_FULL + (size_t)MCTX * D * 2 : O2 + (size_t)(ks - 2) * SLAB_SMP;
        u.out = ob + ((size_t)(seq * 1024 + pm * 256) * D + pn * 256) * 2; u.nt = 8; u.ldc = D; u.flag = 0; u.row0 = 0; return true; } };
__device__ __forceinline__ void ph_f2(Frame& F) {
    pg8::EpiBf16 E{nullptr};
    { SchedF2C S{F.G, F.wg, (const char*)(F.tab_() + TAB_CST256), (const char*)(F.big_() + BIG_ZTC), (char*)F.slab_()}; pg8::gemm_phase(F.lds, 512, 512, S, E); }
    { SchedF2S S{F.G, F.wg, (const char*)(F.tab_() + TAB_CST1024), (const char*)(F.big_() + BIG_ZTS), (char*)F.slab_(), (char*)(F.slab_() + 2 * SLAB_FULL)}; pg8::gemm_phase(F.lds, 2048, 2048, S, E); }
}

struct SchedCols { int G, c, np, first, gate_p; const char* A; const char* B; char* O; int ldc;
    __device__ __forceinline__ bool next(int i, pg8::Unit& u) const { int pm, pp; if (c < 0 || !pg8::tile_order(i * G + c, 24, np, pm, pp)) return false;
        const int pn = (pp == gate_p) ? 12 : first + pp;
        u.A = A + (size_t)pm * 256 * D * 2; u.B = B + (size_t)pn * 256 * D * 2; u.out = O + ((size_t)pm * 256 * ldc + (size_t)pn * 256) * 2; u.nt = 16; u.ldc = ldc; u.flag = (pp == gate_p) ? 1 : 0; u.row0 = pm * 256; return true; } };
__device__ __forceinline__ void ph_proj(Frame& F, const void* WT, int nfull) {
    pg8::EpiBf16 E{(float*)(F.big_() + BIG_GATES)};
    if (nfull == 16) {
        pg8::SchedPlain S = mk_plain(F, F.H_(), D, WT, D, nfull + 1, 1, 16, F.big_() + BIG_PROJ, nfull * 256, 2, 0, nfull);
        pg8::gemm_phase<pg8::EpiBf16, pg8::SchedPlain, true>(F.lds, D, D, S, E);
    } else {
        SchedCols S{F.G, F.wg, 9, 0, 8, (const char*)F.H_(), (const char*)WT, (char*)(F.big_() + BIG_PROJ), nfull * 256};
        pg8::gemm_phase<pg8::EpiBf16, SchedCols, true>(F.lds, D, D, S, E);
    }
}
__device__ __forceinline__ const char* firstB_proj(Frame& F, const void* WT, int nfull) { pg8::Unit u;
    if (nfull == 16) { pg8::SchedPlain S = mk_plain(F, F.H_(), D, WT, D, nfull + 1, 1, 16, F.big_() + BIG_PROJ, nfull * 256, 2, 0, nfull); return S.next(0, u) ? u.B : nullptr; }
    SchedCols S{F.G, F.wg, 9, 0, 8, (const char*)F.H_(), (const char*)WT, (char*)(F.big_() + BIG_PROJ), nfull * 256}; return S.next(0, u) ? u.B : nullptr; }
__device__ __forceinline__ void ph_ml_ogate(Frame& F) {
    __syncthreads();
    SchedCols S{96, F.wg >= 160 ? F.wg - 160 : -1, 4, 8, -1, (const char*)F.H_(), (const char*)(F.wt_() + WT_MIN), (char*)(F.big_() + BIG_PROJ), 3072};
    pg8::EpiBf16 E{nullptr};
    pg8::gemm_phase<pg8::EpiBf16, SchedCols, true>(F.lds, D, D, S, E);
}
__device__ __forceinline__ const char* firstB_og(Frame& F) { pg8::Unit u;
    SchedCols S{96, F.wg >= 160 ? F.wg - 160 : -1, 4, 8, -1, (const char*)F.H_(), (const char*)(F.wt_() + WT_MIN), (char*)(F.big_() + BIG_PROJ), 3072}; return S.next(0, u) ? u.B : nullptr; }
__device__ __forceinline__ void chunk_pos(int ck, int& seq, int& t0, int& T) { if (ck < 64) { seq = ck >> 2; t0 = (ck & 3) * 64; T = 256; } else { const int u = ck - 64; seq = 16 + (u >> 4); t0 = (u & 15) * 64; T = 1024; } }

constexpr int DP_LQ = 0, DP_LK = 17408, DP_LQK = 34816, DP_LKK = 52224, DP_LKT = 69632, DP_LVT = 88064, DP_SC = 106496, DP_T = DP_LQK;
constexpr int DS_VEC_F = 192;
__device__ __forceinline__ void ph_dn_prep2(Frame& F) {
    const bf16_t* P = (const bf16_t*)(F.big_() + BIG_PROJ); const float* GT = (const float*)(F.big_() + BIG_GATES);
    LAS bf16_t* LQ = (LAS bf16_t*)(F.lds + DP_LQ); LAS bf16_t* LK = (LAS bf16_t*)(F.lds + DP_LK); LAS float* LQK = (LAS float*)(F.lds + DP_LQK); LAS float* LKK = (LAS float*)(F.lds + DP_LKK);
    LAS bf16_t* LKT = (LAS bf16_t*)(F.lds + DP_LKT); LAS bf16_t* LVT = (LAS bf16_t*)(F.lds + DP_LVT); LAS float* SC = (LAS float*)(F.lds + DP_SC);
    const int tid = F.tid, lane = F.lane, w = F.wave, r = lane & 15, g = lane >> 4;
    const float* cw = F.inp(I_DCW);
    unsigned xr[12][3];
    auto load_xr = [&](int task_) { const int ck_ = task_ >> 3, h_ = task_ & 7; int seq_, t0_, T_; chunk_pos(ck_, seq_, t0_, T_);
        unsigned rowv = (unsigned)(seq_row0(seq_) + t0_ + 8 * w - 2); asm volatile("" : "+v"(rowv));
#pragma unroll
        for (int rr = 0; rr < 12; ++rr) { const int tp = t0_ + 8 * w - 2 + rr; const bool ok = tp >= 0 && tp < T_;
#pragma unroll
            for (int wh = 0; wh < 3; ++wh) { xr[rr][wh] = 0u; if (ok) xr[rr][wh] = *(const unsigned*)(P + ((rowv + rr) * 4096u + (unsigned)(wh * 1024 + h_ * 128 + 2 * lane))); } } };
    if (F.wg < 96 * 8) load_xr(F.wg);
    for (int task = F.wg; task < 96 * 8; task += F.G) {
        const int ck = task >> 3, h = task & 7; int seq, t0, T; chunk_pos(ck, seq, t0, T); const int row0 = seq_row0(seq) + t0;
        __syncthreads();
        {
            float cwr[3][5][2];
#pragma unroll
            for (int wh = 0; wh < 3; ++wh)
#pragma unroll
                for (int j = 0; j < 5; ++j) { const f32x2 c = *(const f32x2*)(cw + j * 3072 + wh * 1024 + h * 128 + 2 * lane); cwr[wh][j][0] = c[0]; cwr[wh][j][1] = c[1]; }
            bf16_t* QSg = (bf16_t*)(F.big_() + BIG_QS) + (size_t)task * 64 * 128;
#pragma unroll
            for (int tt = 0; tt < 8; ++tt) { const int tk = 8 * w + tt;
                float val[3][2];
#pragma unroll
                for (int wh = 0; wh < 3; ++wh) { float a0 = 0.f, a1 = 0.f;
#pragma unroll
                    for (int j = 0; j < 5; ++j) { const unsigned x = xr[tt + j][wh]; a0 += bf2f(x & 0xffffu) * cwr[wh][j][0]; a1 += bf2f(x >> 16) * cwr[wh][j][1]; }
                    val[wh][0] = silu_f(a0); val[wh][1] = silu_f(a1); }
                const float qs = rsqrtf(wave_sum(val[0][0] * val[0][0] + val[0][1] * val[0][1]) + EPS) * 0.08838834764831845f;
                const float ks = rsqrtf(wave_sum(val[1][0] * val[1][0] + val[1][1] * val[1][1]) + EPS);
                const unsigned qp = cvtpk(val[0][0] * qs, val[0][1] * qs), kp = cvtpk(val[1][0] * ks, val[1][1] * ks), vp = cvtpk(val[2][0], val[2][1]);
                *(LAS unsigned*)(LQ + tk * 136 + 2 * lane) = qp; *(LAS unsigned*)(LK + tk * 136 + 2 * lane) = kp;
                *(unsigned*)(QSg + tk * 128 + 2 * lane) = qp;
                LKT[(2 * lane) * 72 + tk] = (bf16_t)(kp & 0xffffu); LKT[(2 * lane + 1) * 72 + tk] = (bf16_t)(kp >> 16);
                LVT[(2 * lane) * 72 + tk] = (bf16_t)(vp & 0xffffu); LVT[(2 * lane + 1) * 72 + tk] = (bf16_t)(vp >> 16);
            }
        }
        if (task + F.G < 96 * 8) load_xr(task + F.G);
        float gl_dir = 0.f;
        if (w < 2) { const int dir = w, c = dir ? 63 - lane : lane;
            const float graw = GT[(size_t)(row0 + c) * 32 + dir * 16 + h], braw = GT[(size_t)(row0 + c) * 32 + dir * 16 + 8 + h];
            float gsum = -expf(F.inp(I_DALOG)[dir * 8 + h]) * softplus_f(graw + F.inp(I_DDT)[dir * 8 + h]);
#pragma unroll
            for (int o = 1; o < 64; o <<= 1) { const float t = __shfl_up(gsum, o); if (lane >= o) gsum += t; }
            SC[dir * 64 + c] = gsum; SC[128 + dir * 64 + c] = sigmoid_f(braw);
            gl_dir = __shfl(gsum, 63);
        }
        __syncthreads();
        {
            const LAS bf16_t* Asrc = w < 4 ? LK : LQ; LAS float* Dst = w < 4 ? LKK : LQK; const int mi = w & 3;
            f32x4 acc[4];
#pragma unroll
            for (int ni = 0; ni < 4; ++ni) acc[ni] = (f32x4){0.f, 0.f, 0.f, 0.f};
#pragma unroll
            for (int kk = 0; kk < 4; ++kk) { const bf16x8_t a = frag_nat(Asrc, 136, 16 * mi + r, 32 * kk, g);
#pragma unroll
                for (int ni = 0; ni < 4; ++ni) acc[ni] = MFMA16(a, frag_nat(LK, 136, 16 * ni + r, 32 * kk, g), acc[ni]); }
#pragma unroll
            for (int ni = 0; ni < 4; ++ni)
#pragma unroll
                for (int i = 0; i < 4; ++i) Dst[(16 * mi + 4 * g + i) * 68 + 16 * ni + r] = acc[ni][i];
        }
        __syncthreads();
        {
            const size_t cd0 = (size_t)task * 2;
            bf16_t* QKMg = (bf16_t*)(F.big_() + BIG_QKM) + cd0 * 64 * 64;
#pragma unroll
            for (int it = 0; it < 4; ++it) { const int idx = tid + 512 * it, c = idx >> 5, s = (idx & 31) * 2;
                const float gFc = SC[c], gBc = SC[64 + c], bFc = SC[128 + c], bBc = SC[192 + c];
                float qf[2], qb[2];
#pragma unroll
                for (int e = 0; e < 2; ++e) { const int ss = s + e; const float qk = LQK[c * 68 + ss], kk = LKK[c * 68 + ss];
                    const float dF = __expf(gFc - SC[ss]), dB = __expf(gBc - SC[64 + ss]);
                    qf[e] = ss <= c ? qk * dF : 0.f; qb[e] = ss >= c ? qk * dB : 0.f;
                    LKK[c * 68 + ss] = ss < c ? bFc * kk * dF : (ss > c ? bBc * kk * dB : 0.f); }
                *(unsigned*)(QKMg + c * 64 + s) = pk2(qf[0], qf[1]); *(unsigned*)(QKMg + 4096 + c * 64 + s) = pk2(qb[0], qb[1]); }
            bf16_t* KTg = (bf16_t*)(F.big_() + BIG_KTG) + (size_t)task * 128 * 64;
#pragma unroll
            for (int it = 0; it < 2; ++it) { const int idx = tid + 512 * it, d = idx >> 3, c8 = (idx & 7) * 8; *(u4v*)(KTg + d * 64 + c8) = *(const LAS u4v*)(LKT + d * 72 + c8); }
            if (tid < 128) { const int dir = tid >> 6, c = tid & 63; float* VEC = (float*)(F.big_() + BIG_VEC) + (cd0 + dir) * DS_VEC_F;
                const float gc = SC[dir * 64 + c], gl = SC[dir * 64 + (dir ? 0 : 63)];
                VEC[c] = __expf(gc); VEC[64 + c] = __expf(gl - gc); if (c == 0) VEC[128] = __expf(gl); }
        }
        __syncthreads();
#pragma unroll
        for (int it = 0; it < 8; ++it) { const int idx = tid + 512 * it, p = idx >> 6, pj = idx & 63; LQK[p * 68 + pj] = LKK[(63 - p) * 68 + 63 - pj]; }
        __syncthreads();
        {
            LAS float* TF0 = (LAS float*)(F.lds + DP_LQ); LAS float* XS = (LAS float*)(F.lds + DP_SC + 1024) + w * 272;
            unsigned lofs = 0u; asm volatile("" : "+v"(lofs));
            const LAS float* Lf = (const LAS float*)(F.lds + DP_LKK + lofs); const LAS float* Lb = (const LAS float*)(F.lds + DP_LQK + lofs);
            const int lr = lane & 15, lg = lane >> 4;
            { const int dir = w >> 2, bi = w & 3; const LAS float* Ls = (dir ? Lb : Lf) + (16 * bi) * 68 + 16 * bi; LAS float* Td = TF0 + dir * 64 * 68 + (16 * bi) * 68 + 16 * bi + lofs;
                float Tr[16];
#pragma unroll
                for (int p = 0; p < 16; ++p) { float a0 = (p == lr) ? 1.f : 0.f;
#pragma unroll
                    for (int pj = 0; pj < p; ++pj) a0 -= Ls[p * 68 + pj] * Tr[pj];
                    Tr[p] = a0; }
                if (lane < 16) {
#pragma unroll
                    for (int p = 0; p < 16; ++p) Td[p * 68 + lr] = Tr[p]; } }
            __syncthreads();
#define MM16(acc, Ap, pa, Bp, pb) do { _Pragma("unroll") for (int s_ = 0; s_ < 4; ++s_) acc = __builtin_amdgcn_mfma_f32_16x16x4f32((Ap)[lr * (pa) + 4 * s_ + lg], (Bp)[(4 * s_ + lg) * (pb) + lr], acc, 0, 0, 0); } while (0)
#pragma unroll
            for (int lev = 1; lev < 4; ++lev) {
                const int ntask = 2 * (4 - lev);
                if (w < ntask) { const int dir = w / (4 - lev), bi = lev + w % (4 - lev), bj = bi - lev;
                    const LAS float* Ls = dir ? Lb : Lf; LAS float* Tf = TF0 + dir * 64 * 68 + lofs;
                    f32x4 x = (f32x4){0.f, 0.f, 0.f, 0.f};
#pragma unroll
                    for (int d = 0; d < 3; ++d) if (d < lev) { const int bk = bj + d;
                        MM16(x, Ls + (16 * bi) * 68 + 16 * bk, 68, Tf + (16 * bk) * 68 + 16 * bj, 68); }
#pragma unroll
                    for (int rr = 0; rr < 4; ++rr) XS[(4 * lg + rr) * 17 + lr] = x[rr];
                    f32x4 t = (f32x4){0.f, 0.f, 0.f, 0.f};
                    MM16(t, Tf + (16 * bi) * 68 + 16 * bi, 68, XS, 17);
#pragma unroll
                    for (int rr = 0; rr < 4; ++rr) Tf[(16 * bi + 4 * lg + rr) * 68 + 16 * bj + lr] = -t[rr]; }
                __syncthreads();
            }
#undef MM16
            LAS bf16_t* Tb = (LAS bf16_t*)(F.lds + DP_T);
#pragma unroll
            for (int it = 0; it < 8; ++it) { const int idx = tid + 512 * it, dir = idx >> 11, p = (idx >> 5) & 63, pj = (idx & 31) * 2;
                const f32x2 tv = *(const LAS f32x2*)(TF0 + dir * 64 * 68 + p * 68 + pj);
                const int c = dir ? 63 - p : p, s0 = dir ? 63 - pj : pj, s1 = dir ? 62 - pj : pj + 1;
                const float t0 = (pj >> 4) <= (p >> 4) ? tv[0] : 0.f, t1 = ((pj + 1) >> 4) <= (p >> 4) ? tv[1] : 0.f;
                const float b0 = SC[128 + dir * 64 + s0], b1 = SC[128 + dir * 64 + s1], e0 = b0 * __expf(SC[dir * 64 + s0]), e1 = b1 * __expf(SC[dir * 64 + s1]);
                LAS bf16_t* T1 = Tb + dir * 2 * 4096; LAS bf16_t* T2 = T1 + 4096;
                T1[c * 64 + s0] = (bf16_t)f2bf(t0 * b0); T1[c * 64 + s1] = (bf16_t)f2bf(t1 * b1); T2[c * 64 + s0] = (bf16_t)f2bf(t0 * e0); T2[c * 64 + s1] = (bf16_t)f2bf(t1 * e1); }
        }
        __syncthreads();
#pragma unroll
        for (int dir = 0; dir < 2; ++dir) { const size_t cd = (size_t)task * 2 + dir;
            const LAS bf16_t* T1 = (const LAS bf16_t*)(F.lds + DP_T) + dir * 2 * 4096; const LAS bf16_t* T2 = T1 + 4096;
            bf16_t* Ug = (bf16_t*)(F.big_() + BIG_U) + cd * 8192 + (size_t)w * 1024; bf16_t* WNg = (bf16_t*)(F.big_() + BIG_WN) + cd * 8192;
#pragma unroll
            for (int m = 0; m < 4; ++m) { f32x4 au = (f32x4){0.f, 0.f, 0.f, 0.f}, aw = (f32x4){0.f, 0.f, 0.f, 0.f};
#pragma unroll
                for (int kk = 0; kk < 2; ++kk) {
                    au = MFMA16(frag_nat(T1, 64, rowp(m, r), 32 * kk, g), frag_nat(LVT, 72, 16 * w + r, 32 * kk, g), au);
                    aw = MFMA16(frag_nat(LKT, 72, 16 * w + r, 32 * kk, g), frag_nat(T2, 64, 16 * m + r, 32 * kk, g), aw); }
                *(u2v*)(Ug + m * 256 + lane * 4) = pk4(au);
                u2v o; o.x = pk2(-aw[0], -aw[1]); o.y = pk2(-aw[2], -aw[3]);
                *(u2v*)(WNg + (16 * m + r) * 128 + 16 * w + 4 * g) = o; }
        }
    }
}

constexpr int DS_LWN = 0, DS_LQS = 17408, DS_LQKM = 34816, DS_LKT = 44032, DS_LVEC = 62464;
__device__ __forceinline__ void dn_scan_seq(Frame& F, int seq, int h, int dir, int esl0, int nact) {
    LAS bf16_t* LWN = (LAS bf16_t*)(F.lds + DS_LWN); LAS bf16_t* LQS = (LAS bf16_t*)(F.lds + DS_LQS); LAS bf16_t* LQKM = (LAS bf16_t*)(F.lds + DS_LQKM); LAS bf16_t* LKT = (LAS bf16_t*)(F.lds + DS_LKT);
    LAS float* LVEC = (LAS float*)(F.lds + DS_LVEC);
    const int tid = F.tid, lane = F.lane, w = F.wave, r = lane & 15, g = lane >> 4, ws = esl0 + (w < nact ? w : 0); const bool act = w < nact;
    const int NC = seq < 16 ? 4 : 16, ck0 = seq < 16 ? seq * 4 : 64 + (seq - 16) * 16, rowS = seq_row0(seq);
    bf16_t* O = (bf16_t*)(F.slab_() + (dir ? SLAB_FULL : 0));
    f32x4 Sacc[8];
    if (seq >= 16) { const float* s0 = F.inp(I_SD) + ((size_t)((seq - 16) * 2 + dir) * 8 + h) * 16384 + 16 * ws + r;
#pragma unroll
        for (int j = 0; j < 8; ++j)
#pragma unroll
            for (int i = 0; i < 4; ++i) Sacc[j][i] = s0[(32 * (j >> 1) + 8 * g + 4 * (j & 1) + i) * 128]; }
    else {
#pragma unroll
        for (int j = 0; j < 8; ++j) Sacc[j] = (f32x4){0.f, 0.f, 0.f, 0.f}; }
    struct DStage { u4v wn[2], qs[2], qkm, kt[2]; f32x4 vec; u2v U[4]; };
    constexpr int PD = 1;
    DStage st[PD];
#define DS_LOAD(S, n) do { const int ckn = ck0 + (dir ? NC - 1 - (n) : (n)); const size_t tk = (size_t)ckn * 8 + h, cd = tk * 2 + dir; \
        const u4v* gWN = (const u4v*)((const bf16_t*)(F.big_() + BIG_WN) + cd * 8192); const u4v* gQS = (const u4v*)((const bf16_t*)(F.big_() + BIG_QS) + tk * 8192); \
        const u4v* gQKM = (const u4v*)((const bf16_t*)(F.big_() + BIG_QKM) + cd * 4096); const u4v* gKT = (const u4v*)((const bf16_t*)(F.big_() + BIG_KTG) + tk * 8192); \
        S.wn[0] = gWN[tid]; S.wn[1] = gWN[tid + 512]; S.qs[0] = gQS[tid]; S.qs[1] = gQS[tid + 512]; S.qkm = gQKM[tid]; S.kt[0] = gKT[tid]; S.kt[1] = gKT[tid + 512]; \
        S.vec = (f32x4){0.f, 0.f, 0.f, 0.f}; if (tid < 48) S.vec = *(const f32x4*)((const float*)(F.big_() + BIG_VEC) + cd * DS_VEC_F + tid * 4); \
        const bf16_t* gU = (const bf16_t*)(F.big_() + BIG_U) + cd * 8192 + (size_t)ws * 1024 + lane * 4; \
        _Pragma("unroll") for (int m = 0; m < 4; ++m) S.U[m] = *(const u2v*)(gU + m * 256); } while (0)
#pragma unroll
    for (int k = 0; k < PD; ++k) DS_LOAD(st[k], k);
    for (int n0 = 0; n0 < NC; n0 += PD) {
#pragma unroll
      for (int k = 0; k < PD; ++k) { const int n = n0 + k;
        __syncthreads();
#pragma unroll
        for (int i = 0; i < 2; ++i) { const int idx = tid + 512 * i;
            const int r16 = idx >> 4, c16 = (idx & 15) ^ (((r16 >> 4) & 1) << 2), r8 = idx >> 3, c8 = (idx & 7) ^ (((r8 >> 4) & 1) << 2);
            *(LAS u4v*)(LWN + r16 * 136 + c16 * 8) = st[k].wn[i]; *(LAS u4v*)(LQS + r16 * 136 + c16 * 8) = st[k].qs[i];
            *(LAS u4v*)(LKT + r8 * 72 + c8 * 8) = st[k].kt[i]; }
        { const int r8 = tid >> 3, c8 = (tid & 7) ^ (((r8 >> 4) & 1) << 2); *(LAS u4v*)(LQKM + r8 * 72 + c8 * 8) = st[k].qkm; }
        if (tid < 48) *(LAS f32x4*)(LVEC + tid * 4) = st[k].vec;
        f32x4 vn[4];
#pragma unroll
        for (int m = 0; m < 4; ++m) vn[m] = up4(st[k].U[m]);
        const int ckc = ck0 + (dir ? NC - 1 - n : n);
        __syncthreads();
        if (n + PD < NC) DS_LOAD(st[k], n + PD);
        if (act) {
        bf16x8_t Sb[4];
#pragma unroll
        for (int kk = 0; kk < 4; ++kk) Sb[kk] = pack_acc(Sacc[2 * kk], Sacc[2 * kk + 1]);
        f32x4 o[4];
#pragma unroll
        for (int m = 0; m < 4; ++m) { o[m] = (f32x4){0.f, 0.f, 0.f, 0.f};
#pragma unroll
            for (int kk = 0; kk < 4; ++kk) { vn[m] = MFMA16(frag_sw(LWN, 136, rowp(m, r), 4 * kk, g), Sb[kk], vn[m]); o[m] = MFMA16(frag_sw(LQS, 136, rowp(m, r), 4 * kk, g), Sb[kk], o[m]); }
            o[m] = o[m] * *(const LAS f32x4*)(LVEC + 32 * (m >> 1) + 8 * g + 4 * (m & 1)); }
        bf16x8_t vb[2], vs[2];
#pragma unroll
        for (int k2 = 0; k2 < 2; ++k2) { vb[k2] = pack_acc(vn[2 * k2], vn[2 * k2 + 1]);
            const f32x4 e0 = *(const LAS f32x4*)(LVEC + 64 + 32 * k2 + 8 * g), e1 = *(const LAS f32x4*)(LVEC + 64 + 32 * k2 + 8 * g + 4);
            vs[k2] = pack_acc(vn[2 * k2] * e0, vn[2 * k2 + 1] * e1); }
#pragma unroll
        for (int m = 0; m < 4; ++m) {
#pragma unroll
            for (int k2 = 0; k2 < 2; ++k2) o[m] = MFMA16(frag_sw(LQKM, 72, rowp(m, r), 4 * k2, g), vb[k2], o[m]);
            bf16_t* op = O + (size_t)(rowS + (ckc - ck0) * 64 + 32 * (m >> 1) + 8 * g + 4 * (m & 1)) * D + h * 128 + 16 * ws + r;
            const unsigned p01 = cvtpk(o[m][0], o[m][1]), p23 = cvtpk(o[m][2], o[m][3]);
            op[0] = (bf16_t)p01; op[(size_t)D] = (bf16_t)(p01 >> 16); op[(size_t)2 * D] = (bf16_t)p23; op[(size_t)3 * D] = (bf16_t)(p23 >> 16); }
        const float egl = LVEC[128];
#pragma unroll
        for (int j = 0; j < 8; ++j) { Sacc[j] = Sacc[j] * egl;
#pragma unroll
            for (int k2 = 0; k2 < 2; ++k2) Sacc[j] = MFMA16(frag_sw(LKT, 72, rowp(j, r), 4 * k2, g), vs[k2], Sacc[j]); }
        }
      }
    }
#undef DS_LOAD
    if (seq < 16 && act) { float* nd = F.out + O_ND + ((size_t)(seq * 2 + dir) * 8 + h) * 16384 + 16 * ws + r;
#pragma unroll
        for (int j = 0; j < 8; ++j)
#pragma unroll
            for (int i = 0; i < 4; ++i) nd[(32 * (j >> 1) + 8 * g + 4 * (j & 1) + i) * 128] = Sacc[j][i]; }
}
__device__ __forceinline__ bool scan_slot(int wg, int rnd, int& seq, int& h, int& dir, int& esl0, int& nact) {
    int id;
    if (wg < 64) { if (rnd) return false; id = wg >> 1; esl0 = (wg & 1) * 4; nact = 4; seq = 16 + id / 16; }
    else { id = (wg - 64) + rnd * 192; if (id >= 256) return false; esl0 = 0; nact = 8; seq = id / 16; }
    h = (id >> 1) & 7; dir = id & 1; return true;
}
__device__ __forceinline__ void ph_dn_scan2(Frame& F) {
    for (int rnd = 0; rnd < 2; ++rnd) { int seq, h, dir, esl0, nact; if (!scan_slot(F.wg, rnd, seq, h, dir, esl0, nact)) break; dn_scan_seq(F, seq, h, dir, esl0, nact); }
}
constexpr size_t BIG_MINTRA = BIG_WN;
constexpr size_t BIG_MU = BIG_MINTRA + (size_t)1536 * 8192 * 4;
constexpr size_t BIG_MVEC = BIG_MU + (size_t)1536 * 8192 * 4;
constexpr size_t BIG_MQS = BIG_MVEC + (size_t)1536 * 272 * 4;
static_assert(BIG_MQS + (size_t)768 * 4096 * 2 <= BIG_END, "mLSTM buffers exceed the big region");
constexpr int MP_LQ = 0, MP_LK = 9216, MP_LKT = 18432, MP_LVT = 27648, MP_LQK = 46080, MP_LPM = 63488, MP_LKW = 81920, MP_SC = 100352;
__device__ __forceinline__ void ph_ml_prep(Frame& F) {
    const bf16_t* P = (const bf16_t*)(F.big_() + BIG_PROJ); const float* GT = (const float*)(F.big_() + BIG_GATES);
    LAS bf16_t* LQ = (LAS bf16_t*)(F.lds + MP_LQ); LAS bf16_t* LK = (LAS bf16_t*)(F.lds + MP_LK); LAS bf16_t* LKT = (LAS bf16_t*)(F.lds + MP_LKT); LAS bf16_t* LVT = (LAS bf16_t*)(F.lds + MP_LVT);
    LAS float* LQK = (LAS float*)(F.lds + MP_LQK); LAS bf16_t* LPM = (LAS bf16_t*)(F.lds + MP_LPM); LAS bf16_t* LKW = (LAS bf16_t*)(F.lds + MP_LKW);
    LAS float* SC = (LAS float*)(F.lds + MP_SC);
    const int tid = F.tid, lane = F.lane, w = F.wave, r = lane & 15, g = lane >> 4;
    unsigned xqk[8], xvv[8];
    auto load_x = [&](int task_) { const int ck_ = task_ >> 3, h_ = task_ & 7; int seq_, t0_, T_; chunk_pos(ck_, seq_, t0_, T_);
        unsigned rowv = (unsigned)(seq_row0(seq_) + t0_ + 8 * w); asm volatile("" : "+v"(rowv));
#pragma unroll
        for (int tt = 0; tt < 8; ++tt) {
            xqk[tt] = *(const unsigned*)(P + ((rowv + tt) * 3072u + (unsigned)((lane < 32 ? 0 : 512) + h_ * 64 + (lane & 31) * 2)));
            xvv[tt] = *(const unsigned*)(P + ((rowv + tt) * 3072u + (unsigned)(1024 + h_ * 128 + 2 * lane))); } };
    if (F.wg < 96 * 8) load_x(F.wg);
    for (int task = F.wg; task < 96 * 8; task += F.G) {
        const int ck = task >> 3, h = task & 7; int seq, t0, T; chunk_pos(ck, seq, t0, T); const int row0 = seq_row0(seq) + t0;
        __syncthreads();
        {
            bf16_t* QSg = (bf16_t*)(F.big_() + BIG_MQS) + (size_t)task * 4096;
#pragma unroll
            for (int tt = 0; tt < 8; ++tt) { const int tk = 8 * w + tt;
                const int l2 = (lane & 31) * 2;
                const unsigned qk = xqk[tt], vv = xvv[tt];
                if (lane < 32) { const unsigned qs = pk2(bf2f(qk & 0xffffu) * 0.125f, bf2f(qk >> 16) * 0.125f); *(LAS unsigned*)(LQ + tk * 72 + l2) = qs; *(unsigned*)(QSg + tk * 64 + l2) = qs; }
                else { *(LAS unsigned*)(LK + tk * 72 + l2) = qk; LKT[l2 * 72 + tk] = (bf16_t)(qk & 0xffffu); LKT[(l2 + 1) * 72 + tk] = (bf16_t)(qk >> 16); }
                LVT[(2 * lane) * 72 + tk] = (bf16_t)(vv & 0xffffu); LVT[(2 * lane + 1) * 72 + tk] = (bf16_t)(vv >> 16);
            }
        }
        if (task + F.G < 96 * 8) load_x(task + F.G);
        if (w < 2) { const int dir = w, c = dir ? 63 - lane : lane;
            const float li = GT[(size_t)(row0 + c) * 32 + dir * 16 + h] + F.inp(I_MBI)[dir * 8 + h];
            float bc = logsigmoid_f(GT[(size_t)(row0 + c) * 32 + dir * 16 + 8 + h] + F.inp(I_MBF)[dir * 8 + h]);
#pragma unroll
            for (int o = 1; o < 64; o <<= 1) { const float t = __shfl_up(bc, o); if (lane >= o) bc += t; }
            const float a = li - bc; float am = a;
#pragma unroll
            for (int o = 1; o < 64; o <<= 1) { const float t = __shfl_up(am, o); if (lane >= o) am = fmaxf(am, t); }
            SC[dir * 256 + c] = bc; SC[dir * 256 + 64 + c] = a; SC[dir * 256 + 128 + c] = am;
            if (lane == 63) { SC[512 + dir * 2] = bc; SC[512 + dir * 2 + 1] = am; }
        }
        __syncthreads();
        {
            const int mi = w >> 1;
            f32x4 acc[2] = {(f32x4){0.f, 0.f, 0.f, 0.f}, (f32x4){0.f, 0.f, 0.f, 0.f}};
#pragma unroll
            for (int kk = 0; kk < 2; ++kk) { const bf16x8_t a = frag_nat(LQ, 72, 16 * mi + r, 32 * kk, g);
#pragma unroll
                for (int nn = 0; nn < 2; ++nn) acc[nn] = MFMA16(a, frag_nat(LK, 72, 16 * (2 * (w & 1) + nn) + r, 32 * kk, g), acc[nn]); }
#pragma unroll
            for (int nn = 0; nn < 2; ++nn)
#pragma unroll
                for (int i = 0; i < 4; ++i) LQK[(16 * mi + 4 * g + i) * 68 + 16 * (2 * (w & 1) + nn) + r] = acc[nn][i];
        }
        __syncthreads();
        {
            const size_t cd0 = (size_t)task * 2;
#pragma unroll
            for (int it = 0; it < 4; ++it) { const int idx = tid + 512 * it, c = idx >> 5, s = (idx & 31) * 2;
#pragma unroll
                for (int dir = 0; dir < 2; ++dir) { const LAS float* sc = SC + dir * 256;
                    const float amc = sc[128 + c], amL = SC[512 + dir * 2 + 1];
                    float pm[2], kw[2];
#pragma unroll
                    for (int e = 0; e < 2; ++e) { const int ss = s + e; const bool ok = dir ? ss >= c : ss <= c;
                        pm[e] = ok ? LQK[c * 68 + ss] * __expf(sc[64 + ss] - amc) : 0.f;
                        kw[e] = bf2f(LKT[c * 72 + ss]) * __expf(sc[64 + ss] - amL); }
                    *(LAS unsigned*)(LPM + dir * 64 * 72 + c * 72 + s) = pk2(pm[0], pm[1]); *(LAS unsigned*)(LKW + dir * 64 * 72 + c * 72 + s) = pk2(kw[0], kw[1]);
                    float ps = pm[0] + pm[1], ks = kw[0] + kw[1];
#pragma unroll
                    for (int o = 1; o < 32; o <<= 1) { ps += __shfl_xor(ps, o); ks += __shfl_xor(ks, o); }
                    if ((lane & 31) == 0) { float* VEC = (float*)(F.big_() + BIG_MVEC) + (cd0 + dir) * 272; VEC[128 + (c & 15) * 4 + (c >> 4)] = ps; VEC[192 + c] = ks; }
                } }
            if (tid < 128) { const int dir = tid >> 6, c = tid & 63; float* VEC = (float*)(F.big_() + BIG_MVEC) + (cd0 + dir) * 272; const LAS float* sc = SC + dir * 256;
                VEC[(c & 15) * 4 + (c >> 4)] = sc[c]; VEC[64 + (c & 15) * 4 + (c >> 4)] = sc[c] + sc[128 + c];
                if (c == 0) { const float bl = SC[512 + dir * 2]; VEC[256] = bl; VEC[257] = bl + SC[512 + dir * 2 + 1]; } }
        }
        __syncthreads();
#pragma unroll
        for (int dir = 0; dir < 2; ++dir) { const size_t cd = (size_t)task * 2 + dir;
            bf16_t* Ig = (bf16_t*)(F.big_() + BIG_MINTRA) + cd * 8192 + (size_t)w * 1024 + lane * 4; bf16_t* Ug = (bf16_t*)(F.big_() + BIG_MU) + cd * 8192 + (size_t)w * 1024 + lane * 4;
            const bf16x8_t v0 = frag_nat(LVT, 72, 16 * w + r, 0, g), v1 = frag_nat(LVT, 72, 16 * w + r, 32, g);
#pragma unroll
            for (int m = 0; m < 4; ++m) { f32x4 ai = (f32x4){0.f, 0.f, 0.f, 0.f}, au = (f32x4){0.f, 0.f, 0.f, 0.f};
                ai = MFMA16(frag_nat(LPM + dir * 64 * 72, 72, 16 * m + r, 0, g), v0, ai); ai = MFMA16(frag_nat(LPM + dir * 64 * 72, 72, 16 * m + r, 32, g), v1, ai);
                au = MFMA16(frag_nat(LKW + dir * 64 * 72, 72, rowp(m, r), 0, g), v0, au); au = MFMA16(frag_nat(LKW + dir * 64 * 72, 72, rowp(m, r), 32, g), v1, au);
                *(u2v*)(Ig + m * 256) = pk4(ai); *(u2v*)(Ug + m * 256) = pk4(au); }
        }
    }
}
constexpr int MS_LQS = 0, MS_LVEC = 9216, MS_WSCR = 10304;
__device__ __forceinline__ void ml_scan_seq(Frame& F, int seq, int h, int dir, int esl0, int nact) {
    const int lane = F.lane, w = F.wave, r = lane & 15, g = lane >> 4, ws = esl0 + w;
    if (w >= nact) return;
    LAS float* WS = (LAS float*)(F.lds + MS_WSCR) + w * 192;
    const int NC = seq < 16 ? 4 : 16, ck0 = seq < 16 ? seq * 4 : 64 + (seq - 16) * 16, rowS = seq_row0(seq);
    bf16_t* O = (bf16_t*)(F.slab_() + (dir ? SLAB_FULL : 0));
    f32x4 Cacc[4]; float nst = 0.f, mst = 0.f;
    if (seq >= 16) { const size_t sidx = (size_t)((seq - 16) * 2 + dir) * 8 + h; const float* c0 = F.inp(I_SC) + sidx * 8192 + 16 * ws + r;
#pragma unroll
        for (int j = 0; j < 4; ++j)
#pragma unroll
            for (int i = 0; i < 4; ++i) Cacc[j][i] = c0[(32 * (j >> 1) + 8 * g + 4 * (j & 1) + i) * 128];
        nst = F.inp(I_SN)[sidx * 64 + lane]; mst = F.inp(I_SM)[sidx]; }
    else {
#pragma unroll
        for (int j = 0; j < 4; ++j) Cacc[j] = (f32x4){0.f, 0.f, 0.f, 0.f}; }
    struct MStage { bf16x8_t qf[4][2]; f32x4 vt[3]; float ks, bl, wm; u2v I[4], U[4]; };
    constexpr int PD = 2;
    MStage st[PD];
#define MS_LOAD(S, n) do { const int ckn = ck0 + (dir ? NC - 1 - (n) : (n)); const size_t tk = (size_t)ckn * 8 + h, cd = tk * 2 + dir; \
        const bf16_t* gQ = (const bf16_t*)(F.big_() + BIG_MQS) + tk * 4096 + r * 64 + 8 * g; const float* gV = (const float*)(F.big_() + BIG_MVEC) + cd * 272; \
        _Pragma("unroll") for (int m = 0; m < 4; ++m) { S.qf[m][0] = *(const bf16x8_t*)(gQ + m * 1024); S.qf[m][1] = *(const bf16x8_t*)(gQ + m * 1024 + 32); } \
        _Pragma("unroll") for (int q = 0; q < 3; ++q) S.vt[q] = *(const f32x4*)(gV + q * 64 + r * 4); \
        S.ks = gV[192 + lane]; S.bl = gV[256]; S.wm = gV[257]; \
        const bf16_t* gI = (const bf16_t*)(F.big_() + BIG_MINTRA) + cd * 8192 + (size_t)ws * 1024 + lane * 4; const bf16_t* gU = (const bf16_t*)(F.big_() + BIG_MU) + cd * 8192 + (size_t)ws * 1024 + lane * 4; \
        _Pragma("unroll") for (int m = 0; m < 4; ++m) { S.I[m] = *(const u2v*)(gI + m * 256); S.U[m] = *(const u2v*)(gU + m * 256); } } while (0)
#pragma unroll
    for (int k = 0; k < PD; ++k) MS_LOAD(st[k], k);
    for (int n0 = 0; n0 < NC; n0 += PD) {
#pragma unroll
      for (int k = 0; k < PD; ++k) { const int n = n0 + k; const int ckc = ck0 + (dir ? NC - 1 - n : n);
        WS[lane] = nst;
        const f32x4 na0 = *(const LAS f32x4*)(WS + 8 * g), na1 = *(const LAS f32x4*)(WS + 8 * g + 4), nb0 = *(const LAS f32x4*)(WS + 32 + 8 * g), nb1 = *(const LAS f32x4*)(WS + 32 + 8 * g + 4);
        float qn[4];
#pragma unroll
        for (int m = 0; m < 4; ++m) { const bf16x8_t qa = st[k].qf[m][0], qb = st[k].qf[m][1]; float p = 0.f;
#pragma unroll
            for (int e = 0; e < 4; ++e) { p += bf2f((unsigned short)qa[e]) * na0[e]; p += bf2f((unsigned short)qa[4 + e]) * na1[e]; p += bf2f((unsigned short)qb[e]) * nb0[e]; p += bf2f((unsigned short)qb[4 + e]) * nb1[e]; }
            p += __shfl_xor(p, 16); p += __shfl_xor(p, 32); qn[m] = p; }
#pragma unroll
        for (int m = 0; m < 4; ++m) { const float bc = st[k].vt[0][m], dm = st[k].vt[1][m], rs = st[k].vt[2][m];
            const float mt = fmaxf(bc + mst, dm), inter = __expf(bc + mst - mt), rr = __expf(dm - mt);
            const float inv = __builtin_amdgcn_rcpf(fmaxf(fabsf(inter * qn[m] + rr * rs), __expf(-mt)));
            if (g == 0) { WS[64 + 16 * m + r] = inter * inv; WS[128 + 16 * m + r] = rr * inv; } }
        const bf16x8_t Cb0 = pack_acc(Cacc[0], Cacc[1]), Cb1 = pack_acc(Cacc[2], Cacc[3]);
#pragma unroll
        for (int m = 0; m < 4; ++m) { f32x4 qc = (f32x4){0.f, 0.f, 0.f, 0.f};
            qc = MFMA16(st[k].qf[m][0], Cb0, qc); qc = MFMA16(st[k].qf[m][1], Cb1, qc);
            const f32x4 ac = *(const LAS f32x4*)(WS + 64 + 16 * m + 4 * g), bcf = *(const LAS f32x4*)(WS + 128 + 16 * m + 4 * g);
            const f32x4 hv = ac * qc + bcf * up4(st[k].I[m]);
            bf16_t* op = O + (size_t)(rowS + (ckc - ck0) * 64 + 16 * m + 4 * g) * D + h * 128 + 16 * ws + r;
            const unsigned p01 = cvtpk(hv[0], hv[1]), p23 = cvtpk(hv[2], hv[3]);
            op[0] = (bf16_t)p01; op[(size_t)D] = (bf16_t)(p01 >> 16); op[(size_t)2 * D] = (bf16_t)p23; op[(size_t)3 * D] = (bf16_t)(p23 >> 16); }
        const float bl = st[k].bl, wm = st[k].wm, mn = fmaxf(bl + mst, wm), dec = __expf(bl + mst - mn), fw = __expf(wm - mn);
#pragma unroll
        for (int j = 0; j < 4; ++j) Cacc[j] = Cacc[j] * dec + up4(st[k].U[j]) * fw;
        nst = dec * nst + fw * st[k].ks; mst = mn;
        if (n + PD < NC) MS_LOAD(st[k], n + PD);
      }
    }
#undef MS_LOAD
    if (seq < 16) { const size_t sidx = (size_t)(seq * 2 + dir) * 8 + h; float* nc = F.out + O_NC + sidx * 8192 + 16 * ws + r;
#pragma unroll
        for (int j = 0; j < 4; ++j)
#pragma unroll
            for (int i = 0; i < 4; ++i) nc[(32 * (j >> 1) + 8 * g + 4 * (j & 1) + i) * 128] = Cacc[j][i];
        if (w == 0) { F.out[O_NN + sidx * 64 + lane] = nst; if (lane == 0) F.out[O_NM + sidx] = mst; } }
}
__device__ __forceinline__ bool ml_scan_slot(int wg, int rnd, int& seq, int& h, int& dir, int& esl0, int& nact) {
    int id;
    if (wg < 64) { if (rnd) return false; id = wg >> 1; esl0 = (wg & 1) * 4; nact = 4; seq = 16 + id / 16; }
    else { if (wg >= 160) return false; id = (wg - 64) + rnd * 96; if (id >= 256) return false; esl0 = 0; nact = 8; seq = id / 16; }
    h = (id >> 1) & 7; dir = id & 1; return true;
}
__device__ __forceinline__ void ph_ml_scan2(Frame& F) {
    for (int rnd = 0; rnd < 3; ++rnd) { int seq, h, dir, esl0, nact; if (!ml_scan_slot(F.wg, rnd, seq, h, dir, esl0, nact)) break; ml_scan_seq(F, seq, h, dir, esl0, nact); }
}
__device__ __forceinline__ void ph_post(Frame& F, int NP, int gate_col0, int gate_kind, const float* nw) {
    const bf16_t* P = (const bf16_t*)(F.big_() + BIG_PROJ); const bf16_t* OF = (const bf16_t*)F.slab_(); const bf16_t* OB = (const bf16_t*)(F.slab_() + SLAB_FULL); bf16_t* OG = (bf16_t*)(F.big_() + BIG_OG);
    const int gw = F.wg * NWAVES + F.wave, NGW = F.G * NWAVES, lane = F.lane;
    const f32x2 w = *(const f32x2*)(nw + 2 * lane);
    constexpr int IU = 6;
    for (int ib = gw; ib < MTOT * 8; ib += IU * NGW) {
        f32x2 v[IU]; unsigned zz[IU];
#pragma unroll
        for (int q = 0; q < IU; ++q) { const int it = ib + q * NGW; const bool ok = it < MTOT * 8; const int row = ok ? it >> 3 : 0, h = it & 7; const size_t o = (size_t)row * D + h * 128 + 2 * lane;
            { const unsigned uf = *(const unsigned*)(OF + o), ub = *(const unsigned*)(OB + o); v[q] = (f32x2){bf2f(uf & 0xffffu) + bf2f(ub & 0xffffu), bf2f(uf >> 16) + bf2f(ub >> 16)}; } zz[q] = *(const unsigned*)(P + (size_t)row * NP + gate_col0 + h * 128 + 2 * lane); }
#pragma unroll
        for (int q = 0; q < IU; ++q) { const int it = ib + q * NGW; if (it >= MTOT * 8) continue; const int row = it >> 3, h = it & 7; const size_t o = (size_t)row * D + h * 128 + 2 * lane;
            const float rstd = rsqrtf(wave_sum(v[q][0] * v[q][0] + v[q][1] * v[q][1]) * (1.f / 128.f) + EPS);
            const float z0 = bf2f(zz[q] & 0xffffu), z1 = bf2f(zz[q] >> 16);
            const float g0 = gate_kind == 0 ? silu_f(z0) : sigmoid_f(z0), g1 = gate_kind == 0 ? silu_f(z1) : sigmoid_f(z1);
            st4_wt(OG + o, cvtpk(v[q][0] * rstd * w[0] * g0, v[q][1] * rstd * w[1] * g1)); }
    }
}

#define R(cls, call) do { call; if (PROBE_MASK & (1 << (cls))) { call; } } while (0)
constexpr int NPHASES = 36;
__global__ void __launch_bounds__(NTHR, 2) mega(Args args) {
    extern __shared__ __attribute__((aligned(16))) unsigned char lds_raw[];
    Frame F;
    F.out = args.out; F.ws = args.ws; F.lds = (LAS unsigned char*)lds_raw;
    F.tid = threadIdx.x; F.lane = F.tid & 63; F.wave = __builtin_amdgcn_readfirstlane(F.tid >> 6); F.G = gridDim.x; F.wg = blockIdx.x;
    volatile LAS unsigned* MISC = (volatile LAS unsigned*)(F.lds + MISC_OFF);
    if (F.tid < 64) MISC[F.tid] = 0u;
    if (F.tid >= 64 && F.tid < 64 + N_IN) ((LAS unsigned long long*)(F.lds + PTR_OFF))[F.tid - 64] = (unsigned long long)args.in[F.tid - 64];
    __syncthreads();
    const int lo = args.ph_lo, hi = args.ph_hi;
    XcdBarrier bar; bar.bar = (unsigned*)(args.ws + WS_CTL); bar.x = 0; bar.st = MISC + 8;
    if (hi - lo > 1) bar = xcd_barrier_post((unsigned*)(args.ws + WS_CTL), MISC + 8);
    int ph = 0;
#define PH_BEGIN if (ph >= lo && ph < hi) {
#define PH_END   if (ph + 1 < hi) xcd_barrier(bar); } ++ph;
#define PH_ENDC  if (ph + 1 < hi) xcd_barrier(bar, true); } ++ph;
#define PH_END_PREC(Bexpr, ldb) if (ph + 1 < hi) xcd_barrier_pre(bar, F.lds, Bexpr, ldb, true); } ++ph;
#define PH_END_PRE(Bexpr, ldb) if (ph + 1 < hi) xcd_barrier_pre(bar, F.lds, Bexpr, ldb); } ++ph;
    #define in_nmix F.inp(I_NMIX)
#define in_nffn F.inp(I_NFFN)

    PH_BEGIN R(4, ph_prologue(F)); PH_END
    PH_BEGIN R(3, ph_wcs(F)); ph_norm(F, -1, 0, nullptr, 0, 0, 1.f, 1.f, 0, 0, in_nmix, true, 64); PH_ENDC
#define MIX_FOURIER(j) \
    PH_BEGIN R(3, ph_f1(F, j)); PH_ENDC \
    PH_BEGIN R(3, ph_f2(F)); PH_ENDC
#define FFN_BLOCK(l, mbias, nsc, nss, sc_c, sc_s) \
    PH_BEGIN ph_norm(F, l, 2, mbias, nsc, nss, sc_c, sc_s, l, 3, in_nffn + (l) * D); PH_END_PREC(firstB_up(F, l), D) \
    PH_BEGIN ph_ffn_up(F, l); PH_ENDC \
    PH_BEGIN R(2, ph_ffn_conv(F, l)); PH_END_PREC(firstB_slab(F, (const bf16_t*)(F.big_() + BIG_ACT), DFF, F.wt_() + WT_DN + (size_t)(l) * D * DFF * 2), DFF) \
    PH_BEGIN ph_gemm_slab(F, (const bf16_t*)(F.big_() + BIG_ACT), DFF, F.wt_() + WT_DN + (size_t)(l) * D * DFF * 2); PH_ENDC
    MIX_FOURIER(0)
    FFN_BLOCK(0, F.inp(I_FB), 1, 4, 1.f / 256.f, 1.f / 512.f)
    PH_BEGIN ph_norm(F, 0, 5, nullptr, 2, 2, 1.f, 1.f, 1, 0, in_nmix + 1 * D); PH_END_PREC(firstB_proj(F, F.wt_() + WT_DIN, 16), D)
    PH_BEGIN ph_proj(F, F.wt_() + WT_DIN, 16); PH_ENDC
    PH_BEGIN R(5, ph_dn_prep2(F)); PH_END
    PH_BEGIN R(0, ph_dn_scan2(F)); PH_END
    PH_BEGIN R(7, ph_post(F, 4096, 3072, 0, F.inp(I_DNORM))); PH_END_PREC(firstB_slab(F, (const bf16_t*)(F.big_() + BIG_OG), D, F.wt_() + WT_DOUT), D)
    PH_BEGIN ph_gemm_slab(F, (const bf16_t*)(F.big_() + BIG_OG), D, F.wt_() + WT_DOUT); PH_ENDC
    FFN_BLOCK(1, nullptr, 2, 2, 1.f, 1.f)
    PH_BEGIN ph_norm(F, 1, 5, nullptr, 2, 2, 1.f, 1.f, 2, 0, in_nmix + 2 * D); PH_END_PREC(firstB_proj(F, F.wt_() + WT_MIN, 12), D)
    PH_BEGIN ph_proj(F, F.wt_() + WT_MIN, 12); PH_ENDC
    PH_BEGIN R(6, ph_ml_prep(F)); PH_END_PRE(firstB_og(F), D)
    PH_BEGIN R(0, ph_ml_scan2(F)); ph_ml_ogate(F); PH_END
    PH_BEGIN R(7, ph_post(F, 3072, 2048, 1, F.inp(I_MNORM))); PH_END_PREC(firstB_slab(F, (const bf16_t*)(F.big_() + BIG_OG), D, F.wt_() + WT_MOUT), D)
    PH_BEGIN ph_gemm_slab(F, (const bf16_t*)(F.big_() + BIG_OG), D, F.wt_() + WT_MOUT); PH_ENDC
    FFN_BLOCK(2, nullptr, 2, 2, 1.f, 1.f)
    PH_BEGIN ph_norm(F, 2, 5, nullptr, 2, 2, 1.f, 1.f, 3, 0, in_nmix + 3 * D); PH_ENDC
    MIX_FOURIER(1)
    FFN_BLOCK(3, F.inp(I_FB) + D, 1, 4, 1.f / 256.f, 1.f / 512.f)
    PH_BEGIN ph_norm(F, 3, 5, nullptr, 2, 2, 1.f, 1.f, -1, 0, F.inp(I_NFIN)); PH_ENDC
}

extern "C" void kernel_launch(void* const* d_in, const int* in_sizes, int n_in, void* d_out, int out_size, void* d_ws, size_t ws_size, hipStream_t stream) {
    static int grid = 0;
    if (grid == 0) {
        if (n_in != N_IN || ws_size < WS_END) { fprintf(stderr, "kernel_launch: unexpected n_in %d / ws %zu (need %zu)\n", n_in, ws_size, (size_t)WS_END); grid = -1; return; }
        int dev = 0, cus = 0, per_cu = 0;
        (void)hipGetDevice(&dev); (void)hipDeviceGetAttribute(&cus, hipDeviceAttributeMultiprocessorCount, dev);
        (void)hipFuncSetAttribute((const void*)mega, hipFuncAttributeMaxDynamicSharedMemorySize, LDS_BYTES);
        if (hipOccupancyMaxActiveBlocksPerMultiprocessor(&per_cu, (const void*)mega, NTHR, LDS_BYTES) != hipSuccess || per_cu < 1) per_cu = 1;
        (void)hipGetLastError();
        (void)cus; grid = 256;
    }
    if (grid < 0) return;
    (void)hipMemsetAsync((char*)d_ws + WS_CTL, 0, ZERO_BYTES, stream);
    Args a{};
    for (int i = 0; i < N_IN; ++i) a.in[i] = (const float*)d_in[i];
    a.out = (float*)d_out; a.ws = (unsigned char*)d_ws;
#if N_LAUNCH_MODE == 1
    a.ph_lo = 0; a.ph_hi = NPHASES;
    void* kargs[] = {&a};
    hipError_t e = hipLaunchCooperativeKernel((const void*)mega, dim3(grid), dim3(NTHR), kargs, LDS_BYTES, stream);
    if (e != hipSuccess) fprintf(stderr, "cooperative launch failed: %s (grid %d)\n", hipGetErrorString(e), grid);
#else
    for (int p = 0; p < NPHASES; ++p) { a.ph_lo = p; a.ph_hi = p + 1; hipLaunchKernelGGL(mega, dim3(grid), dim3(NTHR), LDS_BYTES, stream, a); }
#endif
}
```
